# Optimizing an MI355X kernel written in HIP

```python
import math
import jax, jax.numpy as jnp
from jax import lax
import numpy as np

D_MODEL = 1024
BATCH = 8
SEQ = 2048
DEPTH = 1

CHUNK = 64
SSD_DIM = D_MODEL
SSD_HEAD_DIM = 64
SSD_HEADS = SSD_DIM // SSD_HEAD_DIM
SSD_NGROUPS = 2
SSD_STATE = 128
SSD_CONV = 4
POOL_DIM = D_MODEL
POOL_WINDOWS = (2, 4, 8, 16)
POOL_GROUPS = len(POOL_WINDOWS)
POOL_GROUP_DIM = POOL_DIM // POOL_GROUPS
MIX_DIM = SSD_DIM + POOL_DIM
CONV_DIM = SSD_DIM + 2 * SSD_NGROUPS * SSD_STATE
IN_DIM = SSD_DIM + CONV_DIM + SSD_HEADS + POOL_DIM
D_FF = 2816
NORM_EPS = 1e-6

kernel_name = "hybrid_ssd_pool_macaron_block"


def rms_norm(x, g):
    xf = x.astype(jnp.float32)
    y = xf * lax.rsqrt(jnp.mean(xf * xf, axis=-1, keepdims=True) + NORM_EPS)
    return (y * g.astype(jnp.float32)).astype(x.dtype)


def swiglu(h, w_gate, w_up, w_down):
    return (jax.nn.silu(h @ w_gate) * (h @ w_up)) @ w_down


def causal_depthwise_conv(u, w, b):
    c = u.shape[-1]
    y = lax.conv_general_dilated(
        u, w.astype(u.dtype)[:, None, :], window_strides=(1,),
        padding=[(SSD_CONV - 1, 0)], dimension_numbers=('NWC', 'WIO', 'NWC'),
        feature_group_count=c)
    return y + b.astype(u.dtype)


def ssd_chunked_scan(xh, dt, A, Bh, Ch):
    b, s, h, p = xh.shape
    n = Bh.shape[-1]
    c = s // CHUNK
    X = (xh * dt[..., None]).reshape(b, c, CHUNK, h, p)
    Bc = Bh.reshape(b, c, CHUNK, h, n)
    Cc = Ch.reshape(b, c, CHUNK, h, n)
    A_cs = jnp.cumsum((dt * A).reshape(b, c, CHUNK, h).transpose(0, 3, 1, 2), axis=-1)
    causal = jnp.tril(jnp.ones((CHUNK, CHUNK), dtype=bool))
    L = jnp.exp(jnp.where(causal, A_cs[..., :, None] - A_cs[..., None, :], -jnp.inf))
    y_diag = jnp.einsum('bclhn,bcshn,bhcls,bcshp->bclhp', Cc, Bc, L, X)
    decay_states = jnp.exp(A_cs[..., -1:] - A_cs)
    states = jnp.einsum('bclhn,bhcl,bclhp->bchpn', Bc, decay_states, X)
    chunk_decay = jnp.exp(A_cs[..., -1])

    def step(carry, inp):
        st, dec = inp
        return dec[..., None, None] * carry + st, carry

    _, prev = lax.scan(step, jnp.zeros((b, h, p, n), jnp.float32),
                       (states.transpose(1, 0, 2, 3, 4), chunk_decay.transpose(2, 0, 1)))
    prev = prev.transpose(1, 0, 2, 3, 4)
    y_off = jnp.einsum('bclhn,bchpn,bhcl->bclhp', Cc, prev, jnp.exp(A_cs))
    return (y_diag + y_off).reshape(b, s, h, p)


def ssd_group(z, xbc, dt_raw, conv_w, conv_b, dt_bias, a_log, d_skip, ssd_norm):
    b, s, _ = z.shape
    xbc = jax.nn.silu(causal_depthwise_conv(xbc, conv_w, conv_b)).astype(jnp.float32)
    gn = SSD_NGROUPS * SSD_STATE
    xs = xbc[..., :SSD_DIM].reshape(b, s, SSD_HEADS, SSD_HEAD_DIM)
    rep = SSD_HEADS // SSD_NGROUPS
    Bh = jnp.repeat(xbc[..., SSD_DIM:SSD_DIM + gn].reshape(b, s, SSD_NGROUPS, SSD_STATE), rep, axis=2)
    Ch = jnp.repeat(xbc[..., SSD_DIM + gn:].reshape(b, s, SSD_NGROUPS, SSD_STATE), rep, axis=2)
    dt = jax.nn.softplus(dt_raw.astype(jnp.float32) + dt_bias.astype(jnp.float32))
    A = -jnp.exp(a_log.astype(jnp.float32))
    y = ssd_chunked_scan(xs, dt, A, Bh, Ch) + d_skip.astype(jnp.float32)[:, None] * xs
    yg = (y.reshape(b, s, SSD_DIM) * jax.nn.silu(z.astype(jnp.float32))).reshape(b, s, SSD_NGROUPS, -1)
    yg = yg * lax.rsqrt(jnp.mean(yg * yg, axis=-1, keepdims=True) + NORM_EPS)
    return (yg.reshape(b, s, SSD_DIM) * ssd_norm.astype(jnp.float32)).astype(z.dtype)


def multiscale_pool_group(u, pool_w, pool_scale):
    b, s, _ = u.shape
    uf = u.astype(jnp.float32).reshape(b, s, POOL_GROUPS, POOL_GROUP_DIM)
    csp = jnp.pad(jnp.cumsum(uf, axis=1), ((0, 0), (1, 0), (0, 0), (0, 0)))
    t = jnp.arange(s)
    outs = []
    for gi, win in enumerate(POOL_WINDOWS):
        cg = csp[:, :, gi]
        lo = jnp.pad(cg[:, :s + 1 - win], ((0, 0), (win - 1, 0), (0, 0)))
        cnt = jnp.minimum(t + 1, win).astype(jnp.float32)[None, :, None]
        outs.append((cg[:, 1:] - lo) / cnt - uf[:, :, gi])
    pooled = jnp.stack(outs, axis=2)
    y = jnp.einsum('bsgc,gcd->bsgd', pooled, pool_w.astype(jnp.float32)).reshape(b, s, POOL_DIM)
    return (y * pool_scale.astype(jnp.float32)).astype(u.dtype)


def setup_inputs(seed: int = 0) -> dict:
    key = jax.random.key(seed)
    ks = jax.random.split(key, 24)
    f32 = jnp.float32

    def nrm(k, shape, scale):
        return jax.random.normal(k, shape, f32) * scale

    def gain(k, shape):
        return 1.0 + 0.05 * jax.random.normal(k, shape, f32)

    L = DEPTH
    dt0 = jnp.exp(jax.random.uniform(ks[9], (L, SSD_HEADS), f32) * (math.log(0.1) - math.log(1e-3)) + math.log(1e-3))
    dt_bias = dt0 + jnp.log(-jnp.expm1(-dt0))
    return {
        "x": jax.random.normal(ks[0], (BATCH, SEQ, D_MODEL), f32),
        "ffn1_norm": gain(ks[1], (L, D_MODEL)),
        "ffn1_w_gate": nrm(ks[2], (L, D_MODEL, D_FF), D_MODEL ** -0.5),
        "ffn1_w_up": nrm(ks[3], (L, D_MODEL, D_FF), D_MODEL ** -0.5),
        "ffn1_w_down": nrm(ks[4], (L, D_FF, D_MODEL), D_FF ** -0.5),
        "mix_norm": gain(ks[5], (L, D_MODEL)),
        "w_in": nrm(ks[6], (L, D_MODEL, IN_DIM), D_MODEL ** -0.5),
        "conv_w": nrm(ks[7], (L, SSD_CONV, CONV_DIM), SSD_CONV ** -0.5),
        "conv_b": nrm(ks[8], (L, CONV_DIM), 0.02),
        "dt_bias": dt_bias,
        "a_log": jnp.log(jax.random.uniform(ks[10], (L, SSD_HEADS), f32, 1.0, 16.0)),
        "d_skip": gain(ks[11], (L, SSD_HEADS)),
        "ssd_norm": gain(ks[12], (L, SSD_DIM)),
        "pool_w": nrm(ks[13], (L, POOL_GROUPS, POOL_GROUP_DIM, POOL_GROUP_DIM), POOL_GROUP_DIM ** -0.5),
        "pool_scale": gain(ks[14], (L, POOL_DIM)),
        "w_out": nrm(ks[15], (L, MIX_DIM, D_MODEL), MIX_DIM ** -0.5),
        "ffn2_norm": gain(ks[16], (L, D_MODEL)),
        "ffn2_w_gate": nrm(ks[17], (L, D_MODEL, D_FF), D_MODEL ** -0.5),
        "ffn2_w_up": nrm(ks[18], (L, D_MODEL, D_FF), D_MODEL ** -0.5),
        "ffn2_w_down": nrm(ks[19], (L, D_FF, D_MODEL), D_FF ** -0.5),
        "final_norm": gain(ks[20], (D_MODEL,)),
    }


def reference(x, ffn1_norm, ffn1_w_gate, ffn1_w_up, ffn1_w_down, mix_norm, w_in, conv_w, conv_b,
              dt_bias, a_log, d_skip, ssd_norm, pool_w, pool_scale, w_out, ffn2_norm,
              ffn2_w_gate, ffn2_w_up, ffn2_w_down, final_norm):
    for i in range(DEPTH):
        x = x + 0.5 * swiglu(rms_norm(x, ffn1_norm[i]), ffn1_w_gate[i], ffn1_w_up[i], ffn1_w_down[i])
        h = rms_norm(x, mix_norm[i])
        proj = h @ w_in[i]
        o1 = SSD_DIM
        o2 = o1 + CONV_DIM
        o3 = o2 + SSD_HEADS
        z, xbc, dt_raw, u = proj[..., :o1], proj[..., o1:o2], proj[..., o2:o3], proj[..., o3:]
        y_ssd = ssd_group(z, xbc, dt_raw, conv_w[i], conv_b[i], dt_bias[i], a_log[i], d_skip[i], ssd_norm[i])
        y_pool = multiscale_pool_group(u, pool_w[i], pool_scale[i])
        x = x + jnp.concatenate([y_ssd, y_pool], axis=-1) @ w_out[i]
        x = x + 0.5 * swiglu(rms_norm(x, ffn2_norm[i]), ffn2_w_gate[i], ffn2_w_up[i], ffn2_w_down[i])
    return rms_norm(x, final_norm)
```

```cpp
#include <hip/hip_runtime.h>
#include <hip/hip_cooperative_groups.h>
#include <cstdio>
#include <cstdint>
namespace cg = cooperative_groups;

#ifndef MK_N_LAUNCHES
#define MK_N_LAUNCHES 1
#endif
#ifndef MK_CG_SYNC
#define MK_CG_SYNC 0
#endif

#define LAS __attribute__((address_space(3)))
#define GAS __attribute__((address_space(1)))
typedef unsigned short bf16;
typedef short bf16x8 __attribute__((ext_vector_type(8)));
typedef float f32x4 __attribute__((ext_vector_type(4)));
typedef float f32x2 __attribute__((ext_vector_type(2)));
typedef unsigned u32x4 __attribute__((ext_vector_type(4)));
typedef unsigned u32x2 __attribute__((ext_vector_type(2)));

constexpr int M = 16384, SEQ = 2048, D = 1024, FF = 2816, NGU = 2 * FF, NIN = 3840, PROJ_LD = 3584, MIXD = 2048;
constexpr int Z_OFF = 0, XS_OFF = 1024, B_OFF = 2048, C_OFF = 2304, U_OFF = 2560;
constexpr int CONV_DIM = 1536;
constexpr float EPS = 1e-6f;
constexpr int NWAVES = 8, NTHR = 512;

constexpr size_t MiB = 1u << 20;
constexpr size_t WS_CTL = 0, CTL_ZERO_BYTES = 64 * 1024;
constexpr size_t WS_SS = 64 * 1024;
constexpr size_t WS_RS0 = 448 * 1024;
constexpr size_t WS_RS1 = 320 * 1024, WS_RS2 = 384 * 1024;
constexpr size_t WS_GU1 = 1 * MiB;
constexpr size_t WS_PSS = 1 * MiB;
constexpr size_t WS_D1 = 12 * MiB;
constexpr size_t WS_DT = 12 * MiB;
constexpr size_t WS_DTV = 13 * MiB;
constexpr size_t WS_CSV = 14 * MiB;
constexpr size_t WS_GU2 = WS_D1 + 5 * MiB + 512 * 1024;
constexpr size_t WS_D2 = WS_GU2 + 11 * MiB;
constexpr size_t WS_WIN = 34 * MiB;
constexpr size_t WS_WOUT = WS_WIN + 7 * MiB + 512 * 1024;
constexpr size_t WS_PROJ = 46 * MiB;
constexpr size_t WS_HID = 46 * MiB;
constexpr size_t WS_MIX = 158 * MiB;
constexpr size_t WS_FA = 158 * MiB;
constexpr size_t WS_FB = 160 * MiB;
constexpr size_t WS_XN = 222 * MiB;
constexpr size_t WS_BCG = 222 * MiB;
constexpr size_t WS_END = 254 * MiB;
constexpr int CW_BAR = 1024;
constexpr int CW_PANEL = 8192;

constexpr int RING_BYTES = 131072;
constexpr int TAB_OFF = RING_BYTES;
constexpr int MISC_OFF = TAB_OFF + 4096;
constexpr int LDS_BYTES = 147456;

__device__ __forceinline__ unsigned f2bf(float f) { unsigned u = __builtin_bit_cast(unsigned, f); return (u + 0x7fffu + ((u >> 16) & 1u)) >> 16; }
__device__ __forceinline__ unsigned cvt_pk_bf16(float lo, float hi) { unsigned r; asm volatile("v_cvt_pk_bf16_f32 %0, %1, %2" : "=v"(r) : "v"(lo), "v"(hi)); return r; }
__device__ __forceinline__ unsigned pk2(float lo, float hi) { return cvt_pk_bf16(lo, hi); }
typedef float f32x2_t __attribute__((ext_vector_type(2))); typedef __bf16 bf16x2_t __attribute__((ext_vector_type(2)));
__device__ __forceinline__ unsigned cvtpk_s(float lo, float hi) { f32x2_t v = {lo, hi}; bf16x2_t b = __builtin_convertvector(v, bf16x2_t); return __builtin_bit_cast(unsigned, b); }
__device__ __forceinline__ float bflo(unsigned u) { return __builtin_bit_cast(float, u << 16); }
__device__ __forceinline__ float bfhi(unsigned u) { return __builtin_bit_cast(float, u & 0xffff0000u); }
__device__ __forceinline__ float silu_f(float v) { return v * __builtin_amdgcn_rcpf(1.0f + __builtin_amdgcn_exp2f(-1.44269504f * v)); }
__device__ __forceinline__ float wave_sum(float v) {
#pragma unroll
    for (int o = 1; o < 64; o <<= 1) v += __shfl_xor(v, o);
    return v;
}
#define LDS_WAIT() asm volatile("s_waitcnt lgkmcnt(0)" ::: "memory")
#define VM_WAIT() asm volatile("s_waitcnt vmcnt(0)" ::: "memory")

namespace pg8 {
constexpr int BM = 256, BK = 64, HALF = 128, HTB = HALF * BK * 2, STAGE_BYTES = 8 * HTB, NXCD = 8, WGM = 8;
__host__ __device__ __forceinline__ int lds_byte(int r, int c) { const int st = (r >> 4) * 2 + (c >> 5), rr = r & 15, cc = c & 31, ob = rr * 64 + cc * 2; return st * 1024 + (ob ^ (((ob >> 9) & 1) << 5)); }
__host__ __device__ __forceinline__ void stage_rc(int b, int& R, int& C) { const int st = b / 1024, sb = b % 1024, swz = sb ^ (((sb >> 9) & 1) << 5); R = (st >> 1) * 16 + swz / 64; C = (st & 1) * 32 + (swz % 64) / 2; }
__host__ __device__ __forceinline__ int perm32(int rho) { const int n = rho >> 4, i = rho & 15; return 8 * (i >> 2) + 4 * n + (i & 3); }

struct Unit { int pm, pn; };
struct Gemm { const bf16* A; const bf16* Bt; int M, N, K; };

struct StaticOrder {
    int nM, nN, nwg, G, c;
    __host__ __device__ void init(int M_, int N_, int G_, int c_) { nM = M_ / BM; nN = N_ / BM; nwg = nM * nN; G = G_; c = c_; }
    __host__ __device__ bool next(int i, Unit& u) const {
        const long L = (long)i * G + c; if (L >= nwg) return false;
        int wgid = (int)L; { const int q = nwg / NXCD, r = nwg % NXCD, xcd = wgid % NXCD, off = wgid / NXCD; wgid = (xcd < r ? xcd * (q + 1) : r * (q + 1) + (xcd - r) * q) + off; }
        const int nig = WGM * nN, gid = wgid / nig, fm = gid * WGM, gsz = (nM - fm) < WGM ? (nM - fm) : WGM;
        u.pm = fm + ((wgid % nig) % gsz); u.pn = (wgid % nig) / gsz; return true;
    }
};

struct FoldOrder {
    int c;
    __host__ __device__ bool next(int i, Unit& u) const { const int idx = i * 64 + c; if (c < 0 || idx >= 16) return false; u.pm = idx; u.pn = idx >> 2; return true; }
};
struct NoHook { static constexpr bool ON = false; };
struct ScaleHook { static constexpr bool ON = true; const LAS float* F; int t0, t1; };

template <class Epi, class Sched, class Hook, bool ALIGN_EPI>
__device__ __forceinline__ void gemm_phase(LAS unsigned char* lds, const Gemm g, const Sched& S, const Epi& E, const Hook& HK) {
    const int tid = threadIdx.x, wid = __builtin_amdgcn_readfirstlane(tid >> 6), lane = tid & 63, wr = wid >> 2, wc = wid & 3, fr = lane & 15, fq = lane >> 4;
    const int K = g.K, nt = K / BK;
    unsigned voffA[2], voffB[2];
#pragma unroll
    for (int i = 0; i < 2; ++i) { int R, C; stage_rc(tid * 16 + i * 8192, R, C); const int Rb = (R & ~31) + perm32(R & 31);
        voffA[i] = (unsigned)(R * K + C) * 2u; voffB[i] = (unsigned)(Rb * K + C) * 2u; }
    const size_t kstep = (size_t)(BK * 2);
    const size_t hstep = (size_t)HALF * K * 2;
    const size_t tstep = 2 * hstep;
    const unsigned ldsw = (unsigned)wid * 1024u;
    const int aoff = lds_byte(wr * 64 + fr, fq * 8), boff = lds_byte(wc * 32 + fr, fq * 8);
#define PG8_SA(b, h) (((b) * 2 + (h)) * HTB)
#define PG8_SB(b, h) ((4 + (b) * 2 + (h)) * HTB)
#define PG8_STAGE(bufoff, gbase, voff) do { _Pragma("unroll") for (int _i = 0; _i < 2; ++_i) \
        __builtin_amdgcn_global_load_lds((const unsigned*)((const char*)(gbase) + (voff)[_i]), (LAS unsigned*)(lds + (bufoff) + ldsw + _i * 8192), 16, 0, 0); } while (0)
#define PG8_LDA(dst, b, h) do { _Pragma("unroll") for (int m = 0; m < 4; ++m) _Pragma("unroll") for (int k = 0; k < 2; ++k) dst[m][k] = *(const LAS bf16x8*)(lds + PG8_SA(b, h) + aoff + m * 2048 + k * 1024); } while (0)
#define PG8_LDB(dst, b, h) do { _Pragma("unroll") for (int n = 0; n < 2; ++n) _Pragma("unroll") for (int k = 0; k < 2; ++k) dst[n][k] = *(const LAS bf16x8*)(lds + PG8_SB(b, h) + boff + n * 2048 + k * 1024); } while (0)
#define PG8_MMA(ai, bj, At, Bt) do { __builtin_amdgcn_s_setprio(1); _Pragma("unroll") for (int m = 0; m < 4; ++m) _Pragma("unroll") for (int n = 0; n < 2; ++n) _Pragma("unroll") for (int k = 0; k < 2; ++k) \
        acc[ai][bj][m][n] = __builtin_amdgcn_mfma_f32_16x16x32_bf16(Bt[n][k], At[m][k], acc[ai][bj][m][n], 0, 0, 0); __builtin_amdgcn_s_setprio(0); } while (0)
#define PG8_WAIT_V(n) asm volatile("s_waitcnt vmcnt(" #n ")" ::: "memory")
#define PG8_WAIT_L(n) asm volatile("s_waitcnt lgkmcnt(" #n ")" ::: "memory")
#define PG8_BAR __builtin_amdgcn_s_barrier()
#define PG8_SCHED __builtin_amdgcn_sched_barrier(0)
    Unit cur, nxt; int ui = 0;
    if (!S.next(0, cur)) return;
    f32x4 acc[2][2][4][2];
#pragma unroll
    for (int a = 0; a < 2; ++a)
#pragma unroll
        for (int b = 0; b < 2; ++b)
#pragma unroll
            for (int m = 0; m < 4; ++m)
#pragma unroll
                for (int n = 0; n < 2; ++n) acc[a][b][m][n] = (f32x4){0.f, 0.f, 0.f, 0.f};
    bf16x8 At[4][2], B0[2][2], B1[2][2];
    const char* cA = (const char*)g.A + (size_t)cur.pm * tstep; const char* cB = (const char*)g.Bt + (size_t)cur.pn * tstep;
    PG8_STAGE(PG8_SB(0, 0), cB, voffB); PG8_STAGE(PG8_SB(0, 1), cB + hstep, voffB); PG8_STAGE(PG8_SA(0, 0), cA, voffA); PG8_STAGE(PG8_SA(0, 1), cA + hstep, voffA);
    if (wr == 1) PG8_BAR;
    PG8_WAIT_V(2); PG8_BAR;
    PG8_STAGE(PG8_SB(1, 0), cB + kstep, voffB); PG8_STAGE(PG8_SA(1, 0), cA + kstep, voffA); PG8_STAGE(PG8_SB(1, 1), cB + hstep + kstep, voffB);
    PG8_WAIT_V(6); PG8_BAR;
    for (;;) {
        const bool has_next = S.next(ui + 1, nxt);
        const char* nA = has_next ? (const char*)g.A + (size_t)nxt.pm * tstep : cA; const char* nB = has_next ? (const char*)g.Bt + (size_t)nxt.pn * tstep : cB;
        for (int t = 0; t < nt; t += 2) {
            const bool last = (t == nt - 2);
            const char* a1 = cA + (size_t)(t + 1) * kstep;
            const char* a2 = last ? nA : cA + (size_t)(t + 2) * kstep; const char* b2 = last ? nB : cB + (size_t)(t + 2) * kstep;
            const char* a3 = a2 + kstep; const char* b3 = b2 + kstep;
            if constexpr (Hook::ON) {
                if (t == HK.t0 || t == HK.t1) {
                    const LAS float* Fp = HK.F + (t == HK.t1 ? 256 : 0);
#pragma unroll
                    for (int ai = 0; ai < 2; ++ai)
#pragma unroll
                        for (int m = 0; m < 4; ++m) { const float f = Fp[ai * HALF + wr * 64 + m * 16 + fr];
#pragma unroll
                            for (int bj = 0; bj < 2; ++bj)
#pragma unroll
                                for (int n = 0; n < 2; ++n) acc[ai][bj][m][n] = acc[ai][bj][m][n] * f; }
                }
            }
            PG8_LDB(B0, 0, 0); PG8_LDB(B1, 0, 1); PG8_SCHED; PG8_LDA(At, 0, 0); PG8_STAGE(PG8_SA(1, 1), a1 + hstep, voffA);
            PG8_WAIT_V(8); PG8_WAIT_L(0); PG8_BAR; PG8_MMA(0, 0, At, B0); PG8_MMA(0, 1, At, B1); PG8_BAR; PG8_SCHED;
            PG8_LDA(At, 0, 1); PG8_STAGE(PG8_SB(0, 0), b2, voffB); PG8_STAGE(PG8_SB(0, 1), b2 + hstep, voffB); PG8_STAGE(PG8_SA(0, 0), a2, voffA);
            PG8_WAIT_V(8); PG8_WAIT_L(0); PG8_BAR; PG8_MMA(1, 0, At, B0); PG8_MMA(1, 1, At, B1); PG8_BAR; PG8_SCHED;
            PG8_LDB(B0, 1, 0); PG8_LDB(B1, 1, 1); PG8_SCHED; PG8_LDA(At, 1, 0); PG8_STAGE(PG8_SA(0, 1), a2 + hstep, voffA);
            PG8_WAIT_V(8); PG8_WAIT_L(0); PG8_BAR; PG8_MMA(0, 0, At, B0); PG8_MMA(0, 1, At, B1); PG8_BAR; PG8_SCHED;
            PG8_LDA(At, 1, 1); PG8_STAGE(PG8_SB(1, 0), b3, voffB); PG8_STAGE(PG8_SB(1, 1), b3 + hstep, voffB); PG8_STAGE(PG8_SA(1, 0), a3, voffA);
            PG8_WAIT_V(8); PG8_WAIT_L(0); PG8_BAR; PG8_MMA(1, 0, At, B0); PG8_MMA(1, 1, At, B1); PG8_BAR; PG8_SCHED;
        }
        if constexpr (ALIGN_EPI) { if (wr == 0) PG8_BAR; }
        if constexpr (!Epi::AFTER_DRAIN) { E(acc, cur, wr, wc, fr, fq); }
        if (!has_next) break;
#pragma unroll
        for (int a = 0; a < 2; ++a)
#pragma unroll
            for (int b = 0; b < 2; ++b)
#pragma unroll
                for (int m = 0; m < 4; ++m)
#pragma unroll
                    for (int n = 0; n < 2; ++n) acc[a][b][m][n] = (f32x4){0.f, 0.f, 0.f, 0.f};
        cur = nxt; cA = nA; cB = nB; ++ui;
        if constexpr (ALIGN_EPI) { if (wr == 1) PG8_BAR; }
    }
    PG8_WAIT_V(0);
    if constexpr (!ALIGN_EPI) { if (wr == 0) PG8_BAR; }
    PG8_BAR;
    if constexpr (Epi::AFTER_DRAIN) { E.fused(acc, cur, wr, wc, fr, fq, lds, wid, lane); }
#undef PG8_SA
#undef PG8_SB
#undef PG8_STAGE
#undef PG8_LDA
#undef PG8_LDB
#undef PG8_MMA
#undef PG8_WAIT_V
#undef PG8_WAIT_L
#undef PG8_BAR
#undef PG8_SCHED
}

__device__ __forceinline__ float row_rstd4(const float* ss, int row) {
    const float s = (ss[row] + ss[M + row]) + (ss[2 * M + row] + ss[3 * M + row]);
    return 1.0f / sqrtf(s * (1.0f / D) + EPS);
}

struct EpiSwiglu {
    static constexpr bool AFTER_DRAIN = false;
    bf16* H; const float* ss;
    __device__ __forceinline__ void operator()(const f32x4 (&acc)[2][2][4][2], const Unit& u, int wr, int wc, int fr, int fq) const {
        const int row0 = u.pm * BM + wr * 64 + fr, col0 = u.pn * HALF + wc * 32 + 8 * fq;
        float r8[8];
#pragma unroll
        for (int gi = 0; gi < 8; ++gi) r8[gi] = ss ? row_rstd4(ss, row0 + (gi >> 2) * HALF + (gi & 3) * 16) : 1.0f;
#pragma unroll
        for (int ai = 0; ai < 2; ++ai)
#pragma unroll
            for (int m = 0; m < 4; ++m) { const int row = row0 + ai * HALF + m * 16;
                const float r = r8[ai * 4 + m];
                float h[8];
#pragma unroll
                for (int n = 0; n < 2; ++n)
#pragma unroll
                    for (int j = 0; j < 4; ++j) { const float gv = acc[ai][0][m][n][j] * r, uv = acc[ai][1][m][n][j] * r; h[4 * n + j] = silu_f(gv) * uv; }
                u32x4 w; w.x = cvt_pk_bf16(h[0], h[1]); w.y = cvt_pk_bf16(h[2], h[3]); w.z = cvt_pk_bf16(h[4], h[5]); w.w = cvt_pk_bf16(h[6], h[7]);
                *(u32x4*)(H + (size_t)row * FF + col0) = w; }
    }
};
struct EpiProj {
    static constexpr bool AFTER_DRAIN = false;
    bf16* P; float* DT; const float* ss;
    __device__ __forceinline__ void operator()(const f32x4 (&acc)[2][2][4][2], const Unit& u, int wr, int wc, int fr, int fq) const {
        const int row0 = u.pm * BM + wr * 64 + fr;
        float r8[8];
#pragma unroll
        for (int gi = 0; gi < 8; ++gi) r8[gi] = ss ? row_rstd4(ss, row0 + (gi >> 2) * HALF + (gi & 3) * 16) : 1.0f;
        if (u.pn < 14) {
            const int col0 = u.pn * BM + wc * 32 + 8 * fq;
#pragma unroll
            for (int ai = 0; ai < 2; ++ai)
#pragma unroll
                for (int m = 0; m < 4; ++m) { const int row = row0 + ai * HALF + m * 16; const float r = r8[ai * 4 + m];
#pragma unroll
                    for (int bj = 0; bj < 2; ++bj) { const f32x4 v0 = acc[ai][bj][m][0] * r, v1 = acc[ai][bj][m][1] * r;
                        u32x4 w; w.x = cvtpk_s(v0[0], v0[1]); w.y = cvtpk_s(v0[2], v0[3]); w.z = cvtpk_s(v1[0], v1[1]); w.w = cvtpk_s(v1[2], v1[3]);
                        *(u32x4*)(P + (size_t)row * PROJ_LD + col0 + bj * HALF) = w; } }
        } else if (wc == 0 && fq < 2) {
#pragma unroll
            for (int ai = 0; ai < 2; ++ai)
#pragma unroll
                for (int m = 0; m < 4; ++m) { const int row = row0 + ai * HALF + m * 16; const float r = r8[ai * 4 + m];
                    *(f32x4*)(DT + (size_t)row * 16 + 8 * fq) = acc[ai][0][m][0] * r; *(f32x4*)(DT + (size_t)row * 16 + 8 * fq + 4) = acc[ai][0][m][1] * r; }
        }
    }
};
struct EpiFold {
    static constexpr bool AFTER_DRAIN = false;
    bf16* WO;
    __device__ __forceinline__ void operator()(const f32x4 (&acc)[2][2][4][2], const Unit& u, int wr, int wc, int fr, int fq) const {
        const int g = u.pm >> 2, n0 = (u.pm & 3) * BM + wr * 64 + fr, col0 = 1024 + 256 * g + wc * 32 + 8 * fq;
#pragma unroll
        for (int ai = 0; ai < 2; ++ai)
#pragma unroll
            for (int m = 0; m < 4; ++m) { const int n = n0 + ai * HALF + m * 16;
#pragma unroll
                for (int bj = 0; bj < 2; ++bj) { const f32x4 v0 = acc[ai][bj][m][0], v1 = acc[ai][bj][m][1];
                    u32x4 w; w.x = cvtpk_s(v0[0], v0[1]); w.y = cvtpk_s(v0[2], v0[3]); w.z = cvtpk_s(v1[0], v1[1]); w.w = cvtpk_s(v1[2], v1[3]);
                    *(u32x4*)(WO + (size_t)n * MIXD + col0 + bj * HALF) = w; } }
    }
};
struct EpiRes {
    static constexpr bool AFTER_DRAIN = true;
    const float* base; float* out; bf16* xn; float* ss; float scale;
    __device__ __forceinline__ void fused(const f32x4 (&acc)[2][2][4][2], const Unit& u, int wr, int wc, int fr, int fq, LAS unsigned char* lds, int wid, int lane) const {
        LAS float* Pt = (LAS float*)lds;
        const int row0 = u.pm * BM + wr * 64 + fr, col0 = u.pn * BM + wc * 32 + 8 * fq;
        f32x4 bq[3][4];
#pragma unroll
        for (int pg = 0; pg < 2; ++pg) { const size_t off = (size_t)(row0 + (pg >> 2) * HALF + (pg & 3) * 16) * D + col0;
#pragma unroll
          for (int bj = 0; bj < 2; ++bj) { bq[pg][2 * bj] = *(const f32x4*)(base + off + bj * HALF); bq[pg][2 * bj + 1] = *(const f32x4*)(base + off + bj * HALF + 4); } }
#pragma unroll
        for (int gi = 0; gi < 8; ++gi) { const int ai = gi >> 2, m = gi & 3;
            const int row = row0 + ai * HALF + m * 16; const size_t off = (size_t)row * D + col0; float q = 0.f;
            if (gi < 6) { const int ai2 = (gi + 2) >> 2, m2 = (gi + 2) & 3; const size_t off2 = (size_t)(row0 + ai2 * HALF + m2 * 16) * D + col0;
#pragma unroll
                for (int bj = 0; bj < 2; ++bj) { bq[(gi + 2) % 3][2 * bj] = *(const f32x4*)(base + off2 + bj * HALF); bq[(gi + 2) % 3][2 * bj + 1] = *(const f32x4*)(base + off2 + bj * HALF + 4); } }
            f32x4 bc[4];
#pragma unroll
            for (int k = 0; k < 4; ++k) bc[k] = bq[gi % 3][k];
#pragma unroll
            for (int bj = 0; bj < 2; ++bj) {
                const f32x4 v0 = bc[2 * bj] + acc[ai][bj][m][0] * scale, v1 = bc[2 * bj + 1] + acc[ai][bj][m][1] * scale;
                *(f32x4*)(out + off + bj * HALF) = v0; *(f32x4*)(out + off + bj * HALF + 4) = v1;
                if (xn) { u32x4 w; w.x = cvt_pk_bf16(v0[0], v0[1]); w.y = cvt_pk_bf16(v0[2], v0[3]); w.z = cvt_pk_bf16(v1[0], v1[1]); w.w = cvt_pk_bf16(v1[2], v1[3]);
                    *(u32x4*)(xn + off + bj * HALF) = w; }
                q += (v0[0] * v0[0] + v0[1] * v0[1]) + (v0[2] * v0[2] + v0[3] * v0[3]) + (v1[0] * v1[0] + v1[1] * v1[1]) + (v1[2] * v1[2] + v1[3] * v1[3]); }
            q += __shfl_xor(q, 16); q += __shfl_xor(q, 32);
            if (fq == 0) Pt[(ai * HALF + wr * 64 + m * 16 + fr) * 4 + wc] = q; }
        LDS_WAIT(); __builtin_amdgcn_s_barrier(); asm volatile("" ::: "memory");
        const int t = wid * 64 + lane;
        if (t < 256) { const float s = (Pt[t * 4 + 0] + Pt[t * 4 + 1]) + (Pt[t * 4 + 2] + Pt[t * 4 + 3]); ss[(size_t)u.pn * M + u.pm * BM + t] = s; }
    }
};
struct EpiResNorm {
    static constexpr bool AFTER_DRAIN = true;
    const float* base; float* out; const float* gain; bf16* xn; float* ss; unsigned* cnt; float scale;
    __device__ __forceinline__ void fused(f32x4 (&acc)[2][2][4][2], const Unit& u, int wr, int wc, int fr, int fq, LAS unsigned char* lds, int wid, int lane) const {
        LAS float* Pt = (LAS float*)lds;
        LAS float* Rt = (LAS float*)(lds + 4096);
        const int row0 = u.pm * BM + wr * 64 + fr, col0 = u.pn * BM + wc * 32 + 8 * fq;
        f32x4 bq[3][4];
#pragma unroll
        for (int pg = 0; pg < 2; ++pg) { const size_t off = (size_t)(row0 + (pg >> 2) * HALF + (pg & 3) * 16) * D + col0;
#pragma unroll
          for (int bj = 0; bj < 2; ++bj) { bq[pg][2 * bj] = *(const f32x4*)(base + off + bj * HALF); bq[pg][2 * bj + 1] = *(const f32x4*)(base + off + bj * HALF + 4); } }
#pragma unroll
        for (int gi = 0; gi < 8; ++gi) { const int ai = gi >> 2, m = gi & 3; float q = 0.f;
            if (gi < 6) { const int ai2 = (gi + 2) >> 2, m2 = (gi + 2) & 3; const size_t off2 = (size_t)(row0 + ai2 * HALF + m2 * 16) * D + col0;
#pragma unroll
                for (int bj = 0; bj < 2; ++bj) { bq[(gi + 2) % 3][2 * bj] = *(const f32x4*)(base + off2 + bj * HALF); bq[(gi + 2) % 3][2 * bj + 1] = *(const f32x4*)(base + off2 + bj * HALF + 4); } }
            f32x4 bc[4];
#pragma unroll
            for (int k = 0; k < 4; ++k) bc[k] = bq[gi % 3][k];
#pragma unroll
            for (int bj = 0; bj < 2; ++bj) {
                const f32x4 v0 = bc[2 * bj] + acc[ai][bj][m][0] * scale, v1 = bc[2 * bj + 1] + acc[ai][bj][m][1] * scale;
                acc[ai][bj][m][0] = v0; acc[ai][bj][m][1] = v1;
                if (xn) { const size_t offo = (size_t)(row0 + ai * HALF + m * 16) * D + col0 + bj * HALF; *(f32x4*)(out + offo) = v0; *(f32x4*)(out + offo + 4) = v1; }
                q += (v0[0] * v0[0] + v0[1] * v0[1]) + (v0[2] * v0[2] + v0[3] * v0[3]) + (v1[0] * v1[0] + v1[1] * v1[1]) + (v1[2] * v1[2] + v1[3] * v1[3]); }
            q += __shfl_xor(q, 16); q += __shfl_xor(q, 32);
            if (fq == 0) Pt[(ai * HALF + wr * 64 + m * 16 + fr) * 4 + wc] = q; }
        LDS_WAIT(); __builtin_amdgcn_s_barrier(); asm volatile("" ::: "memory");
        const int t = wid * 64 + lane;
        if (t < 256) { const float sp = (Pt[t * 4 + 0] + Pt[t * 4 + 1]) + (Pt[t * 4 + 2] + Pt[t * 4 + 3]);
            __hip_atomic_store(ss + (size_t)u.pn * M + u.pm * BM + t, sp, __ATOMIC_RELAXED, __HIP_MEMORY_SCOPE_AGENT); }
        asm volatile("s_waitcnt vmcnt(0)" ::: "memory");
        if (t < 256 && lane == 0) __hip_atomic_fetch_add(cnt + 16 * u.pm, 1u, __ATOMIC_RELAXED, __HIP_MEMORY_SCOPE_AGENT);
        if (wid == 0) {
            unsigned sp_ = 0;
            while ((unsigned)__builtin_amdgcn_readfirstlane(__hip_atomic_load(cnt + 16 * u.pm, __ATOMIC_RELAXED, __HIP_MEMORY_SCOPE_AGENT)) < 16u) { __builtin_amdgcn_s_sleep(1); if (++sp_ > (1u << 22)) break; }
            __builtin_amdgcn_fence(__ATOMIC_ACQUIRE, "agent");
        }
        asm volatile("s_waitcnt vmcnt(0) lgkmcnt(0)" ::: "memory"); __builtin_amdgcn_s_barrier(); asm volatile("" ::: "memory");
        if (t < 256) { float s4 = 0.f;
#pragma unroll
            for (int p = 0; p < 4; ++p) s4 += __hip_atomic_load(ss + (size_t)p * M + u.pm * BM + t, __ATOMIC_RELAXED, __HIP_MEMORY_SCOPE_AGENT);
            Rt[t] = 1.0f / sqrtf(s4 * (1.0f / D) + EPS); }
        f32x4 gv[4];
#pragma unroll
        for (int k = 0; k < 4; ++k) gv[k] = (f32x4){1.f, 1.f, 1.f, 1.f};
        if (!xn) {
#pragma unroll
            for (int bj = 0; bj < 2; ++bj) { gv[2 * bj] = *(const f32x4*)(gain + col0 + bj * HALF); gv[2 * bj + 1] = *(const f32x4*)(gain + col0 + bj * HALF + 4); } }
        LDS_WAIT(); __builtin_amdgcn_s_barrier(); asm volatile("" ::: "memory");
#pragma unroll
        for (int gi = 0; gi < 8; ++gi) { const int ai = gi >> 2, m = gi & 3; const int rl = ai * HALF + wr * 64 + m * 16 + fr; const float r = Rt[rl];
            const size_t off = (size_t)(u.pm * BM + rl) * D + col0;
#pragma unroll
            for (int bj = 0; bj < 2; ++bj) { const f32x4 o0 = acc[ai][bj][m][0] * r * gv[2 * bj], o1 = acc[ai][bj][m][1] * r * gv[2 * bj + 1];
                if (xn) { u32x4 w; w.x = cvt_pk_bf16(o0[0], o0[1]); w.y = cvt_pk_bf16(o0[2], o0[3]); w.z = cvt_pk_bf16(o1[0], o1[1]); w.w = cvt_pk_bf16(o1[2], o1[3]); *(u32x4*)(xn + off + bj * HALF) = w; }
                else { *(f32x4*)(out + off + bj * HALF) = o0; *(f32x4*)(out + off + bj * HALF + 4) = o1; } } }
    }
};
template <bool BASE_BF16, bool FINAL>
struct EpiResX {
    static constexpr bool AFTER_DRAIN = true;
    const float* base; const bf16* bbn; const float* brs; float* out; const float* gain; bf16* xn; float* rs_out; float* ss; unsigned* cnt; float scale; const float* cgain;
    __device__ __forceinline__ void fused(f32x4 (&acc)[2][2][4][2], const Unit& u, int wr, int wc, int fr, int fq, LAS unsigned char* lds, int wid, int lane) const {
        LAS float* Pt = (LAS float*)lds;
        LAS float* Rt = (LAS float*)(lds + 4096);
        const int row0 = u.pm * BM + wr * 64 + fr, col0 = u.pn * BM + wc * 32 + 8 * fq;
        float inv8[8];
#pragma unroll
        for (int gi = 0; gi < 8; ++gi) inv8[gi] = BASE_BF16 ? brs[row0 + (gi >> 2) * HALF + (gi & 3) * 16] : 1.0f;
        f32x4 ci[4];
#pragma unroll
        for (int k = 0; k < 4; ++k) ci[k] = (f32x4){1.f, 1.f, 1.f, 1.f};
        if (BASE_BF16 && cgain) {
#pragma unroll
            for (int k = 0; k < 4; ++k) { const f32x4 gq = *(const f32x4*)(cgain + col0 + (k >> 1) * HALF + (k & 1) * 4); ci[k] = (f32x4){1.0f / gq[0], 1.0f / gq[1], 1.0f / gq[2], 1.0f / gq[3]}; } }
        f32x4 bq[3][4]; u32x4 bqb[3][2];
#define ERX_LOAD(slot, g_) do { const size_t off_ = (size_t)(row0 + ((g_) >> 2) * HALF + ((g_) & 3) * 16) * D + col0; \
            if constexpr (BASE_BF16) { bqb[slot][0] = *(const u32x4*)(bbn + off_); bqb[slot][1] = *(const u32x4*)(bbn + off_ + HALF); } \
            else { _Pragma("unroll") for (int bj_ = 0; bj_ < 2; ++bj_) { bq[slot][2 * bj_] = *(const f32x4*)(base + off_ + bj_ * HALF); bq[slot][2 * bj_ + 1] = *(const f32x4*)(base + off_ + bj_ * HALF + 4); } } } while (0)
        ERX_LOAD(0, 0); ERX_LOAD(1, 1);
#pragma unroll
        for (int gi = 0; gi < 8; ++gi) { const int ai = gi >> 2, m = gi & 3; float q = 0.f;
            if (gi < 6) ERX_LOAD((gi + 2) % 3, gi + 2);
            f32x4 bc[4];
            if constexpr (BASE_BF16) { const float iv = inv8[gi];
#pragma unroll
                for (int bj = 0; bj < 2; ++bj) { const u32x4 w = bqb[gi % 3][bj];
                    bc[2 * bj] = (f32x4){bflo(w.x), bfhi(w.x), bflo(w.y), bfhi(w.y)} * iv * ci[2 * bj]; bc[2 * bj + 1] = (f32x4){bflo(w.z), bfhi(w.z), bflo(w.w), bfhi(w.w)} * iv * ci[2 * bj + 1]; }
            } else {
#pragma unroll
                for (int k = 0; k < 4; ++k) bc[k] = bq[gi % 3][k]; }
#pragma unroll
            for (int bj = 0; bj < 2; ++bj) {
                const f32x4 v0 = bc[2 * bj] + acc[ai][bj][m][0] * scale, v1 = bc[2 * bj + 1] + acc[ai][bj][m][1] * scale;
                acc[ai][bj][m][0] = v0; acc[ai][bj][m][1] = v1;
                q += (v0[0] * v0[0] + v0[1] * v0[1]) + (v0[2] * v0[2] + v0[3] * v0[3]) + (v1[0] * v1[0] + v1[1] * v1[1]) + (v1[2] * v1[2] + v1[3] * v1[3]); }
            q += __shfl_xor(q, 16); q += __shfl_xor(q, 32);
            if (fq == 0) Pt[(ai * HALF + wr * 64 + m * 16 + fr) * 4 + wc] = q; }
#undef ERX_LOAD
        LDS_WAIT(); __builtin_amdgcn_s_barrier(); asm volatile("" ::: "memory");
        const int t = wid * 64 + lane;
        if (t < 256) { const float sp = (Pt[t * 4 + 0] + Pt[t * 4 + 1]) + (Pt[t * 4 + 2] + Pt[t * 4 + 3]);
            __hip_atomic_store(ss + (size_t)u.pn * M + u.pm * BM + t, sp, __ATOMIC_RELAXED, __HIP_MEMORY_SCOPE_AGENT); }
        asm volatile("s_waitcnt vmcnt(0)" ::: "memory");
        if (t < 256 && lane == 0) __hip_atomic_fetch_add(cnt + 16 * u.pm, 1u, __ATOMIC_RELAXED, __HIP_MEMORY_SCOPE_AGENT);
        if (wid == 0) {
            unsigned sp_ = 0;
            while ((unsigned)__builtin_amdgcn_readfirstlane(__hip_atomic_load(cnt + 16 * u.pm, __ATOMIC_RELAXED, __HIP_MEMORY_SCOPE_AGENT)) < 16u) { __builtin_amdgcn_s_sleep(1); if (++sp_ > (1u << 22)) break; }
            __builtin_amdgcn_fence(__ATOMIC_ACQUIRE, "agent");
        }
        asm volatile("s_waitcnt vmcnt(0) lgkmcnt(0)" ::: "memory"); __builtin_amdgcn_s_barrier(); asm volatile("" ::: "memory");
        if (t < 256) { float s4 = 0.f;
#pragma unroll
            for (int p = 0; p < 4; ++p) s4 += __hip_atomic_load(ss + (size_t)p * M + u.pm * BM + t, __ATOMIC_RELAXED, __HIP_MEMORY_SCOPE_AGENT);
            const float ms = s4 * (1.0f / D) + EPS, sq = sqrtf(ms);
            Rt[t] = 1.0f / sq;
            if (!FINAL && u.pn == 0) rs_out[u.pm * BM + t] = sq; }
        f32x4 gv[4];
#pragma unroll
        for (int k = 0; k < 4; ++k) gv[k] = (f32x4){1.f, 1.f, 1.f, 1.f};
        if constexpr (FINAL) {
#pragma unroll
            for (int bj = 0; bj < 2; ++bj) { gv[2 * bj] = *(const f32x4*)(gain + col0 + bj * HALF); gv[2 * bj + 1] = *(const f32x4*)(gain + col0 + bj * HALF + 4); } }
        LDS_WAIT(); __builtin_amdgcn_s_barrier(); asm volatile("" ::: "memory");
#pragma unroll
        for (int gi = 0; gi < 8; ++gi) { const int ai = gi >> 2, m = gi & 3; const int rl = ai * HALF + wr * 64 + m * 16 + fr; const float r = Rt[rl];
            const size_t off = (size_t)(u.pm * BM + rl) * D + col0;
#pragma unroll
            for (int bj = 0; bj < 2; ++bj) { const f32x4 o0 = acc[ai][bj][m][0] * r * gv[2 * bj], o1 = acc[ai][bj][m][1] * r * gv[2 * bj + 1];
                if constexpr (!FINAL) { u32x4 w; w.x = cvt_pk_bf16(o0[0], o0[1]); w.y = cvt_pk_bf16(o0[2], o0[3]); w.z = cvt_pk_bf16(o1[0], o1[1]); w.w = cvt_pk_bf16(o1[2], o1[3]); *(u32x4*)(xn + off + bj * HALF) = w; }
                else { *(f32x4*)(out + off + bj * HALF) = o0; *(f32x4*)(out + off + bj * HALF + 4) = o1; } } }
    }
};
}

#define XB_TMO      128
#define XB_XCNT(j)  (256  + 64 * (j))
#define XB_XSUB(j)  (1280 + 64 * (j))
#define XB_XGEN(j)  (2304 + 64 * (j))
#define XB_TOP      3328
#define XB_TOPGEN   3392
#define XCD_BAR_WORDS 3456
#define XB_SPIN_CAP (1u << 18)
__device__ __forceinline__ unsigned xb_ld(unsigned* p)              { return __hip_atomic_load(p, __ATOMIC_RELAXED, __HIP_MEMORY_SCOPE_AGENT); }
__device__ __forceinline__ unsigned xb_add(unsigned* p, unsigned v) { return __hip_atomic_fetch_add(p, v, __ATOMIC_RELAXED, __HIP_MEMORY_SCOPE_AGENT); }
__device__ __forceinline__ unsigned xb_xcc_id() { return (unsigned)__builtin_amdgcn_s_getreg((3 << 11) | 20) & 0xFu; }
#define XB_SPIN(cond, bar) do { unsigned _sp = 0; while (cond) { __builtin_amdgcn_s_sleep(1); \
    if ((++_sp & 255u) == 0u) { if (xb_ld(&(bar)[XB_TMO])) break; if (_sp > XB_SPIN_CAP) { atomicAdd(&(bar)[XB_TMO], 1u); break; } } } } while (0)
struct XcdBarrier { unsigned* bar; unsigned x; volatile LAS unsigned* st; };
__device__ __forceinline__ XcdBarrier xcd_barrier_post(unsigned* bar, volatile LAS unsigned* st) {
    XcdBarrier b; b.bar = bar; b.x = xb_xcc_id(); b.st = st;
    if (threadIdx.x == 0) (void)xb_add(&bar[XB_XCNT(b.x)], 1u);
    return b;
}
__device__ __forceinline__ void xcd_barrier_complete(unsigned* bar, unsigned x, unsigned& nloc, unsigned& nx) {
    const unsigned G = gridDim.x * gridDim.y * gridDim.z;
    unsigned sum, cnt, mine, sp = 0u;
    for (;;) {
        sum = 0u; cnt = 0u; mine = 0u;
#pragma unroll
        for (unsigned j = 0; j < 16; ++j) { const unsigned c = xb_ld(&bar[XB_XCNT(j)]); sum += c; cnt += (c > 0u) ? 1u : 0u; mine = (j == x) ? c : mine; }
        if (sum == G) break;
        __builtin_amdgcn_s_sleep(1);
        if ((++sp & 255u) == 0u) { if (xb_ld(&bar[XB_TMO])) break; if (sp > XB_SPIN_CAP) { atomicAdd(&bar[XB_TMO], 1u); break; } }
    }
    nloc = mine > 0u ? mine : 1u; nx = cnt > 0u ? cnt : 1u;
}
__device__ __forceinline__ void xcd_barrier(const XcdBarrier& b) {
    asm volatile("s_waitcnt vmcnt(0)" ::: "memory");
    __syncthreads();
    if (threadIdx.x == 0) {
        unsigned* bar = b.bar;
        __builtin_amdgcn_s_waitcnt(0);
        unsigned nloc = b.st[0], nx = b.st[1];
        if (nloc == 0u) { xcd_barrier_complete(bar, b.x, nloc, nx); b.st[0] = nloc; b.st[1] = nx; }
        const unsigned old = xb_add(&bar[XB_XSUB(b.x)], 1u);
        const unsigned gen = old / nloc;
        if (old + 1u == (gen + 1u) * nloc) {
            __builtin_amdgcn_fence(__ATOMIC_RELEASE, "agent");
            asm volatile("s_waitcnt vmcnt(0)" ::: "memory");
            const unsigned og = xb_add(&bar[XB_TOP], 1u);
            const unsigned tg = og / nx;
            if (og + 1u == (tg + 1u) * nx) xb_add(&bar[XB_TOPGEN], 1u);
            else XB_SPIN(xb_ld(&bar[XB_TOPGEN]) == tg, bar);
            __builtin_amdgcn_fence(__ATOMIC_ACQUIRE, "agent");
            xb_add(&bar[XB_XGEN(b.x)], 1u);
            asm volatile("s_waitcnt vmcnt(0)" ::: "memory");
        } else {
            XB_SPIN(xb_ld(&bar[XB_XGEN(b.x)]) == gen, bar);
            __builtin_amdgcn_fence(__ATOMIC_ACQUIRE, "agent");
            asm volatile("s_waitcnt vmcnt(0)" ::: "memory");
        }
    }
    __syncthreads();
}

__device__ __forceinline__ void p0_transpose_item(const float* W, int ldw, int k0, int nsrc0, int nvalid, const float* kscale, bf16* WT, int ldk, int ndst0, LAS float* scr, int lane) {
    const int n4 = (lane & 7) * 4;
    const int n4c = n4 < nvalid ? n4 : 0;
    f32x4 tv[8]; float ksv[8];
#pragma unroll
    for (int i = 0; i < 8; ++i) { const int kk = 8 * i + (lane >> 3); tv[i] = *(const f32x4*)(W + (size_t)(k0 + kk) * ldw + nsrc0 + n4c); }
    if (kscale) {
#pragma unroll
        for (int i = 0; i < 8; ++i) ksv[i] = kscale[k0 + 8 * i + (lane >> 3)];
#pragma unroll
        for (int i = 0; i < 8; ++i) tv[i] = tv[i] * ksv[i]; }
#pragma unroll
    for (int i = 0; i < 8; ++i) { const int kk = 8 * i + (lane >> 3);
        scr[kk * 33 + n4] = tv[i].x; scr[kk * 33 + n4 + 1] = tv[i].y; scr[kk * 33 + n4 + 2] = tv[i].z; scr[kk * 33 + n4 + 3] = tv[i].w; }
    LDS_WAIT(); asm volatile("" ::: "memory");
    const int c = lane & 7;
#pragma unroll
    for (int j = 0; j < 4; ++j) { const int n = (lane >> 3) + 8 * j; const LAS float* s = scr + (8 * c) * 33 + n;
        u32x4 o; o.x = pk2(s[0 * 33], s[1 * 33]); o.y = pk2(s[2 * 33], s[3 * 33]); o.z = pk2(s[4 * 33], s[5 * 33]); o.w = pk2(s[6 * 33], s[7 * 33]);
        if (n < nvalid) *(u32x4*)(WT + (size_t)(ndst0 + n) * ldk + k0 + 8 * c) = o; }
    LDS_WAIT(); asm volatile("" ::: "memory");
}

struct Args { const float* in[21]; float* out; unsigned char* ws; int ph_lo, ph_hi; };

template <int PART>
__device__ __forceinline__ void p0_prologue(const Args& a, LAS unsigned char* lds, int gw, int NGW, int wave, int lane) {
    LAS float* scr = (LAS float*)(lds + wave * 16384);
    unsigned char* ws = a.ws;
    bf16 *GU1 = (bf16*)(ws + WS_GU1), *D1 = (bf16*)(ws + WS_D1), *GU2 = (bf16*)(ws + WS_GU2), *D2 = (bf16*)(ws + WS_D2), *WIN = (bf16*)(ws + WS_WIN), *WOUT = (bf16*)(ws + WS_WOUT), *XN = (bf16*)(ws + WS_XN);
    if constexpr (PART == 0) {
        const float* gain = a.in[1];
        f32x4 gv[4];
#pragma unroll
        for (int j = 0; j < 4; ++j) gv[j] = *((const f32x4*)gain + lane + 64 * j);
        for (int m = gw; m < M; m += 4 * NGW) {
            f32x4 v[4][4];
#pragma unroll
            for (int q = 0; q < 4; ++q) { const int mm = m + q * NGW; const f32x4* xr = (const f32x4*)(a.in[0] + (size_t)(mm < M ? mm : m) * D) + lane;
#pragma unroll
                for (int j = 0; j < 4; ++j) v[q][j] = xr[64 * j]; }
#pragma unroll
            for (int q = 0; q < 4; ++q) { const int mm = m + q * NGW; float s = 0.f;
#pragma unroll
                for (int j = 0; j < 4; ++j) s += (v[q][j].x * v[q][j].x + v[q][j].y * v[q][j].y) + (v[q][j].z * v[q][j].z + v[q][j].w * v[q][j].w);
                const float sq0 = sqrtf(wave_sum(s) * (1.0f / D) + EPS), r = 1.0f / sq0;
                if (mm < M && lane == 0) ((float*)(ws + WS_RS0))[mm] = sq0;
                if (mm < M) { u32x2* o8 = (u32x2*)(XN + (size_t)mm * D) + lane;
#pragma unroll
                    for (int j = 0; j < 4; ++j) { u32x2 w; w.x = pk2(v[q][j].x * r * gv[j].x, v[q][j].y * r * gv[j].y); w.y = pk2(v[q][j].z * r * gv[j].z, v[q][j].w * r * gv[j].w); o8[64 * j] = w; } } }
        }
    }
    constexpr int I_GU = 16 * 88, I_DN = 44 * 32, I_IN = 16 * 113, I_OUT = 16 * 32;
    if constexpr (PART == 0) {
    for (int it = gw; it < 4 * I_GU; it += NGW) {
        int r = it; const int which = r / I_GU; r -= which * I_GU; const int kb = r / 88, nb = r % 88, j0 = 32 * nb;
        const float* W = a.in[which == 0 ? 2 : which == 1 ? 3 : which == 2 ? 17 : 18];
        const float* ks = which >= 2 ? a.in[16] : nullptr;
        bf16* WT = which >= 2 ? GU2 : GU1;
        p0_transpose_item(W, FF, 64 * kb, j0, 32, ks, WT, D, 256 * (j0 >> 7) + (j0 & 127) + 128 * (which & 1), scr, lane); }
    }
    if constexpr (PART == 1 || PART == 2) {
    for (int it = gw; it < I_DN; it += NGW) { const int kb = it / 32, nb = it % 32;
        p0_transpose_item(a.in[PART == 2 ? 19 : 4], D, 64 * kb, 32 * nb, 32, nullptr, PART == 2 ? D2 : D1, FF, 32 * nb, scr, lane); }
    }
    if constexpr (PART == 1) {
    for (int it = gw; it < I_IN + I_OUT; it += NGW) {
        int r = it;
        if (r < I_IN) { const int kb = r / 113, db = r % 113;
            const int nd = 32 * db, nsrc = db < 80 ? nd : (db < 112 ? nd + 16 : 2560), nv = db < 112 ? 32 : 16;
            p0_transpose_item(a.in[6], 3600, 64 * kb, nsrc, nv, a.in[5], WIN, D, nd, scr, lane); continue; }
        r -= I_IN;
        { const int kb = r / 32, nb = r % 32;
            p0_transpose_item(a.in[15], D, 64 * kb, 32 * nb, 32, a.in[12], WOUT, MIXD, 32 * nb, scr, lane); }
    }
    for (int it = gw; it < 16 * 32; it += NGW) { const int kb = it / 32, nb = it % 32;
        p0_transpose_item(a.in[15] + (size_t)1024 * D, D, 64 * kb, 32 * nb, 32, nullptr, (bf16*)(ws + WS_FA) + (size_t)(kb >> 2) * 1024 * 256 - (size_t)(kb >> 2) * 256, 256, 32 * nb, scr, lane); }
    { bf16* FB = (bf16*)(ws + WS_FB);
      for (int i = gw * 64 + lane; i < 4 * 256 * 256 / 4; i += NGW * 64) { const int e0 = 4 * i, g = e0 >> 16, d = e0 & 255;
          const f32x4 w = *(const f32x4*)(a.in[13] + e0), sc = *(const f32x4*)(a.in[14] + 256 * g + d);
          *(u32x2*)(FB + e0) = (u32x2){pk2(w.x * sc.x, w.y * sc.y), pk2(w.z * sc.z, w.w * sc.w)}; } }
    }
}

constexpr int SB_CC = 0, SB_BC = 17408, SB_XT = 34816, SB_XD = 39424, SB_VEC = 44032, SB_STRIDE = 45056;
constexpr int SL_MM = 90112, SL_SL = 99328, SL_END = 108032;
constexpr int P272 = 272, P144 = 144;
typedef short v4i16_t __attribute__((ext_vector_type(4)));

__device__ __forceinline__ void unpack8(const u32x4 r, float (&f)[8]) { f[0] = bflo(r.x); f[1] = bfhi(r.x); f[2] = bflo(r.y); f[3] = bfhi(r.y); f[4] = bflo(r.z); f[5] = bfhi(r.z); f[6] = bflo(r.w); f[7] = bfhi(r.w); }

__device__ __forceinline__ void conv8x4(const bf16* PROJ, size_t tok0, int tseq, int col, const float* conv_w, const float* conv_b, bf16* dst, int pitch) {
    float wbc[4][8], bbc[8];
#pragma unroll
    for (int k = 0; k < 4; ++k) { const f32x4 w0 = *(const f32x4*)(conv_w + k * CONV_DIM + col - 1024), w1 = *(const f32x4*)(conv_w + k * CONV_DIM + col - 1024 + 4);
#pragma unroll
        for (int e = 0; e < 4; ++e) { wbc[k][e] = w0[e]; wbc[k][4 + e] = w1[e]; } }
    { const f32x4 w0 = *(const f32x4*)(conv_b + col - 1024), w1 = *(const f32x4*)(conv_b + col - 1024 + 4);
#pragma unroll
        for (int e = 0; e < 4; ++e) { bbc[e] = w0[e]; bbc[4 + e] = w1[e]; } }
    u32x4 rbc[7];
#pragma unroll
    for (int i = 0; i < 7; ++i) { rbc[i] = (u32x4){0u, 0u, 0u, 0u}; if (tseq - 3 + i >= 0) rbc[i] = *(const u32x4*)(PROJ + (tok0 + tseq - 3 + i) * PROJ_LD + col); }
    float ob[4][8];
#pragma unroll
    for (int j = 0; j < 4; ++j)
#pragma unroll
        for (int e = 0; e < 8; ++e) ob[j][e] = bbc[e];
#pragma unroll
    for (int i = 0; i < 7; ++i) { float f[8]; unpack8(rbc[i], f);
#pragma unroll
        for (int j = 0; j < 4; ++j) { const int k = i - j; if (k >= 0 && k < 4) {
#pragma unroll
            for (int e = 0; e < 8; ++e) ob[j][e] += wbc[k][e] * f[e]; } } }
#pragma unroll
    for (int j = 0; j < 4; ++j) {
#pragma unroll
        for (int e = 0; e < 8; ++e) ob[j][e] = silu_f(ob[j][e]);
        u32x4 w; w.x = cvt_pk_bf16(ob[j][0], ob[j][1]); w.y = cvt_pk_bf16(ob[j][2], ob[j][3]); w.z = cvt_pk_bf16(ob[j][4], ob[j][5]); w.w = cvt_pk_bf16(ob[j][6], ob[j][7]);
        *(u32x4*)(dst + (size_t)j * pitch) = w; }
}

__device__ __forceinline__ void conv_phase(const Args& a, int G) {
    const int tid = threadIdx.x, lane = tid & 63, wave = __builtin_amdgcn_readfirstlane(tid >> 6);
    const bf16* PROJ = (const bf16*)(a.ws + WS_PROJ);
    bf16* BCG = (bf16*)a.out;
    bf16* MIX = (bf16*)(a.ws + WS_MIX);
    const float* DT = (const float*)(a.ws + WS_DT);
    float* DTV = (float*)(a.ws + WS_DTV); float* CSV = (float*)(a.ws + WS_CSV);
    const float* conv_w = a.in[7]; const float* conv_b = a.in[8];
    for (int unit = blockIdx.x; unit < 512; unit += G) {
        const int b = unit >> 6, c = (unit >> 1) & 31, g = unit & 1;
        const size_t tok0 = (size_t)b * SEQ;
        { const int cg = tid & 31, tl = tid >> 5;
          conv8x4(PROJ, tok0, c * 64 + 4 * tl, B_OFF + (cg >> 4) * 256 + g * 128 + 8 * (cg & 15), conv_w, conv_b, BCG + (size_t)unit * 16384 + (4 * tl) * 256 + 8 * cg, 256); }
#pragma unroll 1
        for (int pass = 0; pass < 2; ++pass) { const int cgx = tid & 63, tlx = (tid >> 6) + 8 * pass; const int ch = g * 512 + 8 * cgx;
          conv8x4(PROJ, tok0, c * 64 + 4 * tlx, XS_OFF + ch, conv_w, conv_b, MIX + (tok0 + c * 64 + 4 * tlx) * MIXD + ch, MIXD); }
        { const int h = 8 * g + wave; const size_t tok = tok0 + c * 64 + lane;
          const float xdt = DT[tok * 16 + h] + a.in[9][h];
          const float dtv = xdt > 20.f ? xdt : log1pf(expf(xdt));
          float cs = dtv * (-expf(a.in[10][h]));
#pragma unroll
          for (int o = 1; o < 64; o <<= 1) { const float t = __shfl_up(cs, o); if (lane >= o) cs += t; }
          DTV[tok * 16 + h] = dtv; CSV[tok * 16 + h] = cs; }
    }
}

__device__ __forceinline__ void ssd_phase(LAS unsigned char* lds, const Args& a, int G) {
    const int tid = threadIdx.x, lane = tid & 63, wave = __builtin_amdgcn_readfirstlane(tid >> 6);
    const int l16 = lane & 15, quad = lane >> 4;
    const bf16* PROJ = (const bf16*)(a.ws + WS_PROJ);
    const bf16* BCG = (const bf16*)a.out;
    const float* DTV = (const float*)(a.ws + WS_DTV); const float* CSV = (const float*)(a.ws + WS_CSV);
    bf16* MIX = (bf16*)(a.ws + WS_MIX);
    float* PSS = (float*)(a.ws + WS_PSS);
    for (int item = blockIdx.x; item < 256; item += G) {
        const int b = item >> 5, h = (item >> 1) & 15, ph = item & 1, g = h >> 3;
        const float Dh = a.in[11][h];
        const int xtok = tid >> 3, xc4 = tid & 7;
        const int x_ch = h * 64 + ph * 32 + 4 * xc4;
        f32x4 accS[2]; accS[0] = (f32x4){0.f, 0.f, 0.f, 0.f}; accS[1] = accS[0];
        for (int i = tid; i < (SL_END - SL_SL) / 4; i += NTHR) ((LAS unsigned*)(lds + SL_SL))[i] = 0u;
        const size_t tok0 = (size_t)b * SEQ;
        const int ti = wave >> 1, q = wave & 1;
        const int pcol = h * 64 + ph * 32 + 16 * q + 4 * quad;
        u32x4 rbA[2][4]; u32x2 xrA[2]; float dtvA[2], csA[2]; u32x2 zrA[2];
#define SSD_LOAD_RAW(c, S) do { const bf16* ub = BCG + ((size_t)(b * 32 + (c)) * 2 + g) * 16384; \
            _Pragma("unroll") for (int k = 0; k < 4; ++k) rbA[S][k] = *(const u32x4*)(ub + (size_t)(tid + 512 * k) * 8); \
            xrA[S] = *(const u32x2*)(MIX + (tok0 + (size_t)(c) * 64 + xtok) * MIXD + x_ch); \
            dtvA[S] = DTV[(tok0 + (c) * 64 + lane) * 16 + h]; csA[S] = CSV[(tok0 + (c) * 64 + lane) * 16 + h]; \
            zrA[S] = *(const u32x2*)(PROJ + (tok0 + (size_t)(c) * 64 + 16 * ti + l16) * PROJ_LD + Z_OFF + pcol); } while (0)
        SSD_LOAD_RAW(0, 0); SSD_LOAD_RAW(1, 1);
#pragma unroll 2
        for (int c = 0; c < 32; ++c) {
            const int S = c & 1;
            const float dtv = dtvA[S], cs = csA[S]; const u32x2 xr = xrA[S];
            LAS unsigned char* sb = lds + (c & 1) * SB_STRIDE;
            const float cs63 = __shfl(cs, 63);
#pragma unroll
            for (int k = 0; k < 4; ++k) { const int pp = tid + 512 * k, row = pp >> 5, c16 = pp & 31;
                *(LAS u32x4*)(sb + (c16 < 16 ? SB_BC : SB_CC) + row * P272 + 16 * (c16 & 15)) = rbA[S][k]; }
            {
                const float sd = __shfl(dtv, xtok & 63) * __expf(cs63 - __shfl(cs, xtok & 63));
                const float f[4] = {bflo(xr.x), bfhi(xr.x), bflo(xr.y), bfhi(xr.y)};
                const unsigned xb[4] = {xr.x & 0xffffu, xr.x >> 16, xr.y & 0xffffu, xr.y >> 16};
#pragma unroll
                for (int e = 0; e < 4; ++e) {
                    *(LAS unsigned short*)(sb + SB_XT + (4 * xc4 + e) * P144 + 2 * xtok) = (unsigned short)xb[e];
                    *(LAS unsigned short*)(sb + SB_XD + (4 * xc4 + e) * P144 + 2 * xtok) = (unsigned short)f2bf(f[e] * sd); }
            }
            if (wave == 0) { ((LAS float*)(sb + SB_VEC))[lane] = cs; ((LAS float*)(sb + SB_VEC))[64 + lane] = dtv; }
            const float dec = __expf(cs63);
            LDS_WAIT(); __builtin_amdgcn_s_barrier(); asm volatile("" ::: "memory");
            const size_t otok = tok0 + (size_t)c * 64 + 16 * ti + l16;
            const float zv[4] = {bflo(zrA[S].x), bfhi(zrA[S].x), bflo(zrA[S].y), bfhi(zrA[S].y)};
            if (c + 2 < 32) SSD_LOAD_RAW(c + 2, S);
            const float cs_l = ((const LAS float*)(sb + SB_VEC))[16 * ti + l16];
            bf16x8 Cf[4];
#pragma unroll
            for (int k = 0; k < 4; ++k) Cf[k] = *(const LAS bf16x8*)(sb + SB_CC + (16 * ti + l16) * P272 + (32 * k + 8 * quad) * 2);
#pragma unroll
            for (int jj = 0; jj < 2; ++jj) {
                const int j = 2 * q + jj;
                if (j <= ti) {
                    f32x4 gacc = (f32x4){0.f, 0.f, 0.f, 0.f};
#pragma unroll
                    for (int k = 0; k < 4; ++k) {
                        const bf16x8 Aop = *(const LAS bf16x8*)(sb + SB_BC + (16 * j + l16) * P272 + (32 * k + 8 * quad) * 2);
                        gacc = __builtin_amdgcn_mfma_f32_16x16x32_bf16(Aop, Cf[k], gacc, 0, 0, 0); }
                    const f32x4 cs_s = *(const LAS f32x4*)(sb + SB_VEC + (16 * j + 4 * quad) * 4), dt_s = *(const LAS f32x4*)(sb + SB_VEC + 256 + (16 * j + 4 * quad) * 4);
                    float mv[4];
#pragma unroll
                    for (int r = 0; r < 4; ++r) { const int s_ = 16 * j + 4 * quad + r, l = 16 * ti + l16;
                        float v = gacc[r] * __expf(fminf(cs_l - cs_s[r], 0.f)) * dt_s[r];
                        v = (s_ <= l) ? v : 0.f; if (s_ == l) v += Dh; mv[r] = v; }
                    *(LAS u32x2*)(lds + SL_MM + (16 * ti + l16) * P144 + (16 * j + 4 * quad) * 2) = (u32x2){cvt_pk_bf16(mv[0], mv[1]), cvt_pk_bf16(mv[2], mv[3])};
                } else if ((j >> 1) <= (ti >> 1)) {
                    *(LAS u32x2*)(lds + SL_MM + (16 * ti + l16) * P144 + (16 * j + 4 * quad) * 2) = (u32x2){0u, 0u};
                }
            }
            f32x4 y = (f32x4){0.f, 0.f, 0.f, 0.f};
#pragma unroll
            for (int k = 0; k < 4; ++k) {
                const bf16x8 Aop = *(const LAS bf16x8*)(lds + SL_SL + (16 * q + l16) * P272 + (32 * k + 8 * quad) * 2);
                y = __builtin_amdgcn_mfma_f32_16x16x32_bf16(Aop, Cf[k], y, 0, 0, 0); }
            y = y * __expf(cs_l);
#pragma unroll
            for (int t = 0; t < 2; ++t) { const int jn = 2 * ti + t;
                accS[t] = accS[t] * dec;
#pragma unroll
                for (int kk = 0; kk < 2; ++kk) {
                    LAS unsigned char* tp = sb + SB_BC + (32 * kk + 8 * quad + (l16 >> 2)) * P272 + (16 * jn + 4 * (lane & 3)) * 2;
                    const v4i16_t lo = __builtin_amdgcn_ds_read_tr16_b64_v4i16((LAS v4i16_t*)tp), hi = __builtin_amdgcn_ds_read_tr16_b64_v4i16((LAS v4i16_t*)(tp + 4 * P272));
                    const bf16x8 Aop = __builtin_shufflevector(lo, hi, 0, 1, 2, 3, 4, 5, 6, 7);
                    const bf16x8 Bop = *(const LAS bf16x8*)(sb + SB_XD + (16 * q + l16) * P144 + (32 * kk + 8 * quad) * 2);
                    accS[t] = __builtin_amdgcn_mfma_f32_16x16x32_bf16(Aop, Bop, accS[t], 0, 0, 0); } }
            LDS_WAIT(); __builtin_amdgcn_s_barrier(); asm volatile("" ::: "memory");
            for (int kk = 0; kk <= (ti >> 1); ++kk) {
                const bf16x8 Aop = *(const LAS bf16x8*)(sb + SB_XT + (16 * q + l16) * P144 + (32 * kk + 8 * quad) * 2);
                const bf16x8 Bop = *(const LAS bf16x8*)(lds + SL_MM + (16 * ti + l16) * P144 + (32 * kk + 8 * quad) * 2);
                y = __builtin_amdgcn_mfma_f32_16x16x32_bf16(Aop, Bop, y, 0, 0, 0); }
#pragma unroll
            for (int t = 0; t < 2; ++t) { const int jn = 2 * ti + t;
                *(LAS u32x2*)(lds + SL_SL + (16 * q + l16) * P272 + (16 * jn + 4 * quad) * 2) = (u32x2){cvtpk_s(accS[t][0], accS[t][1]), cvtpk_s(accS[t][2], accS[t][3])}; }
            float v[4], ssq = 0.f;
#pragma unroll
            for (int r = 0; r < 4; ++r) { v[r] = y[r] * silu_f(zv[r]); ssq += v[r] * v[r]; }
            *(u32x2*)(MIX + otok * MIXD + pcol) = (u32x2){cvt_pk_bf16(v[0], v[1]), cvt_pk_bf16(v[2], v[3])};
            ssq += __shfl_xor(ssq, 16); ssq += __shfl_xor(ssq, 32);
            PSS[(size_t)(g * 32 + (h & 7) * 4 + ph * 2 + q) * M + otok] = ssq;
        }
        LDS_WAIT(); __builtin_amdgcn_s_barrier(); asm volatile("" ::: "memory");
#undef SSD_LOAD_RAW
    }
}

template <int WIN>
__device__ __forceinline__ void pool_quads(const bf16* PROJ, bf16* MIX, int blk, int cgp, int tr) {
    for (int i = 0; i < 4; ++i) {
        const int t0 = blk * 64 + tr * 16 + 4 * i, ts0 = t0 & (SEQ - 1);
        u32x4 r[WIN + 3];
#pragma unroll
        for (int k = 0; k < WIN + 3; ++k) { const int dt = k - (WIN - 1); r[k] = (u32x4){0u, 0u, 0u, 0u};
            if (ts0 + dt >= 0) r[k] = *(const u32x4*)(PROJ + (size_t)(t0 + dt) * PROJ_LD + U_OFF + 8 * cgp); }
        float s[8];
#pragma unroll
        for (int e = 0; e < 8; ++e) s[e] = 0.f;
#pragma unroll
        for (int k = 0; k < WIN; ++k) { float f[8]; unpack8(r[k], f);
#pragma unroll
            for (int e = 0; e < 8; ++e) s[e] += f[e]; }
#pragma unroll
        for (int j = 0; j < 4; ++j) {
            float u0[8]; unpack8(r[WIN - 1 + j], u0);
            if (j > 0) { float f[8]; unpack8(r[j - 1], f);
#pragma unroll
                for (int e = 0; e < 8; ++e) s[e] += u0[e] - f[e]; }
            const int cnt = (ts0 + j + 1) < WIN ? (ts0 + j + 1) : WIN; const float inv = 1.0f / (float)cnt;
            u32x4 o; o.x = cvt_pk_bf16(s[0] * inv - u0[0], s[1] * inv - u0[1]); o.y = cvt_pk_bf16(s[2] * inv - u0[2], s[3] * inv - u0[3]);
            o.z = cvt_pk_bf16(s[4] * inv - u0[4], s[5] * inv - u0[5]); o.w = cvt_pk_bf16(s[6] * inv - u0[6], s[7] * inv - u0[7]);
            *(u32x4*)(MIX + (size_t)(t0 + j) * MIXD + 1024 + 8 * cgp) = o; }
    }
}
__device__ __forceinline__ void pool_phase(const Args& a, int G) {
    const bf16* PROJ = (const bf16*)(a.ws + WS_PROJ);
    bf16* MIX = (bf16*)(a.ws + WS_MIX);
    const int tid = threadIdx.x, lane = tid & 63, wave = __builtin_amdgcn_readfirstlane(tid >> 6);
    const int grp = wave & 3, cgp = grp * 32 + (lane & 31), tr = (wave >> 2) * 2 + (lane >> 5);
    for (int blk = blockIdx.x; blk < M / 64; blk += G) {
        if (grp == 0) pool_quads<2>(PROJ, MIX, blk, cgp, tr);
        else if (grp == 1) pool_quads<4>(PROJ, MIX, blk, cgp, tr);
        else if (grp == 2) pool_quads<8>(PROJ, MIX, blk, cgp, tr);
        else pool_quads<16>(PROJ, MIX, blk, cgp, tr);
    }
}

constexpr int N_PHASES = 9;
__global__ void __launch_bounds__(NTHR, 2) hybrid_fwd(Args args) {
    extern __shared__ __attribute__((aligned(16))) unsigned char lds_raw[];
    LAS unsigned char* lds = (LAS unsigned char*)lds_raw;
    const int tid = threadIdx.x, lane = tid & 63, wave = __builtin_amdgcn_readfirstlane(tid >> 6);
    const int G = gridDim.x; const int bx = blockIdx.x; const int vcu = (G % 8 == 0) ? (bx % 8) * (G / 8) + bx / 8 : bx;
    unsigned char* ws = args.ws;
    volatile LAS unsigned* MISC = (volatile LAS unsigned*)(lds + MISC_OFF);
    if (tid < 32) MISC[tid] = 0u;
    __syncthreads();
    const int lo = args.ph_lo, hi = args.ph_hi;
#if MK_CG_SYNC
    cg::grid_group grid = cg::this_grid();
#define GRID_BAR() do { __threadfence(); grid.sync(); } while (0)
#else
    cg::grid_group grid = cg::this_grid();
    XcdBarrier bar; bar.bar = (unsigned*)(ws + WS_CTL) + CW_BAR; bar.x = 0; bar.st = nullptr;
    if (hi - lo > 1) bar = xcd_barrier_post((unsigned*)(ws + WS_CTL) + CW_BAR, MISC + 8);
    if (lo > 1000) grid.sync();
#define GRID_BAR() xcd_barrier(bar)
#endif
#define IN(k) (lo <= (k) && (k) < hi)
#define BOTH(k) (IN(k) && IN((k) + 1))
    bf16 *GU1 = (bf16*)(ws + WS_GU1), *D1 = (bf16*)(ws + WS_D1), *GU2 = (bf16*)(ws + WS_GU2), *D2 = (bf16*)(ws + WS_D2), *WIN = (bf16*)(ws + WS_WIN), *WOUT = (bf16*)(ws + WS_WOUT);
    bf16 *XN = (bf16*)(ws + WS_XN), *HID = (bf16*)(ws + WS_HID), *PROJ = (bf16*)(ws + WS_PROJ), *MIX = (bf16*)(ws + WS_MIX);
    float *SS = (float*)(ws + WS_SS), *DTB = (float*)(ws + WS_DT), *PSS = (float*)(ws + WS_PSS);

    if (IN(0)) { p0_prologue<0>(args, lds, vcu * NWAVES + wave, G * NWAVES, wave, lane); if (BOTH(0)) GRID_BAR(); }
    if (IN(1)) {
        pg8::Gemm g{XN, GU1, M, NGU, D}; pg8::StaticOrder S; S.init(M, NGU, G, bx);
        pg8::EpiSwiglu E{HID, nullptr};
        pg8::gemm_phase<pg8::EpiSwiglu, pg8::StaticOrder, pg8::NoHook, true>(lds, g, S, E, pg8::NoHook{});
        { const int first = ((M / 256) * (NGU / 256)) % G;
          if (bx >= first) p0_prologue<1>(args, lds, (bx - first) * NWAVES + wave, (G - first) * NWAVES, wave, lane); }
        if (BOTH(1)) GRID_BAR();
    }
    if (IN(2)) {
        pg8::Gemm g{HID, D1, M, D, FF}; pg8::StaticOrder S; S.init(M, D, G, bx);
        pg8::EpiResX<true, false> E{nullptr, XN, (const float*)(ws + WS_RS0), nullptr, nullptr, XN, (float*)(ws + WS_RS1), SS, (unsigned*)(ws + WS_CTL) + CW_PANEL, 0.5f, args.in[1]};
        pg8::gemm_phase<pg8::EpiResX<true, false>, pg8::StaticOrder, pg8::NoHook, false>(lds, g, S, E, pg8::NoHook{});
        if (BOTH(2)) GRID_BAR();
    }
    if (IN(3)) {
        pg8::Gemm g{XN, WIN, M, NIN, D}; pg8::StaticOrder S; S.init(M, NIN, G, bx);
        pg8::EpiProj E{PROJ, DTB, nullptr};
        pg8::gemm_phase<pg8::EpiProj, pg8::StaticOrder, pg8::NoHook, true>(lds, g, S, E, pg8::NoHook{});
        {
            pg8::Gemm gf{(const bf16*)(ws + WS_FA), (const bf16*)(ws + WS_FB), 4096, 1024, 256}; pg8::FoldOrder SF{G == 256 ? bx - 192 : bx};
            pg8::EpiFold EF{WOUT};
            pg8::gemm_phase<pg8::EpiFold, pg8::FoldOrder, pg8::NoHook, true>(lds, gf, SF, EF, pg8::NoHook{});
        }
        if (BOTH(3)) GRID_BAR();
    }
    if (IN(4)) {
        pool_phase(args, G);
        conv_phase(args, G);
        if (BOTH(4)) GRID_BAR();
    }
    if (IN(5)) {
        ssd_phase(lds, args, G);
        if (BOTH(5)) GRID_BAR();
    }
    if (IN(6)) {
        pg8::StaticOrder S; S.init(M, D, G, bx); pg8::Unit u0;
        LAS float* TAB = (LAS float*)(lds + TAB_OFF);
        if (S.next(0, u0)) {
            const int row = tid & 255, gg = tid >> 8; float s = 0.f;
            for (int k = 0; k < 32; ++k) s += PSS[(size_t)(gg * 32 + k) * M + u0.pm * 256 + row];
            TAB[512 + gg * 256 + row] = 1.0f / sqrtf(s * (1.0f / 512.0f) + EPS);
        }
        __syncthreads();
        if (tid < 256) { const float r0 = TAB[512 + tid], r1 = TAB[768 + tid]; TAB[tid] = r0 / r1; TAB[256 + tid] = r1; }
        __syncthreads();
        pg8::Gemm g{MIX, WOUT, M, D, MIXD};
        pg8::EpiResX<true, false> E{nullptr, XN, (const float*)(ws + WS_RS1), nullptr, nullptr, XN, (float*)(ws + WS_RS2), SS, (unsigned*)(ws + WS_CTL) + CW_PANEL + 1024, 1.0f, nullptr};
        pg8::ScaleHook HK{TAB, 8, 16};
        pg8::gemm_phase<pg8::EpiResX<true, false>, pg8::StaticOrder, pg8::ScaleHook, false>(lds, g, S, E, HK);
        if (BOTH(6)) GRID_BAR();
    }
    if (IN(7)) {
        pg8::Gemm g{XN, GU2, M, NGU, D}; pg8::StaticOrder S; S.init(M, NGU, G, bx);
        pg8::EpiSwiglu E{HID, nullptr};
        pg8::gemm_phase<pg8::EpiSwiglu, pg8::StaticOrder, pg8::NoHook, true>(lds, g, S, E, pg8::NoHook{});
        { const int first = ((M / 256) * (NGU / 256)) % G;
          if (bx >= first) p0_prologue<2>(args, lds, (bx - first) * NWAVES + wave, (G - first) * NWAVES, wave, lane); }
        if (BOTH(7)) GRID_BAR();
    }
    if (IN(8)) {
        pg8::Gemm g{HID, D2, M, D, FF}; pg8::StaticOrder S; S.init(M, D, G, bx);
        pg8::EpiResX<true, true> E{nullptr, XN, (const float*)(ws + WS_RS2), args.out, args.in[20], nullptr, nullptr, SS, (unsigned*)(ws + WS_CTL) + CW_PANEL + 2048, 0.5f, nullptr};
        pg8::gemm_phase<pg8::EpiResX<true, true>, pg8::StaticOrder, pg8::NoHook, false>(lds, g, S, E, pg8::NoHook{});
    }
#undef IN
#undef BOTH
}

extern "C" void kernel_launch(void* const* d_in, const int* in_sizes, int n_in, void* d_out, int out_size, void* d_ws, size_t ws_size, hipStream_t stream) {
    static int grid = 0;
    if (grid == 0) {
        if (n_in != 21 || in_sizes[0] != M * D || out_size != M * D || ws_size < WS_END) { fprintf(stderr, "kernel_launch: unexpected shapes (n_in %d, in0 %d, out %d, ws %zu)\n", n_in, n_in > 0 ? in_sizes[0] : -1, out_size, ws_size); grid = -1; return; }
        int dev = 0, cus = 0, per_cu = 0;
        if (hipGetDevice(&dev) != hipSuccess || hipDeviceGetAttribute(&cus, hipDeviceAttributeMultiprocessorCount, dev) != hipSuccess) { grid = -1; return; }
        if (hipFuncSetAttribute((const void*)hybrid_fwd, hipFuncAttributeMaxDynamicSharedMemorySize, LDS_BYTES) != hipSuccess) { fprintf(stderr, "kernel_launch: hipFuncSetAttribute failed\n"); grid = -1; return; }
        if (hipOccupancyMaxActiveBlocksPerMultiprocessor(&per_cu, (const void*)hybrid_fwd, NTHR, LDS_BYTES) != hipSuccess || per_cu < 1) { fprintf(stderr, "kernel_launch: occupancy query says %d\n", per_cu); per_cu = 1; }
        (void)hipGetLastError();
        grid = cus;
        if (grid != 256) fprintf(stderr, "kernel_launch: %d CUs; the single-unit GEMM phases expect 256\n", grid);
    }
    if (grid < 0) return;
    (void)hipMemsetAsync((char*)d_ws + WS_CTL, 0, CTL_ZERO_BYTES, stream);
    Args a{};
    for (int i = 0; i < 21; ++i) a.in[i] = (const float*)d_in[i];
    a.out = (float*)d_out; a.ws = (unsigned char*)d_ws;
#if MK_N_LAUNCHES == 1
    a.ph_lo = 0; a.ph_hi = N_PHASES;
    void* kargs[] = {&a};
    hipError_t e = hipLaunchCooperativeKernel((const void*)hybrid_fwd, dim3(grid), dim3(NTHR), kargs, LDS_BYTES, stream);
    if (e != hipSuccess) fprintf(stderr, "kernel_launch: cooperative launch failed: %s (grid %d)\n", hipGetErrorString(e), grid);
#else
    for (int p = 0; p < N_PHASES; ++p) { a.ph_lo = p; a.ph_hi = p + 1; hipLaunchKernelGGL(hybrid_fwd, dim3(grid), dim3(NTHR), LDS_BYTES, stream, a); }
#endif
}
```

```cpp
#include <hip/hip_runtime.h>
#include <hip/hip_cooperative_groups.h>
#include <cstdio>
#include <cstdint>
namespace cg = cooperative_groups;

#ifndef MK_N_LAUNCHES
#define MK_N_LAUNCHES 1
#endif
#ifndef MK_CG_SYNC
#define MK_CG_SYNC 0
#endif

#define LAS __attribute__((address_space(3)))
#define GAS __attribute__((address_space(1)))
typedef unsigned short bf16;
typedef short bf16x8 __attribute__((ext_vector_type(8)));
typedef float f32x4 __attribute__((ext_vector_type(4)));
typedef float f32x2 __attribute__((ext_vector_type(2)));
typedef unsigned u32x4 __attribute__((ext_vector_type(4)));
typedef unsigned u32x2 __attribute__((ext_vector_type(2)));

constexpr int M = 16384, SEQ = 2048, D = 1024, FF = 2816, NGU = 2 * FF, NIN = 3840, PROJ_LD = 3584, MIXD = 2048;
constexpr int Z_OFF = 0, XS_OFF = 1024, B_OFF = 2048, C_OFF = 2304, U_OFF = 2560;
constexpr int CONV_DIM = 1536;
constexpr float EPS = 1e-6f;
constexpr int NWAVES = 8, NTHR = 512;

constexpr size_t MiB = 1u << 20;
constexpr size_t WS_CTL = 0, CTL_ZERO_BYTES = 64 * 1024;
constexpr size_t WS_SS = 64 * 1024;
constexpr size_t WS_RS0 = 448 * 1024;
constexpr size_t WS_RS1 = 320 * 1024, WS_RS2 = 384 * 1024;
constexpr size_t WS_GU1 = 1 * MiB;
constexpr size_t WS_PSS = 1 * MiB;
constexpr size_t WS_D1 = 12 * MiB;
constexpr size_t WS_DT = 12 * MiB;
constexpr size_t WS_DTV = 13 * MiB;
constexpr size_t WS_CSV = 14 * MiB;
constexpr size_t WS_GU2 = WS_D1 + 5 * MiB + 512 * 1024;
constexpr size_t WS_D2 = WS_GU2 + 11 * MiB;
constexpr size_t WS_WIN = 34 * MiB;
constexpr size_t WS_WOUT = WS_WIN + 7 * MiB + 512 * 1024;
constexpr size_t WS_PROJ = 46 * MiB;
constexpr size_t WS_HID = 46 * MiB;
constexpr size_t WS_MIX = 158 * MiB;
constexpr size_t WS_FA = 158 * MiB;
constexpr size_t WS_FB = 160 * MiB;
constexpr size_t WS_XN = 222 * MiB;
constexpr size_t WS_BCG = 222 * MiB;
constexpr size_t WS_END = 254 * MiB;
constexpr int CW_BAR = 1024;
constexpr int CW_PANEL = 8192;

constexpr int RING_BYTES = 131072;
constexpr int TAB_OFF = RING_BYTES;
constexpr int MISC_OFF = TAB_OFF + 4096;
constexpr int LDS_BYTES = 147456;

__device__ __forceinline__ unsigned f2bf(float f) { unsigned u = __builtin_bit_cast(unsigned, f); return (u + 0x7fffu + ((u >> 16) & 1u)) >> 16; }
__device__ __forceinline__ unsigned cvt_pk_bf16(float lo, float hi) { unsigned r; asm volatile("v_cvt_pk_bf16_f32 %0, %1, %2" : "=v"(r) : "v"(lo), "v"(hi)); return r; }
__device__ __forceinline__ unsigned pk2(float lo, float hi) { return cvt_pk_bf16(lo, hi); }
typedef float f32x2_t __attribute__((ext_vector_type(2))); typedef __bf16 bf16x2_t __attribute__((ext_vector_type(2)));
__device__ __forceinline__ unsigned cvtpk_s(float lo, float hi) { f32x2_t v = {lo, hi}; bf16x2_t b = __builtin_convertvector(v, bf16x2_t); return __builtin_bit_cast(unsigned, b); }
__device__ __forceinline__ float bflo(unsigned u) { return __builtin_bit_cast(float, u << 16); }
__device__ __forceinline__ float bfhi(unsigned u) { return __builtin_bit_cast(float, u & 0xffff0000u); }
__device__ __forceinline__ float silu_f(float v) { return v * __builtin_amdgcn_rcpf(1.0f + __builtin_amdgcn_exp2f(-1.44269504f * v)); }
__device__ __forceinline__ float wave_sum(float v) {
#pragma unroll
    for (int o = 1; o < 64; o <<= 1) v += __shfl_xor(v, o);
    return v;
}
#define LDS_WAIT() asm volatile("s_waitcnt lgkmcnt(0)" ::: "memory")
#define VM_WAIT() asm volatile("s_waitcnt vmcnt(0)" ::: "memory")

namespace pg8 {
constexpr int BM = 256, BK = 64, HALF = 128, HTB = HALF * BK * 2, STAGE_BYTES = 8 * HTB, NXCD = 8, WGM = 8;
__host__ __device__ __forceinline__ int lds_byte(int r, int c) { const int st = (r >> 4) * 2 + (c >> 5), rr = r & 15, cc = c & 31, ob = rr * 64 + cc * 2; return st * 1024 + (ob ^ (((ob >> 9) & 1) << 5)); }
__host__ __device__ __forceinline__ void stage_rc(int b, int& R, int& C) { const int st = b / 1024, sb = b % 1024, swz = sb ^ (((sb >> 9) & 1) << 5); R = (st >> 1) * 16 + swz / 64; C = (st & 1) * 32 + (swz % 64) / 2; }
__host__ __device__ __forceinline__ int perm32(int rho) { const int n = rho >> 4, i = rho & 15; return 8 * (i >> 2) + 4 * n + (i & 3); }

struct Unit { int pm, pn; };
struct Gemm { const bf16* A; const bf16* Bt; int M, N, K; };

struct StaticOrder {
    int nM, nN, nwg, G, c;
    __host__ __device__ void init(int M_, int N_, int G_, int c_) { nM = M_ / BM; nN = N_ / BM; nwg = nM * nN; G = G_; c = c_; }
    __host__ __device__ bool next(int i, Unit& u) const {
        const long L = (long)i * G + c; if (L >= nwg) return false;
        int wgid = (int)L; { const int q = nwg / NXCD, r = nwg % NXCD, xcd = wgid % NXCD, off = wgid / NXCD; wgid = (xcd < r ? xcd * (q + 1) : r * (q + 1) + (xcd - r) * q) + off; }
        const int nig = WGM * nN, gid = wgid / nig, fm = gid * WGM, gsz = (nM - fm) < WGM ? (nM - fm) : WGM;
        u.pm = fm + ((wgid % nig) % gsz); u.pn = (wgid % nig) / gsz; return true;
    }
};

struct FoldOrder {
    int c;
    __host__ __device__ bool next(int i, Unit& u) const { const int idx = i * 64 + c; if (c < 0 || idx >= 16) return false; u.pm = idx; u.pn = idx >> 2; return true; }
};
struct NoHook { static constexpr bool ON = false; };
struct ScaleHook { static constexpr bool ON = true; const LAS float* F; int t0, t1; };

template <class Epi, class Sched, class Hook, bool ALIGN_EPI>
__device__ __forceinline__ void gemm_phase(LAS unsigned char* lds, const Gemm g, const Sched& S, const Epi& E, const Hook& HK) {
    const int tid = threadIdx.x, wid = __builtin_amdgcn_readfirstlane(tid >> 6), lane = tid & 63, wr = wid >> 2, wc = wid & 3, fr = lane & 15, fq = lane >> 4;
    const int K = g.K, nt = K / BK;
    unsigned voffA[2], voffB[2];
#pragma unroll
    for (int i = 0; i < 2; ++i) { int R, C; stage_rc(tid * 16 + i * 8192, R, C); const int Rb = (R & ~31) + perm32(R & 31);
        voffA[i] = (unsigned)(R * K + C) * 2u; voffB[i] = (unsigned)(Rb * K + C) * 2u; }
    const size_t kstep = (size_t)(BK * 2);
    const size_t hstep = (size_t)HALF * K * 2;
    const size_t tstep = 2 * hstep;
    const unsigned ldsw = (unsigned)wid * 1024u;
    const int aoff = lds_byte(wr * 64 + fr, fq * 8), boff = lds_byte(wc * 32 + fr, fq * 8);
#define PG8_SA(b, h) (((b) * 2 + (h)) * HTB)
#define PG8_SB(b, h) ((4 + (b) * 2 + (h)) * HTB)
#define PG8_STAGE(bufoff, gbase, voff) do { _Pragma("unroll") for (int _i = 0; _i < 2; ++_i) \
        __builtin_amdgcn_global_load_lds((const unsigned*)((const char*)(gbase) + (voff)[_i]), (LAS unsigned*)(lds + (bufoff) + ldsw + _i * 8192), 16, 0, 0); } while (0)
#define PG8_LDA(dst, b, h) do { _Pragma("unroll") for (int m = 0; m < 4; ++m) _Pragma("unroll") for (int k = 0; k < 2; ++k) dst[m][k] = *(const LAS bf16x8*)(lds + PG8_SA(b, h) + aoff + m * 2048 + k * 1024); } while (0)
#define PG8_LDB(dst, b, h) do { _Pragma("unroll") for (int n = 0; n < 2; ++n) _Pragma("unroll") for (int k = 0; k < 2; ++k) dst[n][k] = *(const LAS bf16x8*)(lds + PG8_SB(b, h) + boff + n * 2048 + k * 1024); } while (0)
#define PG8_MMA(ai, bj, At, Bt) do { __builtin_amdgcn_s_setprio(1); _Pragma("unroll") for (int m = 0; m < 4; ++m) _Pragma("unroll") for (int n = 0; n < 2; ++n) _Pragma("unroll") for (int k = 0; k < 2; ++k) \
        acc[ai][bj][m][n] = __builtin_amdgcn_mfma_f32_16x16x32_bf16(Bt[n][k], At[m][k], acc[ai][bj][m][n], 0, 0, 0); __builtin_amdgcn_s_setprio(0); } while (0)
#define PG8_WAIT_V(n) asm volatile("s_waitcnt vmcnt(" #n ")" ::: "memory")
#define PG8_WAIT_L(n) asm volatile("s_waitcnt lgkmcnt(" #n ")" ::: "memory")
#define PG8_BAR __builtin_amdgcn_s_barrier()
#define PG8_SCHED __builtin_amdgcn_sched_barrier(0)
    Unit cur, nxt; int ui = 0;
    if (!S.next(0, cur)) return;
    f32x4 acc[2][2][4][2];
#pragma unroll
    for (int a = 0; a < 2; ++a)
#pragma unroll
        for (int b = 0; b < 2; ++b)
#pragma unroll
            for (int m = 0; m < 4; ++m)
#pragma unroll
                for (int n = 0; n < 2; ++n) acc[a][b][m][n] = (f32x4){0.f, 0.f, 0.f, 0.f};
    bf16x8 At[4][2], B0[2][2], B1[2][2];
    const char* cA = (const char*)g.A + (size_t)cur.pm * tstep; const char* cB = (const char*)g.Bt + (size_t)cur.pn * tstep;
    PG8_STAGE(PG8_SB(0, 0), cB, voffB); PG8_STAGE(PG8_SB(0, 1), cB + hstep, voffB); PG8_STAGE(PG8_SA(0, 0), cA, voffA); PG8_STAGE(PG8_SA(0, 1), cA + hstep, voffA);
    if (wr == 1) PG8_BAR;
    PG8_WAIT_V(2); PG8_BAR;
    PG8_STAGE(PG8_SB(1, 0), cB + kstep, voffB); PG8_STAGE(PG8_SA(1, 0), cA + kstep, voffA); PG8_STAGE(PG8_SB(1, 1), cB + hstep + kstep, voffB);
    PG8_WAIT_V(6); PG8_BAR;
    for (;;) {
        const bool has_next = S.next(ui + 1, nxt);
        const char* nA = has_next ? (const char*)g.A + (size_t)nxt.pm * tstep : cA; const char* nB = has_next ? (const char*)g.Bt + (size_t)nxt.pn * tstep : cB;
        for (int t = 0; t < nt; t += 2) {
            const bool last = (t == nt - 2);
            const char* a1 = cA + (size_t)(t + 1) * kstep;
            const char* a2 = last ? nA : cA + (size_t)(t + 2) * kstep; const char* b2 = last ? nB : cB + (size_t)(t + 2) * kstep;
            const char* a3 = a2 + kstep; const char* b3 = b2 + kstep;
            if constexpr (Hook::ON) {
                if (t == HK.t0 || t == HK.t1) {
                    const LAS float* Fp = HK.F + (t == HK.t1 ? 256 : 0);
#pragma unroll
                    for (int ai = 0; ai < 2; ++ai)
#pragma unroll
                        for (int m = 0; m < 4; ++m) { const float f = Fp[ai * HALF + wr * 64 + m * 16 + fr];
#pragma unroll
                            for (int bj = 0; bj < 2; ++bj)
#pragma unroll
                                for (int n = 0; n < 2; ++n) acc[ai][bj][m][n] = acc[ai][bj][m][n] * f; }
                }
            }
            PG8_LDB(B0, 0, 0); PG8_LDB(B1, 0, 1); PG8_SCHED; PG8_LDA(At, 0, 0); PG8_STAGE(PG8_SA(1, 1), a1 + hstep, voffA);
            PG8_WAIT_V(8); PG8_WAIT_L(0); PG8_BAR; PG8_MMA(0, 0, At, B0); PG8_MMA(0, 1, At, B1); PG8_BAR; PG8_SCHED;
            PG8_LDA(At, 0, 1); PG8_STAGE(PG8_SB(0, 0), b2, voffB); PG8_STAGE(PG8_SB(0, 1), b2 + hstep, voffB); PG8_STAGE(PG8_SA(0, 0), a2, voffA);
            PG8_WAIT_V(8); PG8_WAIT_L(0); PG8_BAR; PG8_MMA(1, 0, At, B0); PG8_MMA(1, 1, At, B1); PG8_BAR; PG8_SCHED;
            PG8_LDB(B0, 1, 0); PG8_LDB(B1, 1, 1); PG8_SCHED; PG8_LDA(At, 1, 0); PG8_STAGE(PG8_SA(0, 1), a2 + hstep, voffA);
            PG8_WAIT_V(8); PG8_WAIT_L(0); PG8_BAR; PG8_MMA(0, 0, At, B0); PG8_MMA(0, 1, At, B1); PG8_BAR; PG8_SCHED;
            PG8_LDA(At, 1, 1); PG8_STAGE(PG8_SB(1, 0), b3, voffB); PG8_STAGE(PG8_SB(1, 1), b3 + hstep, voffB); PG8_STAGE(PG8_SA(1, 0), a3, voffA);
            PG8_WAIT_V(8); PG8_WAIT_L(0); PG8_BAR; PG8_MMA(1, 0, At, B0); PG8_MMA(1, 1, At, B1); PG8_BAR; PG8_SCHED;
        }
        if constexpr (ALIGN_EPI) { if (wr == 0) PG8_BAR; }
        if constexpr (!Epi::AFTER_DRAIN) { E(acc, cur, wr, wc, fr, fq); }
        if (!has_next) break;
#pragma unroll
        for (int a = 0; a < 2; ++a)
#pragma unroll
            for (int b = 0; b < 2; ++b)
#pragma unroll
                for (int m = 0; m < 4; ++m)
#pragma unroll
                    for (int n = 0; n < 2; ++n) acc[a][b][m][n] = (f32x4){0.f, 0.f, 0.f, 0.f};
        cur = nxt; cA = nA; cB = nB; ++ui;
        if constexpr (ALIGN_EPI) { if (wr == 1) PG8_BAR; }
    }
    PG8_WAIT_V(0);
    if constexpr (!ALIGN_EPI) { if (wr == 0) PG8_BAR; }
    PG8_BAR;
    if constexpr (Epi::AFTER_DRAIN) { E.fused(acc, cur, wr, wc, fr, fq, lds, wid, lane); }
#undef PG8_SA
#undef PG8_SB
#undef PG8_STAGE
#undef PG8_LDA
#undef PG8_LDB
#undef PG8_MMA
#undef PG8_WAIT_V
#undef PG8_WAIT_L
#undef PG8_BAR
#undef PG8_SCHED
}

__device__ __forceinline__ float row_rstd4(const float* ss, int row) {
    const float s = (ss[row] + ss[M + row]) + (ss[2 * M + row] + ss[3 * M + row]);
    return 1.0f / sqrtf(s * (1.0f / D) + EPS);
}

struct EpiSwiglu {
    static constexpr bool AFTER_DRAIN = false;
    bf16* H; const float* ss;
    __device__ __forceinline__ void operator()(const f32x4 (&acc)[2][2][4][2], const Unit& u, int wr, int wc, int fr, int fq) const {
        const int row0 = u.pm * BM + wr * 64 + fr, col0 = u.pn * HALF + wc * 32 + 8 * fq;
        float r8[8];
#pragma unroll
        for (int gi = 0; gi < 8; ++gi) r8[gi] = ss ? row_rstd4(ss, row0 + (gi >> 2) * HALF + (gi & 3) * 16) : 1.0f;
#pragma unroll
        for (int ai = 0; ai < 2; ++ai)
#pragma unroll
            for (int m = 0; m < 4; ++m) { const int row = row0 + ai * HALF + m * 16;
                const float r = r8[ai * 4 + m];
                float h[8];
#pragma unroll
                for (int n = 0; n < 2; ++n)
#pragma unroll
                    for (int j = 0; j < 4; ++j) { const float gv = acc[ai][0][m][n][j] * r, uv = acc[ai][1][m][n][j] * r; h[4 * n + j] = silu_f(gv) * uv; }
                u32x4 w; w.x = cvt_pk_bf16(h[0], h[1]); w.y = cvt_pk_bf16(h[2], h[3]); w.z = cvt_pk_bf16(h[4], h[5]); w.w = cvt_pk_bf16(h[6], h[7]);
                *(u32x4*)(H + (size_t)row * FF + col0) = w; }
    }
};
struct EpiProj {
    static constexpr bool AFTER_DRAIN = false;
    bf16* P; float* DT; const float* ss;
    __device__ __forceinline__ void operator()(const f32x4 (&acc)[2][2][4][2], const Unit& u, int wr, int wc, int fr, int fq) const {
        const int row0 = u.pm * BM + wr * 64 + fr;
        float r8[8];
#pragma unroll
        for (int gi = 0; gi < 8; ++gi) r8[gi] = ss ? row_rstd4(ss, row0 + (gi >> 2) * HALF + (gi & 3) * 16) : 1.0f;
        if (u.pn < 14) {
            const int col0 = u.pn * BM + wc * 32 + 8 * fq;
#pragma unroll
            for (int ai = 0; ai < 2; ++ai)
#pragma unroll
                for (int m = 0; m < 4; ++m) { const int row = row0 + ai * HALF + m * 16; const float r = r8[ai * 4 + m];
#pragma unroll
                    for (int bj = 0; bj < 2; ++bj) { const f32x4 v0 = acc[ai][bj][m][0] * r, v1 = acc[ai][bj][m][1] * r;
                        u32x4 w; w.x = cvtpk_s(v0[0], v0[1]); w.y = cvtpk_s(v0[2], v0[3]); w.z = cvtpk_s(v1[0], v1[1]); w.w = cvtpk_s(v1[2], v1[3]);
                        *(u32x4*)(P + (size_t)row * PROJ_LD + col0 + bj * HALF) = w; } }
        } else if (wc == 0 && fq < 2) {
#pragma unroll
            for (int ai = 0; ai < 2; ++ai)
#pragma unroll
                for (int m = 0; m < 4; ++m) { const int row = row0 + ai * HALF + m * 16; const float r = r8[ai * 4 + m];
                    *(f32x4*)(DT + (size_t)row * 16 + 8 * fq) = acc[ai][0][m][0] * r; *(f32x4*)(DT + (size_t)row * 16 + 8 * fq + 4) = acc[ai][0][m][1] * r; }
        }
    }
};
struct EpiFold {
    static constexpr bool AFTER_DRAIN = false;
    bf16* WO;
    __device__ __forceinline__ void operator()(const f32x4 (&acc)[2][2][4][2], const Unit& u, int wr, int wc, int fr, int fq) const {
        const int g = u.pm >> 2, n0 = (u.pm & 3) * BM + wr * 64 + fr, col0 = 1024 + 256 * g + wc * 32 + 8 * fq;
#pragma unroll
        for (int ai = 0; ai < 2; ++ai)
#pragma unroll
            for (int m = 0; m < 4; ++m) { const int n = n0 + ai * HALF + m * 16;
#pragma unroll
                for (int bj = 0; bj < 2; ++bj) { const f32x4 v0 = acc[ai][bj][m][0], v1 = acc[ai][bj][m][1];
                    u32x4 w; w.x = cvtpk_s(v0[0], v0[1]); w.y = cvtpk_s(v0[2], v0[3]); w.z = cvtpk_s(v1[0], v1[1]); w.w = cvtpk_s(v1[2], v1[3]);
                    *(u32x4*)(WO + (size_t)n * MIXD + col0 + bj * HALF) = w; } }
    }
};
struct EpiRes {
    static constexpr bool AFTER_DRAIN = true;
    const float* base; float* out; bf16* xn; float* ss; float scale;
    __device__ __forceinline__ void fused(const f32x4 (&acc)[2][2][4][2], const Unit& u, int wr, int wc, int fr, int fq, LAS unsigned char* lds, int wid, int lane) const {
        LAS float* Pt = (LAS float*)lds;
        const int row0 = u.pm * BM + wr * 64 + fr, col0 = u.pn * BM + wc * 32 + 8 * fq;
        f32x4 bq[3][4];
#pragma unroll
        for (int pg = 0; pg < 2; ++pg) { const size_t off = (size_t)(row0 + (pg >> 2) * HALF + (pg & 3) * 16) * D + col0;
#pragma unroll
          for (int bj = 0; bj < 2; ++bj) { bq[pg][2 * bj] = *(const f32x4*)(base + off + bj * HALF); bq[pg][2 * bj + 1] = *(const f32x4*)(base + off + bj * HALF + 4); } }
#pragma unroll
        for (int gi = 0; gi < 8; ++gi) { const int ai = gi >> 2, m = gi & 3;
            const int row = row0 + ai * HALF + m * 16; const size_t off = (size_t)row * D + col0; float q = 0.f;
            if (gi < 6) { const int ai2 = (gi + 2) >> 2, m2 = (gi + 2) & 3; const size_t off2 = (size_t)(row0 + ai2 * HALF + m2 * 16) * D + col0;
#pragma unroll
                for (int bj = 0; bj < 2; ++bj) { bq[(gi + 2) % 3][2 * bj] = *(const f32x4*)(base + off2 + bj * HALF); bq[(gi + 2) % 3][2 * bj + 1] = *(const f32x4*)(base + off2 + bj * HALF + 4); } }
            f32x4 bc[4];
#pragma unroll
            for (int k = 0; k < 4; ++k) bc[k] = bq[gi % 3][k];
#pragma unroll
            for (int bj = 0; bj < 2; ++bj) {
                const f32x4 v0 = bc[2 * bj] + acc[ai][bj][m][0] * scale, v1 = bc[2 * bj + 1] + acc[ai][bj][m][1] * scale;
                *(f32x4*)(out + off + bj * HALF) = v0; *(f32x4*)(out + off + bj * HALF + 4) = v1;
                if (xn) { u32x4 w; w.x = cvt_pk_bf16(v0[0], v0[1]); w.y = cvt_pk_bf16(v0[2], v0[3]); w.z = cvt_pk_bf16(v1[0], v1[1]); w.w = cvt_pk_bf16(v1[2], v1[3]);
                    *(u32x4*)(xn + off + bj * HALF) = w; }
                q += (v0[0] * v0[0] + v0[1] * v0[1]) + (v0[2] * v0[2] + v0[3] * v0[3]) + (v1[0] * v1[0] + v1[1] * v1[1]) + (v1[2] * v1[2] + v1[3] * v1[3]); }
            q += __shfl_xor(q, 16); q += __shfl_xor(q, 32);
            if (fq == 0) Pt[(ai * HALF + wr * 64 + m * 16 + fr) * 4 + wc] = q; }
        LDS_WAIT(); __builtin_amdgcn_s_barrier(); asm volatile("" ::: "memory");
        const int t = wid * 64 + lane;
        if (t < 256) { const float s = (Pt[t * 4 + 0] + Pt[t * 4 + 1]) + (Pt[t * 4 + 2] + Pt[t * 4 + 3]); ss[(size_t)u.pn * M + u.pm * BM + t] = s; }
    }
};
struct EpiResNorm {
    static constexpr bool AFTER_DRAIN = true;
    const float* base; float* out; const float* gain; bf16* xn; float* ss; unsigned* cnt; float scale;
    __device__ __forceinline__ void fused(f32x4 (&acc)[2][2][4][2], const Unit& u, int wr, int wc, int fr, int fq, LAS unsigned char* lds, int wid, int lane) const {
        LAS float* Pt = (LAS float*)lds;
        LAS float* Rt = (LAS float*)(lds + 4096);
        const int row0 = u.pm * BM + wr * 64 + fr, col0 = u.pn * BM + wc * 32 + 8 * fq;
        f32x4 bq[3][4];
#pragma unroll
        for (int pg = 0; pg < 2; ++pg) { const size_t off = (size_t)(row0 + (pg >> 2) * HALF + (pg & 3) * 16) * D + col0;
#pragma unroll
          for (int bj = 0; bj < 2; ++bj) { bq[pg][2 * bj] = *(const f32x4*)(base + off + bj * HALF); bq[pg][2 * bj + 1] = *(const f32x4*)(base + off + bj * HALF + 4); } }
#pragma unroll
        for (int gi = 0; gi < 8; ++gi) { const int ai = gi >> 2, m = gi & 3; float q = 0.f;
            if (gi < 6) { const int ai2 = (gi + 2) >> 2, m2 = (gi + 2) & 3; const size_t off2 = (size_t)(row0 + ai2 * HALF + m2 * 16) * D + col0;
#pragma unroll
                for (int bj = 0; bj < 2; ++bj) { bq[(gi + 2) % 3][2 * bj] = *(const f32x4*)(base + off2 + bj * HALF); bq[(gi + 2) % 3][2 * bj + 1] = *(const f32x4*)(base + off2 + bj * HALF + 4); } }
            f32x4 bc[4];
#pragma unroll
            for (int k = 0; k < 4; ++k) bc[k] = bq[gi % 3][k];
#pragma unroll
            for (int bj = 0; bj < 2; ++bj) {
                const f32x4 v0 = bc[2 * bj] + acc[ai][bj][m][0] * scale, v1 = bc[2 * bj + 1] + acc[ai][bj][m][1] * scale;
                acc[ai][bj][m][0] = v0; acc[ai][bj][m][1] = v1;
                if (xn) { const size_t offo = (size_t)(row0 + ai * HALF + m * 16) * D + col0 + bj * HALF; *(f32x4*)(out + offo) = v0; *(f32x4*)(out + offo + 4) = v1; }
                q += (v0[0] * v0[0] + v0[1] * v0[1]) + (v0[2] * v0[2] + v0[3] * v0[3]) + (v1[0] * v1[0] + v1[1] * v1[1]) + (v1[2] * v1[2] + v1[3] * v1[3]); }
            q += __shfl_xor(q, 16); q += __shfl_xor(q, 32);
            if (fq == 0) Pt[(ai * HALF + wr * 64 + m * 16 + fr) * 4 + wc] = q; }
        LDS_WAIT(); __builtin_amdgcn_s_barrier(); asm volatile("" ::: "memory");
        const int t = wid * 64 + lane;
        if (t < 256) { const float sp = (Pt[t * 4 + 0] + Pt[t * 4 + 1]) + (Pt[t * 4 + 2] + Pt[t * 4 + 3]);
            __hip_atomic_store(ss + (size_t)u.pn * M + u.pm * BM + t, sp, __ATOMIC_RELAXED, __HIP_MEMORY_SCOPE_AGENT); }
        asm volatile("s_waitcnt vmcnt(0)" ::: "memory");
        if (t < 256 && lane == 0) __hip_atomic_fetch_add(cnt + 16 * u.pm, 1u, __ATOMIC_RELAXED, __HIP_MEMORY_SCOPE_AGENT);
        if (wid == 0) {
            unsigned sp_ = 0;
            while ((unsigned)__builtin_amdgcn_readfirstlane(__hip_atomic_load(cnt + 16 * u.pm, __ATOMIC_RELAXED, __HIP_MEMORY_SCOPE_AGENT)) < 16u) { __builtin_amdgcn_s_sleep(1); if (++sp_ > (1u << 22)) break; }
            __builtin_amdgcn_fence(__ATOMIC_ACQUIRE, "agent");
        }
        asm volatile("s_waitcnt vmcnt(0) lgkmcnt(0)" ::: "memory"); __builtin_amdgcn_s_barrier(); asm volatile("" ::: "memory");
        if (t < 256) { float s4 = 0.f;
#pragma unroll
            for (int p = 0; p < 4; ++p) s4 += __hip_atomic_load(ss + (size_t)p * M + u.pm * BM + t, __ATOMIC_RELAXED, __HIP_MEMORY_SCOPE_AGENT);
            Rt[t] = 1.0f / sqrtf(s4 * (1.0f / D) + EPS); }
        f32x4 gv[4];
#pragma unroll
        for (int k = 0; k < 4; ++k) gv[k] = (f32x4){1.f, 1.f, 1.f, 1.f};
        if (!xn) {
#pragma unroll
            for (int bj = 0; bj < 2; ++bj) { gv[2 * bj] = *(const f32x4*)(gain + col0 + bj * HALF); gv[2 * bj + 1] = *(const f32x4*)(gain + col0 + bj * HALF + 4); } }
        LDS_WAIT(); __builtin_amdgcn_s_barrier(); asm volatile("" ::: "memory");
#pragma unroll
        for (int gi = 0; gi < 8; ++gi) { const int ai = gi >> 2, m = gi & 3; const int rl = ai * HALF + wr * 64 + m * 16 + fr; const float r = Rt[rl];
            const size_t off = (size_t)(u.pm * BM + rl) * D + col0;
#pragma unroll
            for (int bj = 0; bj < 2; ++bj) { const f32x4 o0 = acc[ai][bj][m][0] * r * gv[2 * bj], o1 = acc[ai][bj][m][1] * r * gv[2 * bj + 1];
                if (xn) { u32x4 w; w.x = cvt_pk_bf16(o0[0], o0[1]); w.y = cvt_pk_bf16(o0[2], o0[3]); w.z = cvt_pk_bf16(o1[0], o1[1]); w.w = cvt_pk_bf16(o1[2], o1[3]); *(u32x4*)(xn + off + bj * HALF) = w; }
                else { *(f32x4*)(out + off + bj * HALF) = o0; *(f32x4*)(out + off + bj * HALF + 4) = o1; } } }
    }
};
template <bool BASE_BF16, bool FINAL>
struct EpiResX {
    static constexpr bool AFTER_DRAIN = true;
    const float* base; const bf16* bbn; const float* brs; float* out; const float* gain; bf16* xn; float* rs_out; float* ss; unsigned* cnt; float scale; const float* cgain;
    __device__ __forceinline__ void fused(f32x4 (&acc)[2][2][4][2], const Unit& u, int wr, int wc, int fr, int fq, LAS unsigned char* lds, int wid, int lane) const {
        LAS float* Pt = (LAS float*)lds;
        LAS float* Rt = (LAS float*)(lds + 4096);
        const int row0 = u.pm * BM + wr * 64 + fr, col0 = u.pn * BM + wc * 32 + 8 * fq;
        float inv8[8];
#pragma unroll
        for (int gi = 0; gi < 8; ++gi) inv8[gi] = BASE_BF16 ? brs[row0 + (gi >> 2) * HALF + (gi & 3) * 16] : 1.0f;
        f32x4 ci[4];
#pragma unroll
        for (int k = 0; k < 4; ++k) ci[k] = (f32x4){1.f, 1.f, 1.f, 1.f};
        if (BASE_BF16 && cgain) {
#pragma unroll
            for (int k = 0; k < 4; ++k) { const f32x4 gq = *(const f32x4*)(cgain + col0 + (k >> 1) * HALF + (k & 1) * 4); ci[k] = (f32x4){1.0f / gq[0], 1.0f / gq[1], 1.0f / gq[2], 1.0f / gq[3]}; } }
        f32x4 bq[3][4]; u32x4 bqb[3][2];
#define ERX_LOAD(slot, g_) do { const size_t off_ = (size_t)(row0 + ((g_) >> 2) * HALF + ((g_) & 3) * 16) * D + col0; \
            if constexpr (BASE_BF16) { bqb[slot][0] = *(const u32x4*)(bbn + off_); bqb[slot][1] = *(const u32x4*)(bbn + off_ + HALF); } \
            else { _Pragma("unroll") for (int bj_ = 0; bj_ < 2; ++bj_) { bq[slot][2 * bj_] = *(const f32x4*)(base + off_ + bj_ * HALF); bq[slot][2 * bj_ + 1] = *(const f32x4*)(base + off_ + bj_ * HALF + 4); } } } while (0)
        ERX_LOAD(0, 0); ERX_LOAD(1, 1);
#pragma unroll
        for (int gi = 0; gi < 8; ++gi) { const int ai = gi >> 2, m = gi & 3; float q = 0.f;
            if (gi < 6) ERX_LOAD((gi + 2) % 3, gi + 2);
            f32x4 bc[4];
            if constexpr (BASE_BF16) { const float iv = inv8[gi];
#pragma unroll
                for (int bj = 0; bj < 2; ++bj) { const u32x4 w = bqb[gi % 3][bj];
                    bc[2 * bj] = (f32x4){bflo(w.x), bfhi(w.x), bflo(w.y), bfhi(w.y)} * iv * ci[2 * bj]; bc[2 * bj + 1] = (f32x4){bflo(w.z), bfhi(w.z), bflo(w.w), bfhi(w.w)} * iv * ci[2 * bj + 1]; }
            } else {
#pragma unroll
                for (int k = 0; k < 4; ++k) bc[k] = bq[gi % 3][k]; }
#pragma unroll
            for (int bj = 0; bj < 2; ++bj) {
                const f32x4 v0 = bc[2 * bj] + acc[ai][bj][m][0] * scale, v1 = bc[2 * bj + 1] + acc[ai][bj][m][1] * scale;
                acc[ai][bj][m][0] = v0; acc[ai][bj][m][1] = v1;
                q += (v0[0] * v0[0] + v0[1] * v0[1]) + (v0[2] * v0[2] + v0[3] * v0[3]) + (v1[0] * v1[0] + v1[1] * v1[1]) + (v1[2] * v1[2] + v1[3] * v1[3]); }
            q += __shfl_xor(q, 16); q += __shfl_xor(q, 32);
            if (fq == 0) Pt[(ai * HALF + wr * 64 + m * 16 + fr) * 4 + wc] = q; }
#undef ERX_LOAD
        LDS_WAIT(); __builtin_amdgcn_s_barrier(); asm volatile("" ::: "memory");
        const int t = wid * 64 + lane;
        if (t < 256) { const float sp = (Pt[t * 4 + 0] + Pt[t * 4 + 1]) + (Pt[t * 4 + 2] + Pt[t * 4 + 3]);
            __hip_atomic_store(ss + (size_t)u.pn * M + u.pm * BM + t, sp, __ATOMIC_RELAXED, __HIP_MEMORY_SCOPE_AGENT); }
        asm volatile("s_waitcnt vmcnt(0)" ::: "memory");
        if (t < 256 && lane == 0) __hip_atomic_fetch_add(cnt + 16 * u.pm, 1u, __ATOMIC_RELAXED, __HIP_MEMORY_SCOPE_AGENT);
        if (wid == 0) {
            unsigned sp_ = 0;
            while ((unsigned)__builtin_amdgcn_readfirstlane(__hip_atomic_load(cnt + 16 * u.pm, __ATOMIC_RELAXED, __HIP_MEMORY_SCOPE_AGENT)) < 16u) { __builtin_amdgcn_s_sleep(1); if (++sp_ > (1u << 22)) break; }
            __builtin_amdgcn_fence(__ATOMIC_ACQUIRE, "agent");
        }
        asm volatile("s_waitcnt vmcnt(0) lgkmcnt(0)" ::: "memory"); __builtin_amdgcn_s_barrier(); asm volatile("" ::: "memory");
        if (t < 256) { float s4 = 0.f;
#pragma unroll
            for (int p = 0; p < 4; ++p) s4 += __hip_atomic_load(ss + (size_t)p * M + u.pm * BM + t, __ATOMIC_RELAXED, __HIP_MEMORY_SCOPE_AGENT);
            const float ms = s4 * (1.0f / D) + EPS, sq = sqrtf(ms);
            Rt[t] = 1.0f / sq;
            if (!FINAL && u.pn == 0) rs_out[u.pm * BM + t] = sq; }
        f32x4 gv[4];
#pragma unroll
        for (int k = 0; k < 4; ++k) gv[k] = (f32x4){1.f, 1.f, 1.f, 1.f};
        if constexpr (FINAL) {
#pragma unroll
            for (int bj = 0; bj < 2; ++bj) { gv[2 * bj] = *(const f32x4*)(gain + col0 + bj * HALF); gv[2 * bj + 1] = *(const f32x4*)(gain + col0 + bj * HALF + 4); } }
        LDS_WAIT(); __builtin_amdgcn_s_barrier(); asm volatile("" ::: "memory");
#pragma unroll
        for (int gi = 0; gi < 8; ++gi) { const int ai = gi >> 2, m = gi & 3; const int rl = ai * HALF + wr * 64 + m * 16 + fr; const float r = Rt[rl];
            const size_t off = (size_t)(u.pm * BM + rl) * D + col0;
#pragma unroll
            for (int bj = 0; bj < 2; ++bj) { const f32x4 o0 = acc[ai][bj][m][0] * r * gv[2 * bj], o1 = acc[ai][bj][m][1] * r * gv[2 * bj + 1];
                if constexpr (!FINAL) { u32x4 w; w.x = cvt_pk_bf16(o0[0], o0[1]); w.y = cvt_pk_bf16(o0[2], o0[3]); w.z = cvt_pk_bf16(o1[0], o1[1]); w.w = cvt_pk_bf16(o1[2], o1[3]); *(u32x4*)(xn + off + bj * HALF) = w; }
                else { *(f32x4*)(out + off + bj * HALF) = o0; *(f32x4*)(out + off + bj * HALF + 4) = o1; } } }
    }
};
}

#define XB_TMO      128
#define XB_XCNT(j)  (256  + 64 * (j))
#define XB_XSUB(j)  (1280 + 64 * (j))
#define XB_XGEN(j)  (2304 + 64 * (j))
#define XB_TOP      3328
#define XB_TOPGEN   3392
#define XCD_BAR_WORDS 3456
#define XB_SPIN_CAP (1u << 18)
__device__ __forceinline__ unsigned xb_ld(unsigned* p)              { return __hip_atomic_load(p, __ATOMIC_RELAXED, __HIP_MEMORY_SCOPE_AGENT); }
__device__ __forceinline__ unsigned xb_add(unsigned* p, unsigned v) { return __hip_atomic_fetch_add(p, v, __ATOMIC_RELAXED, __HIP_MEMORY_SCOPE_AGENT); }
__device__ __forceinline__ unsigned xb_xcc_id() { return (unsigned)__builtin_amdgcn_s_getreg((3 << 11) | 20) & 0xFu; }
#define XB_SPIN(cond, bar) do { unsigned _sp = 0; while (cond) { __builtin_amdgcn_s_sleep(1); \
    if ((++_sp & 255u) == 0u) { if (xb_ld(&(bar)[XB_TMO])) break; if (_sp > XB_SPIN_CAP) { atomicAdd(&(bar)[XB_TMO], 1u); break; } } } } while (0)
struct XcdBarrier { unsigned* bar; unsigned x; volatile LAS unsigned* st; };
__device__ __forceinline__ XcdBarrier xcd_barrier_post(unsigned* bar, volatile LAS unsigned* st) {
    XcdBarrier b; b.bar = bar; b.x = xb_xcc_id(); b.st = st;
    if (threadIdx.x == 0) (void)xb_add(&bar[XB_XCNT(b.x)], 1u);
    return b;
}
__device__ __forceinline__ void xcd_barrier_complete(unsigned* bar, unsigned x, unsigned& nloc, unsigned& nx) {
    const unsigned G = gridDim.x * gridDim.y * gridDim.z;
    unsigned sum, cnt, mine, sp = 0u;
    for (;;) {
        sum = 0u; cnt = 0u; mine = 0u;
#pragma unroll
        for (unsigned j = 0; j < 16; ++j) { const unsigned c = xb_ld(&bar[XB_XCNT(j)]); sum += c; cnt += (c > 0u) ? 1u : 0u; mine = (j == x) ? c : mine; }
        if (sum == G) break;
        __builtin_amdgcn_s_sleep(1);
        if ((++sp & 255u) == 0u) { if (xb_ld(&bar[XB_TMO])) break; if (sp > XB_SPIN_CAP) { atomicAdd(&bar[XB_TMO], 1u); break; } }
    }
    nloc = mine > 0u ? mine : 1u; nx = cnt > 0u ? cnt : 1u;
}
__device__ __forceinline__ void xcd_barrier(const XcdBarrier& b) {
    asm volatile("s_waitcnt vmcnt(0)" ::: "memory");
    __syncthreads();
    if (threadIdx.x == 0) {
        unsigned* bar = b.bar;
        __builtin_amdgcn_s_waitcnt(0);
        unsigned nloc = b.st[0], nx = b.st[1];
        if (nloc == 0u) { xcd_barrier_complete(bar, b.x, nloc, nx); b.st[0] = nloc; b.st[1] = nx; }
        const unsigned old = xb_add(&bar[XB_XSUB(b.x)], 1u);
        const unsigned gen = old / nloc;
        if (old + 1u == (gen + 1u) * nloc) {
            __builtin_amdgcn_fence(__ATOMIC_RELEASE, "agent");
            asm volatile("s_waitcnt vmcnt(0)" ::: "memory");
            const unsigned og = xb_add(&bar[XB_TOP], 1u);
            const unsigned tg = og / nx;
            if (og + 1u == (tg + 1u) * nx) xb_add(&bar[XB_TOPGEN], 1u);
            else XB_SPIN(xb_ld(&bar[XB_TOPGEN]) == tg, bar);
            __builtin_amdgcn_fence(__ATOMIC_ACQUIRE, "agent");
            xb_add(&bar[XB_XGEN(b.x)], 1u);
            asm volatile("s_waitcnt vmcnt(0)" ::: "memory");
        } else {
            XB_SPIN(xb_ld(&bar[XB_XGEN(b.x)]) == gen, bar);
            __builtin_amdgcn_fence(__ATOMIC_ACQUIRE, "agent");
            asm volatile("s_waitcnt vmcnt(0)" ::: "memory");
        }
    }
    __syncthreads();
}

__device__ __forceinline__ void p0_transpose_item(const float* W, int ldw, int k0, int nsrc0, int nvalid, const float* kscale, bf16* WT, int ldk, int ndst0, LAS float* scr, int lane) {
    const int n4 = (lane & 7) * 4;
    const int n4c = n4 < nvalid ? n4 : 0;
    f32x4 tv[8]; float ksv[8];
#pragma unroll
    for (int i = 0; i < 8; ++i) { const int kk = 8 * i + (lane >> 3); tv[i] = *(const f32x4*)(W + (size_t)(k0 + kk) * ldw + nsrc0 + n4c); }
    if (kscale) {
#pragma unroll
        for (int i = 0; i < 8; ++i) ksv[i] = kscale[k0 + 8 * i + (lane >> 3)];
#pragma unroll
        for (int i = 0; i < 8; ++i) tv[i] = tv[i] * ksv[i]; }
#pragma unroll
    for (int i = 0; i < 8; ++i) { const int kk = 8 * i + (lane >> 3);
        scr[kk * 33 + n4] = tv[i].x; scr[kk * 33 + n4 + 1] = tv[i].y; scr[kk * 33 + n4 + 2] = tv[i].z; scr[kk * 33 + n4 + 3] = tv[i].w; }
    LDS_WAIT(); asm volatile("" ::: "memory");
    const int c = lane & 7;
#pragma unroll
    for (int j = 0; j < 4; ++j) { const int n = (lane >> 3) + 8 * j; const LAS float* s = scr + (8 * c) * 33 + n;
        u32x4 o; o.x = pk2(s[0 * 33], s[1 * 33]); o.y = pk2(s[2 * 33], s[3 * 33]); o.z = pk2(s[4 * 33], s[5 * 33]); o.w = pk2(s[6 * 33], s[7 * 33]);
        if (n < nvalid) *(u32x4*)(WT + (size_t)(ndst0 + n) * ldk + k0 + 8 * c) = o; }
    LDS_WAIT(); asm volatile("" ::: "memory");
}

struct Args { const float* in[21]; float* out; unsigned char* ws; int ph_lo, ph_hi; };

template <int PART>
__device__ __forceinline__ void p0_prologue(const Args& a, LAS unsigned char* lds, int gw, int NGW, int wave, int lane) {
    LAS float* scr = (LAS float*)(lds + wave * 16384);
    unsigned char* ws = a.ws;
    bf16 *GU1 = (bf16*)(ws + WS_GU1), *D1 = (bf16*)(ws + WS_D1), *GU2 = (bf16*)(ws + WS_GU2), *D2 = (bf16*)(ws + WS_D2), *WIN = (bf16*)(ws + WS_WIN), *WOUT = (bf16*)(ws + WS_WOUT), *XN = (bf16*)(ws + WS_XN);
    if constexpr (PART == 0) {
        const float* gain = a.in[1];
        f32x4 gv[4];
#pragma unroll
        for (int j = 0; j < 4; ++j) gv[j] = *((const f32x4*)gain + lane + 64 * j);
        for (int m = gw; m < M; m += 4 * NGW) {
            f32x4 v[4][4];
#pragma unroll
            for (int q = 0; q < 4; ++q) { const int mm = m + q * NGW; const f32x4* xr = (const f32x4*)(a.in[0] + (size_t)(mm < M ? mm : m) * D) + lane;
#pragma unroll
                for (int j = 0; j < 4; ++j) v[q][j] = xr[64 * j]; }
#pragma unroll
            for (int q = 0; q < 4; ++q) { const int mm = m + q * NGW; float s = 0.f;
#pragma unroll
                for (int j = 0; j < 4; ++j) s += (v[q][j].x * v[q][j].x + v[q][j].y * v[q][j].y) + (v[q][j].z * v[q][j].z + v[q][j].w * v[q][j].w);
                const float sq0 = sqrtf(wave_sum(s) * (1.0f / D) + EPS), r = 1.0f / sq0;
                if (mm < M && lane == 0) ((float*)(ws + WS_RS0))[mm] = sq0;
                if (mm < M) { u32x2* o8 = (u32x2*)(XN + (size_t)mm * D) + lane;
#pragma unroll
                    for (int j = 0; j < 4; ++j) { u32x2 w; w.x = pk2(v[q][j].x * r * gv[j].x, v[q][j].y * r * gv[j].y); w.y = pk2(v[q][j].z * r * gv[j].z, v[q][j].w * r * gv[j].w); o8[64 * j] = w; } } }
        }
    }
    constexpr int I_GU = 16 * 88, I_DN = 44 * 32, I_IN = 16 * 113, I_OUT = 16 * 32;
    if constexpr (PART == 0) {
    for (int it = gw; it < 4 * I_GU; it += NGW) {
        int r = it; const int which = r / I_GU; r -= which * I_GU; const int kb = r / 88, nb = r % 88, j0 = 32 * nb;
        const float* W = a.in[which == 0 ? 2 : which == 1 ? 3 : which == 2 ? 17 : 18];
        const float* ks = which >= 2 ? a.in[16] : nullptr;
        bf16* WT = which >= 2 ? GU2 : GU1;
        p0_transpose_item(W, FF, 64 * kb, j0, 32, ks, WT, D, 256 * (j0 >> 7) + (j0 & 127) + 128 * (which & 1), scr, lane); }
    }
    if constexpr (PART == 1 || PART == 2) {
    for (int it = gw; it < I_DN; it += NGW) { const int kb = it / 32, nb = it % 32;
        p0_transpose_item(a.in[PART == 2 ? 19 : 4], D, 64 * kb, 32 * nb, 32, nullptr, PART == 2 ? D2 : D1, FF, 32 * nb, scr, lane); }
    }
    if constexpr (PART == 1) {
    for (int it = gw; it < I_IN + I_OUT; it += NGW) {
        int r = it;
        if (r < I_IN) { const int kb = r / 113, db = r % 113;
            const int nd = 32 * db, nsrc = db < 80 ? nd : (db < 112 ? nd + 16 : 2560), nv = db < 112 ? 32 : 16;
            p0_transpose_item(a.in[6], 3600, 64 * kb, nsrc, nv, a.in[5], WIN, D, nd, scr, lane); continue; }
        r -= I_IN;
        { const int kb = r / 32, nb = r % 32;
            p0_transpose_item(a.in[15], D, 64 * kb, 32 * nb, 32, a.in[12], WOUT, MIXD, 32 * nb, scr, lane); }
    }
    for (int it = gw; it < 16 * 32; it += NGW) { const int kb = it / 32, nb = it % 32;
        p0_transpose_item(a.in[15] + (size_t)1024 * D, D, 64 * kb, 32 * nb, 32, nullptr, (bf16*)(ws + WS_FA) + (size_t)(kb >> 2) * 1024 * 256 - (size_t)(kb >> 2) * 256, 256, 32 * nb, scr, lane); }
    { bf16* FB = (bf16*)(ws + WS_FB);
      for (int i = gw * 64 + lane; i < 4 * 256 * 256 / 4; i += NGW * 64) { const int e0 = 4 * i, g = e0 >> 16, d = e0 & 255;
          const f32x4 w = *(const f32x4*)(a.in[13] + e0), sc = *(const f32x4*)(a.in[14] + 256 * g + d);
          *(u32x2*)(FB + e0) = (u32x2){pk2(w.x * sc.x, w.y * sc.y), pk2(w.z * sc.z, w.w * sc.w)}; } }
    }
}

constexpr int SB_CC = 0, SB_BC = 17408, SB_XT = 34816, SB_XD = 39424, SB_VEC = 44032, SB_STRIDE = 45056;
constexpr int SL_MM = 90112, SL_SL = 99328, SL_END = 108032;
constexpr int P272 = 272, P144 = 144;
typedef short v4i16_t __attribute__((ext_vector_type(4)));

__device__ __forceinline__ void unpack8(const u32x4 r, float (&f)[8]) { f[0] = bflo(r.x); f[1] = bfhi(r.x); f[2] = bflo(r.y); f[3] = bfhi(r.y); f[4] = bflo(r.z); f[5] = bfhi(r.z); f[6] = bflo(r.w); f[7] = bfhi(r.w); }

__device__ __forceinline__ void conv8x4(const bf16* PROJ, size_t tok0, int tseq, int col, const float* conv_w, const float* conv_b, bf16* dst, int pitch) {
    float wbc[4][8], bbc[8];
#pragma unroll
    for (int k = 0; k < 4; ++k) { const f32x4 w0 = *(const f32x4*)(conv_w + k * CONV_DIM + col - 1024), w1 = *(const f32x4*)(conv_w + k * CONV_DIM + col - 1024 + 4);
#pragma unroll
        for (int e = 0; e < 4; ++e) { wbc[k][e] = w0[e]; wbc[k][4 + e] = w1[e]; } }
    { const f32x4 w0 = *(const f32x4*)(conv_b + col - 1024), w1 = *(const f32x4*)(conv_b + col - 1024 + 4);
#pragma unroll
        for (int e = 0; e < 4; ++e) { bbc[e] = w0[e]; bbc[4 + e] = w1[e]; } }
    u32x4 rbc[7];
#pragma unroll
    for (int i = 0; i < 7; ++i) { rbc[i] = (u32x4){0u, 0u, 0u, 0u}; if (tseq - 3 + i >= 0) rbc[i] = *(const u32x4*)(PROJ + (tok0 + tseq - 3 + i) * PROJ_LD + col); }
    float ob[4][8];
#pragma unroll
    for (int j = 0; j < 4; ++j)
#pragma unroll
        for (int e = 0; e < 8; ++e) ob[j][e] = bbc[e];
#pragma unroll
    for (int i = 0; i < 7; ++i) { float f[8]; unpack8(rbc[i], f);
#pragma unroll
        for (int j = 0; j < 4; ++j) { const int k = i - j; if (k >= 0 && k < 4) {
#pragma unroll
            for (int e = 0; e < 8; ++e) ob[j][e] += wbc[k][e] * f[e]; } } }
#pragma unroll
    for (int j = 0; j < 4; ++j) {
#pragma unroll
        for (int e = 0; e < 8; ++e) ob[j][e] = silu_f(ob[j][e]);
        u32x4 w; w.x = cvt_pk_bf16(ob[j][0], ob[j][1]); w.y = cvt_pk_bf16(ob[j][2], ob[j][3]); w.z = cvt_pk_bf16(ob[j][4], ob[j][5]); w.w = cvt_pk_bf16(ob[j][6], ob[j][7]);
        *(u32x4*)(dst + (size_t)j * pitch) = w; }
}

__device__ __forceinline__ void conv_phase(const Args& a, int G, int vc) {
    const int tid = threadIdx.x, lane = tid & 63, wave = __builtin_amdgcn_readfirstlane(tid >> 6);
    const bf16* PROJ = (const bf16*)(a.ws + WS_PROJ);
    bf16* BCG = (bf16*)a.out;
    bf16* MIX = (bf16*)(a.ws + WS_MIX);
    const float* DT = (const float*)(a.ws + WS_DT);
    float* DTV = (float*)(a.ws + WS_DTV); float* CSV = (float*)(a.ws + WS_CSV);
    const float* conv_w = a.in[7]; const float* conv_b = a.in[8];
    for (int uu = 2 * vc; uu < 512; uu += 2 * G)
    for (int unit = uu; unit < uu + 2; ++unit) {
        const int b = unit >> 6, c = (unit >> 1) & 31, g = unit & 1;
        const size_t tok0 = (size_t)b * SEQ;
        { const int cg = tid & 31, tl = tid >> 5;
          conv8x4(PROJ, tok0, c * 64 + 4 * tl, B_OFF + (cg >> 4) * 256 + g * 128 + 8 * (cg & 15), conv_w, conv_b, BCG + (size_t)unit * 16384 + (4 * tl) * 256 + 8 * cg, 256); }
#pragma unroll 1
        for (int pass = 0; pass < 2; ++pass) { const int cgx = tid & 63, tlx = (tid >> 6) + 8 * pass; const int ch = g * 512 + 8 * cgx;
          conv8x4(PROJ, tok0, c * 64 + 4 * tlx, XS_OFF + ch, conv_w, conv_b, MIX + (tok0 + c * 64 + 4 * tlx) * MIXD + ch, MIXD); }
        { const int h = 8 * g + wave; const size_t tok = tok0 + c * 64 + lane;
          const float xdt = DT[tok * 16 + h] + a.in[9][h];
          const float dtv = xdt > 20.f ? xdt : log1pf(expf(xdt));
          float cs = dtv * (-expf(a.in[10][h]));
#pragma unroll
          for (int o = 1; o < 64; o <<= 1) { const float t = __shfl_up(cs, o); if (lane >= o) cs += t; }
          DTV[tok * 16 + h] = dtv; CSV[tok * 16 + h] = cs; }
    }
}

__device__ __forceinline__ void ssd_phase(LAS unsigned char* lds, const Args& a, int G, int vc) {
    const int tid = threadIdx.x, lane = tid & 63, wave = __builtin_amdgcn_readfirstlane(tid >> 6);
    const int l16 = lane & 15, quad = lane >> 4;
    const bf16* PROJ = (const bf16*)(a.ws + WS_PROJ);
    const bf16* BCG = (const bf16*)a.out;
    const float* DTV = (const float*)(a.ws + WS_DTV); const float* CSV = (const float*)(a.ws + WS_CSV);
    bf16* MIX = (bf16*)(a.ws + WS_MIX);
    float* PSS = (float*)(a.ws + WS_PSS);
    for (int item = vc; item < 256; item += G) {
        const int b = item >> 5, h = (item >> 1) & 15, ph = item & 1, g = h >> 3;
        const float Dh = a.in[11][h];
        const int xtok = tid >> 3, xc4 = tid & 7;
        const int x_ch = h * 64 + ph * 32 + 4 * xc4;
        f32x4 accS[2]; accS[0] = (f32x4){0.f, 0.f, 0.f, 0.f}; accS[1] = accS[0];
        for (int i = tid; i < (SL_END - SL_SL) / 4; i += NTHR) ((LAS unsigned*)(lds + SL_SL))[i] = 0u;
        const size_t tok0 = (size_t)b * SEQ;
        const int ti = wave >> 1, q = wave & 1;
        const int pcol = h * 64 + ph * 32 + 16 * q + 4 * quad;
        u32x4 rbA[2][4]; u32x2 xrA[2]; float dtvA[2], csA[2]; u32x2 zrA[2];
#define SSD_LOAD_RAW(c, S) do { const bf16* ub = BCG + ((size_t)(b * 32 + (c)) * 2 + g) * 16384; \
            _Pragma("unroll") for (int k = 0; k < 4; ++k) rbA[S][k] = *(const u32x4*)(ub + (size_t)(tid + 512 * k) * 8); \
            xrA[S] = *(const u32x2*)(MIX + (tok0 + (size_t)(c) * 64 + xtok) * MIXD + x_ch); \
            dtvA[S] = DTV[(tok0 + (c) * 64 + lane) * 16 + h]; csA[S] = CSV[(tok0 + (c) * 64 + lane) * 16 + h]; \
            zrA[S] = *(const u32x2*)(PROJ + (tok0 + (size_t)(c) * 64 + 16 * ti + l16) * PROJ_LD + Z_OFF + pcol); } while (0)
        SSD_LOAD_RAW(0, 0); SSD_LOAD_RAW(1, 1);
#pragma unroll 2
        for (int c = 0; c < 32; ++c) {
            const int S = c & 1;
            const float dtv = dtvA[S], cs = csA[S]; const u32x2 xr = xrA[S];
            LAS unsigned char* sb = lds + (c & 1) * SB_STRIDE;
            const float cs63 = __shfl(cs, 63);
#pragma unroll
            for (int k = 0; k < 4; ++k) { const int pp = tid + 512 * k, row = pp >> 5, c16 = pp & 31;
                *(LAS u32x4*)(sb + (c16 < 16 ? SB_BC : SB_CC) + row * P272 + 16 * (c16 & 15)) = rbA[S][k]; }
            {
                const float sd = __shfl(dtv, xtok & 63) * __expf(cs63 - __shfl(cs, xtok & 63));
                const float f[4] = {bflo(xr.x), bfhi(xr.x), bflo(xr.y), bfhi(xr.y)};
                const unsigned xb[4] = {xr.x & 0xffffu, xr.x >> 16, xr.y & 0xffffu, xr.y >> 16};
#pragma unroll
                for (int e = 0; e < 4; ++e) {
                    *(LAS unsigned short*)(sb + SB_XT + (4 * xc4 + e) * P144 + 2 * xtok) = (unsigned short)xb[e];
                    *(LAS unsigned short*)(sb + SB_XD + (4 * xc4 + e) * P144 + 2 * xtok) = (unsigned short)f2bf(f[e] * sd); }
            }
            if (wave == 0) { ((LAS float*)(sb + SB_VEC))[lane] = cs; ((LAS float*)(sb + SB_VEC))[64 + lane] = dtv; }
            const float dec = __expf(cs63);
            LDS_WAIT(); __builtin_amdgcn_s_barrier(); asm volatile("" ::: "memory");
            const size_t otok = tok0 + (size_t)c * 64 + 16 * ti + l16;
            const float zv[4] = {bflo(zrA[S].x), bfhi(zrA[S].x), bflo(zrA[S].y), bfhi(zrA[S].y)};
            if (c + 2 < 32) SSD_LOAD_RAW(c + 2, S);
            const float cs_l = ((const LAS float*)(sb + SB_VEC))[16 * ti + l16];
            bf16x8 Cf[4];
#pragma unroll
            for (int k = 0; k < 4; ++k) Cf[k] = *(const LAS bf16x8*)(sb + SB_CC + (16 * ti + l16) * P272 + (32 * k + 8 * quad) * 2);
#pragma unroll
            for (int jj = 0; jj < 2; ++jj) {
                const int j = 2 * q + jj;
                if (j <= ti) {
                    f32x4 gacc = (f32x4){0.f, 0.f, 0.f, 0.f};
#pragma unroll
                    for (int k = 0; k < 4; ++k) {
                        const bf16x8 Aop = *(const LAS bf16x8*)(sb + SB_BC + (16 * j + l16) * P272 + (32 * k + 8 * quad) * 2);
                        gacc = __builtin_amdgcn_mfma_f32_16x16x32_bf16(Aop, Cf[k], gacc, 0, 0, 0); }
                    const f32x4 cs_s = *(const LAS f32x4*)(sb + SB_VEC + (16 * j + 4 * quad) * 4), dt_s = *(const LAS f32x4*)(sb + SB_VEC + 256 + (16 * j + 4 * quad) * 4);
                    float mv[4];
#pragma unroll
                    for (int r = 0; r < 4; ++r) { const int s_ = 16 * j + 4 * quad + r, l = 16 * ti + l16;
                        float v = gacc[r] * __expf(fminf(cs_l - cs_s[r], 0.f)) * dt_s[r];
                        v = (s_ <= l) ? v : 0.f; if (s_ == l) v += Dh; mv[r] = v; }
                    *(LAS u32x2*)(lds + SL_MM + (16 * ti + l16) * P144 + (16 * j + 4 * quad) * 2) = (u32x2){cvt_pk_bf16(mv[0], mv[1]), cvt_pk_bf16(mv[2], mv[3])};
                } else if ((j >> 1) <= (ti >> 1)) {
                    *(LAS u32x2*)(lds + SL_MM + (16 * ti + l16) * P144 + (16 * j + 4 * quad) * 2) = (u32x2){0u, 0u};
                }
            }
            f32x4 y = (f32x4){0.f, 0.f, 0.f, 0.f};
#pragma unroll
            for (int k = 0; k < 4; ++k) {
                const bf16x8 Aop = *(const LAS bf16x8*)(lds + SL_SL + (16 * q + l16) * P272 + (32 * k + 8 * quad) * 2);
                y = __builtin_amdgcn_mfma_f32_16x16x32_bf16(Aop, Cf[k], y, 0, 0, 0); }
            y = y * __expf(cs_l);
#pragma unroll
            for (int t = 0; t < 2; ++t) { const int jn = 2 * ti + t;
                accS[t] = accS[t] * dec;
#pragma unroll
                for (int kk = 0; kk < 2; ++kk) {
                    LAS unsigned char* tp = sb + SB_BC + (32 * kk + 8 * quad + (l16 >> 2)) * P272 + (16 * jn + 4 * (lane & 3)) * 2;
                    const v4i16_t lo = __builtin_amdgcn_ds_read_tr16_b64_v4i16((LAS v4i16_t*)tp), hi = __builtin_amdgcn_ds_read_tr16_b64_v4i16((LAS v4i16_t*)(tp + 4 * P272));
                    const bf16x8 Aop = __builtin_shufflevector(lo, hi, 0, 1, 2, 3, 4, 5, 6, 7);
                    const bf16x8 Bop = *(const LAS bf16x8*)(sb + SB_XD + (16 * q + l16) * P144 + (32 * kk + 8 * quad) * 2);
                    accS[t] = __builtin_amdgcn_mfma_f32_16x16x32_bf16(Aop, Bop, accS[t], 0, 0, 0); } }
            LDS_WAIT(); __builtin_amdgcn_s_barrier(); asm volatile("" ::: "memory");
            for (int kk = 0; kk <= (ti >> 1); ++kk) {
                const bf16x8 Aop = *(const LAS bf16x8*)(sb + SB_XT + (16 * q + l16) * P144 + (32 * kk + 8 * quad) * 2);
                const bf16x8 Bop = *(const LAS bf16x8*)(lds + SL_MM + (16 * ti + l16) * P144 + (32 * kk + 8 * quad) * 2);
                y = __builtin_amdgcn_mfma_f32_16x16x32_bf16(Aop, Bop, y, 0, 0, 0); }
#pragma unroll
            for (int t = 0; t < 2; ++t) { const int jn = 2 * ti + t;
                *(LAS u32x2*)(lds + SL_SL + (16 * q + l16) * P272 + (16 * jn + 4 * quad) * 2) = (u32x2){cvtpk_s(accS[t][0], accS[t][1]), cvtpk_s(accS[t][2], accS[t][3])}; }
            float v[4], ssq = 0.f;
#pragma unroll
            for (int r = 0; r < 4; ++r) { v[r] = y[r] * silu_f(zv[r]); ssq += v[r] * v[r]; }
            *(u32x2*)(MIX + otok * MIXD + pcol) = (u32x2){cvt_pk_bf16(v[0], v[1]), cvt_pk_bf16(v[2], v[3])};
            ssq += __shfl_xor(ssq, 16); ssq += __shfl_xor(ssq, 32);
            PSS[(size_t)(g * 32 + (h & 7) * 4 + ph * 2 + q) * M + otok] = ssq;
        }
        LDS_WAIT(); __builtin_amdgcn_s_barrier(); asm volatile("" ::: "memory");
#undef SSD_LOAD_RAW
    }
}

template <int WIN>
__device__ __forceinline__ void pool_quads(const bf16* PROJ, bf16* MIX, int blk, int cgp, int tr) {
    for (int i = 0; i < 4; ++i) {
        const int t0 = blk * 64 + tr * 16 + 4 * i, ts0 = t0 & (SEQ - 1);
        u32x4 r[WIN + 3];
#pragma unroll
        for (int k = 0; k < WIN + 3; ++k) { const int dt = k - (WIN - 1); r[k] = (u32x4){0u, 0u, 0u, 0u};
            if (ts0 + dt >= 0) r[k] = *(const u32x4*)(PROJ + (size_t)(t0 + dt) * PROJ_LD + U_OFF + 8 * cgp); }
        float s[8];
#pragma unroll
        for (int e = 0; e < 8; ++e) s[e] = 0.f;
#pragma unroll
        for (int k = 0; k < WIN; ++k) { float f[8]; unpack8(r[k], f);
#pragma unroll
            for (int e = 0; e < 8; ++e) s[e] += f[e]; }
#pragma unroll
        for (int j = 0; j < 4; ++j) {
            float u0[8]; unpack8(r[WIN - 1 + j], u0);
            if (j > 0) { float f[8]; unpack8(r[j - 1], f);
#pragma unroll
                for (int e = 0; e < 8; ++e) s[e] += u0[e] - f[e]; }
            const int cnt = (ts0 + j + 1) < WIN ? (ts0 + j + 1) : WIN; const float inv = 1.0f / (float)cnt;
            u32x4 o; o.x = cvt_pk_bf16(s[0] * inv - u0[0], s[1] * inv - u0[1]); o.y = cvt_pk_bf16(s[2] * inv - u0[2], s[3] * inv - u0[3]);
            o.z = cvt_pk_bf16(s[4] * inv - u0[4], s[5] * inv - u0[5]); o.w = cvt_pk_bf16(s[6] * inv - u0[6], s[7] * inv - u0[7]);
            *(u32x4*)(MIX + (size_t)(t0 + j) * MIXD + 1024 + 8 * cgp) = o; }
    }
}
__device__ __forceinline__ void pool_phase(const Args& a, int G, int vc) {
    const bf16* PROJ = (const bf16*)(a.ws + WS_PROJ);
    bf16* MIX = (bf16*)(a.ws + WS_MIX);
    const int tid = threadIdx.x, lane = tid & 63, wave = __builtin_amdgcn_readfirstlane(tid >> 6);
    const int grp = wave & 3, cgp = grp * 32 + (lane & 31), tr = (wave >> 2) * 2 + (lane >> 5);
    for (int blk = vc; blk < M / 64; blk += G) {
        if (grp == 0) pool_quads<2>(PROJ, MIX, blk, cgp, tr);
        else if (grp == 1) pool_quads<4>(PROJ, MIX, blk, cgp, tr);
        else if (grp == 2) pool_quads<8>(PROJ, MIX, blk, cgp, tr);
        else pool_quads<16>(PROJ, MIX, blk, cgp, tr);
    }
}

constexpr int N_PHASES = 9;
__global__ void __launch_bounds__(NTHR, 2) hybrid_fwd(Args args) {
    extern __shared__ __attribute__((aligned(16))) unsigned char lds_raw[];
    LAS unsigned char* lds = (LAS unsigned char*)lds_raw;
    const int tid = threadIdx.x, lane = tid & 63, wave = __builtin_amdgcn_readfirstlane(tid >> 6);
    const int G = gridDim.x; const int bx = blockIdx.x; const int vcu = (G % 8 == 0) ? (bx % 8) * (G / 8) + bx / 8 : bx;
    unsigned char* ws = args.ws;
    volatile LAS unsigned* MISC = (volatile LAS unsigned*)(lds + MISC_OFF);
    if (tid < 32) MISC[tid] = 0u;
    __syncthreads();
    const int lo = args.ph_lo, hi = args.ph_hi;
#if MK_CG_SYNC
    cg::grid_group grid = cg::this_grid();
#define GRID_BAR() do { __threadfence(); grid.sync(); } while (0)
#else
    cg::grid_group grid = cg::this_grid();
    XcdBarrier bar; bar.bar = (unsigned*)(ws + WS_CTL) + CW_BAR; bar.x = 0; bar.st = nullptr;
    if (hi - lo > 1) bar = xcd_barrier_post((unsigned*)(ws + WS_CTL) + CW_BAR, MISC + 8);
    if (lo > 1000) grid.sync();
#define GRID_BAR() xcd_barrier(bar)
#endif
#define IN(k) (lo <= (k) && (k) < hi)
#define BOTH(k) (IN(k) && IN((k) + 1))
    bf16 *GU1 = (bf16*)(ws + WS_GU1), *D1 = (bf16*)(ws + WS_D1), *GU2 = (bf16*)(ws + WS_GU2), *D2 = (bf16*)(ws + WS_D2), *WIN = (bf16*)(ws + WS_WIN), *WOUT = (bf16*)(ws + WS_WOUT);
    bf16 *XN = (bf16*)(ws + WS_XN), *HID = (bf16*)(ws + WS_HID), *PROJ = (bf16*)(ws + WS_PROJ), *MIX = (bf16*)(ws + WS_MIX);
    float *SS = (float*)(ws + WS_SS), *DTB = (float*)(ws + WS_DT), *PSS = (float*)(ws + WS_PSS);

    if (IN(0)) { p0_prologue<0>(args, lds, vcu * NWAVES + wave, G * NWAVES, wave, lane); if (BOTH(0)) GRID_BAR(); }
    if (IN(1)) {
        pg8::Gemm g{XN, GU1, M, NGU, D}; pg8::StaticOrder S; S.init(M, NGU, G, bx);
        pg8::EpiSwiglu E{HID, nullptr};
        pg8::gemm_phase<pg8::EpiSwiglu, pg8::StaticOrder, pg8::NoHook, true>(lds, g, S, E, pg8::NoHook{});
        { const int first = ((M / 256) * (NGU / 256)) % G;
          if (bx >= first) p0_prologue<1>(args, lds, (bx - first) * NWAVES + wave, (G - first) * NWAVES, wave, lane); }
        if (BOTH(1)) GRID_BAR();
    }
    if (IN(2)) {
        pg8::Gemm g{HID, D1, M, D, FF}; pg8::StaticOrder S; S.init(M, D, G, bx);
        pg8::EpiResX<true, false> E{nullptr, XN, (const float*)(ws + WS_RS0), nullptr, nullptr, XN, (float*)(ws + WS_RS1), SS, (unsigned*)(ws + WS_CTL) + CW_PANEL, 0.5f, args.in[1]};
        pg8::gemm_phase<pg8::EpiResX<true, false>, pg8::StaticOrder, pg8::NoHook, false>(lds, g, S, E, pg8::NoHook{});
        if (BOTH(2)) GRID_BAR();
    }
    if (IN(3)) {
        pg8::Gemm g{XN, WIN, M, NIN, D}; pg8::StaticOrder S; S.init(M, NIN, G, bx);
        pg8::EpiProj E{PROJ, DTB, nullptr};
        pg8::gemm_phase<pg8::EpiProj, pg8::StaticOrder, pg8::NoHook, true>(lds, g, S, E, pg8::NoHook{});
        {
            pg8::Gemm gf{(const bf16*)(ws + WS_FA), (const bf16*)(ws + WS_FB), 4096, 1024, 256}; pg8::FoldOrder SF{G == 256 ? bx - 192 : bx};
            pg8::EpiFold EF{WOUT};
            pg8::gemm_phase<pg8::EpiFold, pg8::FoldOrder, pg8::NoHook, true>(lds, gf, SF, EF, pg8::NoHook{});
        }
        if (BOTH(3)) GRID_BAR();
    }
    if (IN(4)) {
        pool_phase(args, G, vcu);
        conv_phase(args, G, vcu);
        if (BOTH(4)) GRID_BAR();
    }
    if (IN(5)) {
        ssd_phase(lds, args, G, vcu);
        if (BOTH(5)) GRID_BAR();
    }
    if (IN(6)) {
        pg8::StaticOrder S; S.init(M, D, G, bx); pg8::Unit u0;
        LAS float* TAB = (LAS float*)(lds + TAB_OFF);
        if (S.next(0, u0)) {
            const int row = tid & 255, gg = tid >> 8; float s = 0.f;
            for (int k = 0; k < 32; ++k) s += PSS[(size_t)(gg * 32 + k) * M + u0.pm * 256 + row];
            TAB[512 + gg * 256 + row] = 1.0f / sqrtf(s * (1.0f / 512.0f) + EPS);
        }
        __syncthreads();
        if (tid < 256) { const float r0 = TAB[512 + tid], r1 = TAB[768 + tid]; TAB[tid] = r0 / r1; TAB[256 + tid] = r1; }
        __syncthreads();
        pg8::Gemm g{MIX, WOUT, M, D, MIXD};
        pg8::EpiResX<true, false> E{nullptr, XN, (const float*)(ws + WS_RS1), nullptr, nullptr, XN, (float*)(ws + WS_RS2), SS, (unsigned*)(ws + WS_CTL) + CW_PANEL + 1024, 1.0f, nullptr};
        pg8::ScaleHook HK{TAB, 8, 16};
        pg8::gemm_phase<pg8::EpiResX<true, false>, pg8::StaticOrder, pg8::ScaleHook, false>(lds, g, S, E, HK);
        if (BOTH(6)) GRID_BAR();
    }
    if (IN(7)) {
        pg8::Gemm g{XN, GU2, M, NGU, D}; pg8::StaticOrder S; S.init(M, NGU, G, bx);
        pg8::EpiSwiglu E{HID, nullptr};
        pg8::gemm_phase<pg8::EpiSwiglu, pg8::StaticOrder, pg8::NoHook, true>(lds, g, S, E, pg8::NoHook{});
        { const int first = ((M / 256) * (NGU / 256)) % G;
          if (bx >= first) p0_prologue<2>(args, lds, (bx - first) * NWAVES + wave, (G - first) * NWAVES, wave, lane); }
        if (BOTH(7)) GRID_BAR();
    }
    if (IN(8)) {
        pg8::Gemm g{HID, D2, M, D, FF}; pg8::StaticOrder S; S.init(M, D, G, bx);
        pg8::EpiResX<true, true> E{nullptr, XN, (const float*)(ws + WS_RS2), args.out, args.in[20], nullptr, nullptr, SS, (unsigned*)(ws + WS_CTL) + CW_PANEL + 2048, 0.5f, nullptr};
        pg8::gemm_phase<pg8::EpiResX<true, true>, pg8::StaticOrder, pg8::NoHook, false>(lds, g, S, E, pg8::NoHook{});
    }
#undef IN
#undef BOTH
}

extern "C" void kernel_launch(void* const* d_in, const int* in_sizes, int n_in, void* d_out, int out_size, void* d_ws, size_t ws_size, hipStream_t stream) {
    static int grid = 0;
    if (grid == 0) {
        if (n_in != 21 || in_sizes[0] != M * D || out_size != M * D || ws_size < WS_END) { fprintf(stderr, "kernel_launch: unexpected shapes (n_in %d, in0 %d, out %d, ws %zu)\n", n_in, n_in > 0 ? in_sizes[0] : -1, out_size, ws_size); grid = -1; return; }
        int dev = 0, cus = 0, per_cu = 0;
        if (hipGetDevice(&dev) != hipSuccess || hipDeviceGetAttribute(&cus, hipDeviceAttributeMultiprocessorCount, dev) != hipSuccess) { grid = -1; return; }
        if (hipFuncSetAttribute((const void*)hybrid_fwd, hipFuncAttributeMaxDynamicSharedMemorySize, LDS_BYTES) != hipSuccess) { fprintf(stderr, "kernel_launch: hipFuncSetAttribute failed\n"); grid = -1; return; }
        if (hipOccupancyMaxActiveBlocksPerMultiprocessor(&per_cu, (const void*)hybrid_fwd, NTHR, LDS_BYTES) != hipSuccess || per_cu < 1) { fprintf(stderr, "kernel_launch: occupancy query says %d\n", per_cu); per_cu = 1; }
        (void)hipGetLastError();
        grid = cus;
        if (grid != 256) fprintf(stderr, "kernel_launch: %d CUs; the single-unit GEMM phases expect 256\n", grid);
    }
    if (grid < 0) return;
    (void)hipMemsetAsync((char*)d_ws + WS_CTL, 0, CTL_ZERO_BYTES, stream);
    Args a{};
    for (int i = 0; i < 21; ++i) a.in[i] = (const float*)d_in[i];
    a.out = (float*)d_out; a.ws = (unsigned char*)d_ws;
#if MK_N_LAUNCHES == 1
    a.ph_lo = 0; a.ph_hi = N_PHASES;
    void* kargs[] = {&a};
    hipError_t e = hipLaunchCooperativeKernel((const void*)hybrid_fwd, dim3(grid), dim3(NTHR), kargs, LDS_BYTES, stream);
    if (e != hipSuccess) fprintf(stderr, "kernel_launch: cooperative launch failed: %s (grid %d)\n", hipGetErrorString(e), grid);
#else
    for (int p = 0; p < N_PHASES; ++p) { a.ph_lo = p; a.ph_hi = p + 1; hipLaunchKernelGGL(hybrid_fwd, dim3(grid), dim3(NTHR), LDS_BYTES, stream, a); }
#endif
}
```

```cpp
#include <hip/hip_runtime.h>
#include <hip/hip_cooperative_groups.h>
#include <cstdio>
#include <cstdint>
namespace cg = cooperative_groups;

#ifndef MK_N_LAUNCHES
#define MK_N_LAUNCHES 1
#endif
#ifndef MK_CG_SYNC
#define MK_CG_SYNC 0
#endif

#define LAS __attribute__((address_space(3)))
#define GAS __attribute__((address_space(1)))
typedef unsigned short bf16;
typedef short bf16x8 __attribute__((ext_vector_type(8)));
typedef float f32x4 __attribute__((ext_vector_type(4)));
typedef float f32x2 __attribute__((ext_vector_type(2)));
typedef unsigned u32x4 __attribute__((ext_vector_type(4)));
typedef unsigned u32x2 __attribute__((ext_vector_type(2)));

constexpr int M = 16384, SEQ = 2048, D = 1024, FF = 2816, NGU = 2 * FF, NIN = 3840, PROJ_LD = 3584, MIXD = 2048;
constexpr int Z_OFF = 0, XS_OFF = 1024, B_OFF = 2048, C_OFF = 2304, U_OFF = 2560;
constexpr int CONV_DIM = 1536;
constexpr float EPS = 1e-6f;
constexpr int NWAVES = 8, NTHR = 512;

constexpr size_t MiB = 1u << 20;
constexpr size_t WS_CTL = 0, CTL_ZERO_BYTES = 64 * 1024;
constexpr size_t WS_SS = 64 * 1024;
constexpr size_t WS_RS0 = 448 * 1024;
constexpr size_t WS_RS1 = 320 * 1024, WS_RS2 = 384 * 1024;
constexpr size_t WS_GU1 = 1 * MiB;
constexpr size_t WS_PSS = 1 * MiB;
constexpr size_t WS_D1 = 12 * MiB;
constexpr size_t WS_DT = 12 * MiB;
constexpr size_t WS_DTV = 13 * MiB;
constexpr size_t WS_CSV = 14 * MiB;
constexpr size_t WS_GU2 = WS_D1 + 5 * MiB + 512 * 1024;
constexpr size_t WS_D2 = WS_GU2 + 11 * MiB;
constexpr size_t WS_WIN = 34 * MiB;
constexpr size_t WS_WOUT = WS_WIN + 7 * MiB + 512 * 1024;
constexpr size_t WS_PROJ = 46 * MiB;
constexpr size_t WS_HID = 46 * MiB;
constexpr size_t WS_MIX = 158 * MiB;
constexpr size_t WS_FA = 158 * MiB;
constexpr size_t WS_FB = 160 * MiB;
constexpr size_t WS_XN = 222 * MiB;
constexpr size_t WS_BCG = 222 * MiB;
constexpr size_t WS_END = 254 * MiB;
constexpr int CW_BAR = 1024;
constexpr int CW_PANEL = 8192;

constexpr int RING_BYTES = 131072;
constexpr int TAB_OFF = RING_BYTES;
constexpr int MISC_OFF = TAB_OFF + 4096;
constexpr int LDS_BYTES = 147456;

__device__ __forceinline__ unsigned f2bf(float f) { unsigned u = __builtin_bit_cast(unsigned, f); return (u + 0x7fffu + ((u >> 16) & 1u)) >> 16; }
__device__ __forceinline__ unsigned cvt_pk_bf16(float lo, float hi) { unsigned r; asm volatile("v_cvt_pk_bf16_f32 %0, %1, %2" : "=v"(r) : "v"(lo), "v"(hi)); return r; }
__device__ __forceinline__ unsigned pk2(float lo, float hi) { return cvt_pk_bf16(lo, hi); }
typedef float f32x2_t __attribute__((ext_vector_type(2))); typedef __bf16 bf16x2_t __attribute__((ext_vector_type(2)));
__device__ __forceinline__ unsigned cvtpk_s(float lo, float hi) { f32x2_t v = {lo, hi}; bf16x2_t b = __builtin_convertvector(v, bf16x2_t); return __builtin_bit_cast(unsigned, b); }
__device__ __forceinline__ float bflo(unsigned u) { return __builtin_bit_cast(float, u << 16); }
__device__ __forceinline__ float bfhi(unsigned u) { return __builtin_bit_cast(float, u & 0xffff0000u); }
__device__ __forceinline__ float silu_f(float v) { return v * __builtin_amdgcn_rcpf(1.0f + __builtin_amdgcn_exp2f(-1.44269504f * v)); }
__device__ __forceinline__ float wave_sum(float v) {
#pragma unroll
    for (int o = 1; o < 64; o <<= 1) v += __shfl_xor(v, o);
    return v;
}
#define LDS_WAIT() asm volatile("s_waitcnt lgkmcnt(0)" ::: "memory")
#define VM_WAIT() asm volatile("s_waitcnt vmcnt(0)" ::: "memory")

namespace pg8 {
constexpr int BM = 256, BK = 64, HALF = 128, HTB = HALF * BK * 2, STAGE_BYTES = 8 * HTB, NXCD = 8, WGM = 8;
__host__ __device__ __forceinline__ int lds_byte(int r, int c) { const int st = (r >> 4) * 2 + (c >> 5), rr = r & 15, cc = c & 31, ob = rr * 64 + cc * 2; return st * 1024 + (ob ^ (((ob >> 9) & 1) << 5)); }
__host__ __device__ __forceinline__ void stage_rc(int b, int& R, int& C) { const int st = b / 1024, sb = b % 1024, swz = sb ^ (((sb >> 9) & 1) << 5); R = (st >> 1) * 16 + swz / 64; C = (st & 1) * 32 + (swz % 64) / 2; }
__host__ __device__ __forceinline__ int perm32(int rho) { const int n = rho >> 4, i = rho & 15; return 8 * (i >> 2) + 4 * n + (i & 3); }

struct Unit { int pm, pn; };
struct Gemm { const bf16* A; const bf16* Bt; int M, N, K; };

struct StaticOrder {
    int nM, nN, nwg, G, c;
    __host__ __device__ void init(int M_, int N_, int G_, int c_) { nM = M_ / BM; nN = N_ / BM; nwg = nM * nN; G = G_; c = c_; }
    __host__ __device__ bool next(int i, Unit& u) const {
        const long L = (long)i * G + c; if (L >= nwg) return false;
        int wgid = (int)L; { const int q = nwg / NXCD, r = nwg % NXCD, xcd = wgid % NXCD, off = wgid / NXCD; wgid = (xcd < r ? xcd * (q + 1) : r * (q + 1) + (xcd - r) * q) + off; }
        const int nig = WGM * nN, gid = wgid / nig, fm = gid * WGM, gsz = (nM - fm) < WGM ? (nM - fm) : WGM;
        u.pm = fm + ((wgid % nig) % gsz); u.pn = (wgid % nig) / gsz; return true;
    }
};

struct FoldOrder {
    int c;
    __host__ __device__ bool next(int i, Unit& u) const { const int idx = i * 64 + c; if (c < 0 || idx >= 16) return false; u.pm = idx; u.pn = idx >> 2; return true; }
};
struct NoHook { static constexpr bool ON = false; };
struct ScaleHook { static constexpr bool ON = true; const LAS float* F; int t0, t1; };

template <class Epi, class Sched, class Hook, bool ALIGN_EPI>
__device__ __forceinline__ void gemm_phase(LAS unsigned char* lds, const Gemm g, const Sched& S, const Epi& E, const Hook& HK) {
    const int tid = threadIdx.x, wid = __builtin_amdgcn_readfirstlane(tid >> 6), lane = tid & 63, wr = wid >> 2, wc = wid & 3, fr = lane & 15, fq = lane >> 4;
    const int K = g.K, nt = K / BK;
    unsigned voffA[2], voffB[2];
#pragma unroll
    for (int i = 0; i < 2; ++i) { int R, C; stage_rc(tid * 16 + i * 8192, R, C); const int Rb = (R & ~31) + perm32(R & 31);
        voffA[i] = (unsigned)(R * K + C) * 2u; voffB[i] = (unsigned)(Rb * K + C) * 2u; }
    const size_t kstep = (size_t)(BK * 2);
    const size_t hstep = (size_t)HALF * K * 2;
    const size_t tstep = 2 * hstep;
    const unsigned ldsw = (unsigned)wid * 1024u;
    const int aoff = lds_byte(wr * 64 + fr, fq * 8), boff = lds_byte(wc * 32 + fr, fq * 8);
#define PG8_SA(b, h) (((b) * 2 + (h)) * HTB)
#define PG8_SB(b, h) ((4 + (b) * 2 + (h)) * HTB)
#define PG8_STAGE(bufoff, gbase, voff) do { _Pragma("unroll") for (int _i = 0; _i < 2; ++_i) \
        __builtin_amdgcn_global_load_lds((const unsigned*)((const char*)(gbase) + (voff)[_i]), (LAS unsigned*)(lds + (bufoff) + ldsw + _i * 8192), 16, 0, 0); } while (0)
#define PG8_LDA(dst, b, h) do { _Pragma("unroll") for (int m = 0; m < 4; ++m) _Pragma("unroll") for (int k = 0; k < 2; ++k) dst[m][k] = *(const LAS bf16x8*)(lds + PG8_SA(b, h) + aoff + m * 2048 + k * 1024); } while (0)
#define PG8_LDB(dst, b, h) do { _Pragma("unroll") for (int n = 0; n < 2; ++n) _Pragma("unroll") for (int k = 0; k < 2; ++k) dst[n][k] = *(const LAS bf16x8*)(lds + PG8_SB(b, h) + boff + n * 2048 + k * 1024); } while (0)
#define PG8_MMA(ai, bj, At, Bt) do { __builtin_amdgcn_s_setprio(1); _Pragma("unroll") for (int m = 0; m < 4; ++m) _Pragma("unroll") for (int n = 0; n < 2; ++n) _Pragma("unroll") for (int k = 0; k < 2; ++k) \
        acc[ai][bj][m][n] = __builtin_amdgcn_mfma_f32_16x16x32_bf16(Bt[n][k], At[m][k], acc[ai][bj][m][n], 0, 0, 0); __builtin_amdgcn_s_setprio(0); } while (0)
#define PG8_WAIT_V(n) asm volatile("s_waitcnt vmcnt(" #n ")" ::: "memory")
#define PG8_WAIT_L(n) asm volatile("s_waitcnt lgkmcnt(" #n ")" ::: "memory")
#define PG8_BAR __builtin_amdgcn_s_barrier()
#define PG8_SCHED __builtin_amdgcn_sched_barrier(0)
    Unit cur, nxt; int ui = 0;
    if (!S.next(0, cur)) return;
    f32x4 acc[2][2][4][2];
#pragma unroll
    for (int a = 0; a < 2; ++a)
#pragma unroll
        for (int b = 0; b < 2; ++b)
#pragma unroll
            for (int m = 0; m < 4; ++m)
#pragma unroll
                for (int n = 0; n < 2; ++n) acc[a][b][m][n] = (f32x4){0.f, 0.f, 0.f, 0.f};
    bf16x8 At[4][2], B0[2][2], B1[2][2];
    const char* cA = (const char*)g.A + (size_t)cur.pm * tstep; const char* cB = (const char*)g.Bt + (size_t)cur.pn * tstep;
    PG8_STAGE(PG8_SB(0, 0), cB, voffB); PG8_STAGE(PG8_SB(0, 1), cB + hstep, voffB); PG8_STAGE(PG8_SA(0, 0), cA, voffA); PG8_STAGE(PG8_SA(0, 1), cA + hstep, voffA);
    if (wr == 1) PG8_BAR;
    PG8_WAIT_V(2); PG8_BAR;
    PG8_STAGE(PG8_SB(1, 0), cB + kstep, voffB); PG8_STAGE(PG8_SA(1, 0), cA + kstep, voffA); PG8_STAGE(PG8_SB(1, 1), cB + hstep + kstep, voffB);
    PG8_WAIT_V(6); PG8_BAR;
    for (;;) {
        const bool has_next = S.next(ui + 1, nxt);
        const char* nA = has_next ? (const char*)g.A + (size_t)nxt.pm * tstep : cA; const char* nB = has_next ? (const char*)g.Bt + (size_t)nxt.pn * tstep : cB;
        for (int t = 0; t < nt; t += 2) {
            const bool last = (t == nt - 2);
            const char* a1 = cA + (size_t)(t + 1) * kstep;
            const char* a2 = last ? nA : cA + (size_t)(t + 2) * kstep; const char* b2 = last ? nB : cB + (size_t)(t + 2) * kstep;
            const char* a3 = a2 + kstep; const char* b3 = b2 + kstep;
            if constexpr (Hook::ON) {
                if (t == HK.t0 || t == HK.t1) {
                    const LAS float* Fp = HK.F + (t == HK.t1 ? 256 : 0);
#pragma unroll
                    for (int ai = 0; ai < 2; ++ai)
#pragma unroll
                        for (int m = 0; m < 4; ++m) { const float f = Fp[ai * HALF + wr * 64 + m * 16 + fr];
#pragma unroll
                            for (int bj = 0; bj < 2; ++bj)
#pragma unroll
                                for (int n = 0; n < 2; ++n) acc[ai][bj][m][n] = acc[ai][bj][m][n] * f; }
                }
            }
            PG8_LDB(B0, 0, 0); PG8_LDB(B1, 0, 1); PG8_SCHED; PG8_LDA(At, 0, 0); PG8_STAGE(PG8_SA(1, 1), a1 + hstep, voffA);
            PG8_WAIT_V(8); PG8_WAIT_L(0); PG8_BAR; PG8_MMA(0, 0, At, B0); PG8_MMA(0, 1, At, B1); PG8_BAR; PG8_SCHED;
            PG8_LDA(At, 0, 1); PG8_STAGE(PG8_SB(0, 0), b2, voffB); PG8_STAGE(PG8_SB(0, 1), b2 + hstep, voffB); PG8_STAGE(PG8_SA(0, 0), a2, voffA);
            PG8_WAIT_V(8); PG8_WAIT_L(0); PG8_BAR; PG8_MMA(1, 0, At, B0); PG8_MMA(1, 1, At, B1); PG8_BAR; PG8_SCHED;
            PG8_LDB(B0, 1, 0); PG8_LDB(B1, 1, 1); PG8_SCHED; PG8_LDA(At, 1, 0); PG8_STAGE(PG8_SA(0, 1), a2 + hstep, voffA);
            PG8_WAIT_V(8); PG8_WAIT_L(0); PG8_BAR; PG8_MMA(0, 0, At, B0); PG8_MMA(0, 1, At, B1); PG8_BAR; PG8_SCHED;
            PG8_LDA(At, 1, 1); PG8_STAGE(PG8_SB(1, 0), b3, voffB); PG8_STAGE(PG8_SB(1, 1), b3 + hstep, voffB); PG8_STAGE(PG8_SA(1, 0), a3, voffA);
            PG8_WAIT_V(8); PG8_WAIT_L(0); PG8_BAR; PG8_MMA(1, 0, At, B0); PG8_MMA(1, 1, At, B1); PG8_BAR; PG8_SCHED;
        }
        if constexpr (ALIGN_EPI) { if (wr == 0) PG8_BAR; }
        if constexpr (!Epi::AFTER_DRAIN) { E(acc, cur, wr, wc, fr, fq); }
        if (!has_next) break;
#pragma unroll
        for (int a = 0; a < 2; ++a)
#pragma unroll
            for (int b = 0; b < 2; ++b)
#pragma unroll
                for (int m = 0; m < 4; ++m)
#pragma unroll
                    for (int n = 0; n < 2; ++n) acc[a][b][m][n] = (f32x4){0.f, 0.f, 0.f, 0.f};
        cur = nxt; cA = nA; cB = nB; ++ui;
        if constexpr (ALIGN_EPI) { if (wr == 1) PG8_BAR; }
    }
    PG8_WAIT_V(0);
    if constexpr (!ALIGN_EPI) { if (wr == 0) PG8_BAR; }
    PG8_BAR;
    if constexpr (Epi::AFTER_DRAIN) { E.fused(acc, cur, wr, wc, fr, fq, lds, wid, lane); }
#undef PG8_SA
#undef PG8_SB
#undef PG8_STAGE
#undef PG8_LDA
#undef PG8_LDB
#undef PG8_MMA
#undef PG8_WAIT_V
#undef PG8_WAIT_L
#undef PG8_BAR
#undef PG8_SCHED
}

__device__ __forceinline__ float row_rstd4(const float* ss, int row) {
    const float s = (ss[row] + ss[M + row]) + (ss[2 * M + row] + ss[3 * M + row]);
    return 1.0f / sqrtf(s * (1.0f / D) + EPS);
}

struct EpiSwiglu {
    static constexpr bool AFTER_DRAIN = false;
    bf16* H; const float* ss;
    __device__ __forceinline__ void operator()(const f32x4 (&acc)[2][2][4][2], const Unit& u, int wr, int wc, int fr, int fq) const {
        const int row0 = u.pm * BM + wr * 64 + fr, col0 = u.pn * HALF + wc * 32 + 8 * fq;
        float r8[8];
#pragma unroll
        for (int gi = 0; gi < 8; ++gi) r8[gi] = ss ? row_rstd4(ss, row0 + (gi >> 2) * HALF + (gi & 3) * 16) : 1.0f;
#pragma unroll
        for (int ai = 0; ai < 2; ++ai)
#pragma unroll
            for (int m = 0; m < 4; ++m) { const int row = row0 + ai * HALF + m * 16;
                const float r = r8[ai * 4 + m];
                float h[8];
#pragma unroll
                for (int n = 0; n < 2; ++n)
#pragma unroll
                    for (int j = 0; j < 4; ++j) { const float gv = acc[ai][0][m][n][j] * r, uv = acc[ai][1][m][n][j] * r; h[4 * n + j] = silu_f(gv) * uv; }
                u32x4 w; w.x = cvt_pk_bf16(h[0], h[1]); w.y = cvt_pk_bf16(h[2], h[3]); w.z = cvt_pk_bf16(h[4], h[5]); w.w = cvt_pk_bf16(h[6], h[7]);
                *(u32x4*)(H + (size_t)row * FF + col0) = w; }
    }
};
struct EpiProj {
    static constexpr bool AFTER_DRAIN = false;
    bf16* P; float* DT; const float* ss;
    __device__ __forceinline__ void operator()(const f32x4 (&acc)[2][2][4][2], const Unit& u, int wr, int wc, int fr, int fq) const {
        const int row0 = u.pm * BM + wr * 64 + fr;
        float r8[8];
#pragma unroll
        for (int gi = 0; gi < 8; ++gi) r8[gi] = ss ? row_rstd4(ss, row0 + (gi >> 2) * HALF + (gi & 3) * 16) : 1.0f;
        if (u.pn < 14) {
            const int col0 = u.pn * BM + wc * 32 + 8 * fq;
#pragma unroll
            for (int ai = 0; ai < 2; ++ai)
#pragma unroll
                for (int m = 0; m < 4; ++m) { const int row = row0 + ai * HALF + m * 16; const float r = r8[ai * 4 + m];
#pragma unroll
                    for (int bj = 0; bj < 2; ++bj) { const f32x4 v0 = acc[ai][bj][m][0] * r, v1 = acc[ai][bj][m][1] * r;
                        u32x4 w; w.x = cvtpk_s(v0[0], v0[1]); w.y = cvtpk_s(v0[2], v0[3]); w.z = cvtpk_s(v1[0], v1[1]); w.w = cvtpk_s(v1[2], v1[3]);
                        *(u32x4*)(P + (size_t)row * PROJ_LD + col0 + bj * HALF) = w; } }
        } else if (wc == 0 && fq < 2) {
#pragma unroll
            for (int ai = 0; ai < 2; ++ai)
#pragma unroll
                for (int m = 0; m < 4; ++m) { const int row = row0 + ai * HALF + m * 16; const float r = r8[ai * 4 + m];
                    *(f32x4*)(DT + (size_t)row * 16 + 8 * fq) = acc[ai][0][m][0] * r; *(f32x4*)(DT + (size_t)row * 16 + 8 * fq + 4) = acc[ai][0][m][1] * r; }
        }
    }
};
struct EpiFold {
    static constexpr bool AFTER_DRAIN = false;
    bf16* WO;
    __device__ __forceinline__ void operator()(const f32x4 (&acc)[2][2][4][2], const Unit& u, int wr, int wc, int fr, int fq) const {
        const int g = u.pm >> 2, n0 = (u.pm & 3) * BM + wr * 64 + fr, col0 = 1024 + 256 * g + wc * 32 + 8 * fq;
#pragma unroll
        for (int ai = 0; ai < 2; ++ai)
#pragma unroll
            for (int m = 0; m < 4; ++m) { const int n = n0 + ai * HALF + m * 16;
#pragma unroll
                for (int bj = 0; bj < 2; ++bj) { const f32x4 v0 = acc[ai][bj][m][0], v1 = acc[ai][bj][m][1];
                    u32x4 w; w.x = cvtpk_s(v0[0], v0[1]); w.y = cvtpk_s(v0[2], v0[3]); w.z = cvtpk_s(v1[0], v1[1]); w.w = cvtpk_s(v1[2], v1[3]);
                    *(u32x4*)(WO + (size_t)n * MIXD + col0 + bj * HALF) = w; } }
    }
};
struct EpiRes {
    static constexpr bool AFTER_DRAIN = true;
    const float* base; float* out; bf16* xn; float* ss; float scale;
    __device__ __forceinline__ void fused(const f32x4 (&acc)[2][2][4][2], const Unit& u, int wr, int wc, int fr, int fq, LAS unsigned char* lds, int wid, int lane) const {
        LAS float* Pt = (LAS float*)lds;
        const int row0 = u.pm * BM + wr * 64 + fr, col0 = u.pn * BM + wc * 32 + 8 * fq;
        f32x4 bq[3][4];
#pragma unroll
        for (int pg = 0; pg < 2; ++pg) { const size_t off = (size_t)(row0 + (pg >> 2) * HALF + (pg & 3) * 16) * D + col0;
#pragma unroll
          for (int bj = 0; bj < 2; ++bj) { bq[pg][2 * bj] = *(const f32x4*)(base + off + bj * HALF); bq[pg][2 * bj + 1] = *(const f32x4*)(base + off + bj * HALF + 4); } }
#pragma unroll
        for (int gi = 0; gi < 8; ++gi) { const int ai = gi >> 2, m = gi & 3;
            const int row = row0 + ai * HALF + m * 16; const size_t off = (size_t)row * D + col0; float q = 0.f;
            if (gi < 6) { const int ai2 = (gi + 2) >> 2, m2 = (gi + 2) & 3; const size_t off2 = (size_t)(row0 + ai2 * HALF + m2 * 16) * D + col0;
#pragma unroll
                for (int bj = 0; bj < 2; ++bj) { bq[(gi + 2) % 3][2 * bj] = *(const f32x4*)(base + off2 + bj * HALF); bq[(gi + 2) % 3][2 * bj + 1] = *(const f32x4*)(base + off2 + bj * HALF + 4); } }
            f32x4 bc[4];
#pragma unroll
            for (int k = 0; k < 4; ++k) bc[k] = bq[gi % 3][k];
#pragma unroll
            for (int bj = 0; bj < 2; ++bj) {
                const f32x4 v0 = bc[2 * bj] + acc[ai][bj][m][0] * scale, v1 = bc[2 * bj + 1] + acc[ai][bj][m][1] * scale;
                *(f32x4*)(out + off + bj * HALF) = v0; *(f32x4*)(out + off + bj * HALF + 4) = v1;
                if (xn) { u32x4 w; w.x = cvt_pk_bf16(v0[0], v0[1]); w.y = cvt_pk_bf16(v0[2], v0[3]); w.z = cvt_pk_bf16(v1[0], v1[1]); w.w = cvt_pk_bf16(v1[2], v1[3]);
                    *(u32x4*)(xn + off + bj * HALF) = w; }
                q += (v0[0] * v0[0] + v0[1] * v0[1]) + (v0[2] * v0[2] + v0[3] * v0[3]) + (v1[0] * v1[0] + v1[1] * v1[1]) + (v1[2] * v1[2] + v1[3] * v1[3]); }
            q += __shfl_xor(q, 16); q += __shfl_xor(q, 32);
            if (fq == 0) Pt[(ai * HALF + wr * 64 + m * 16 + fr) * 4 + wc] = q; }
        LDS_WAIT(); __builtin_amdgcn_s_barrier(); asm volatile("" ::: "memory");
        const int t = wid * 64 + lane;
        if (t < 256) { const float s = (Pt[t * 4 + 0] + Pt[t * 4 + 1]) + (Pt[t * 4 + 2] + Pt[t * 4 + 3]); ss[(size_t)u.pn * M + u.pm * BM + t] = s; }
    }
};
struct EpiResNorm {
    static constexpr bool AFTER_DRAIN = true;
    const float* base; float* out; const float* gain; bf16* xn; float* ss; unsigned* cnt; float scale;
    __device__ __forceinline__ void fused(f32x4 (&acc)[2][2][4][2], const Unit& u, int wr, int wc, int fr, int fq, LAS unsigned char* lds, int wid, int lane) const {
        LAS float* Pt = (LAS float*)lds;
        LAS float* Rt = (LAS float*)(lds + 4096);
        const int row0 = u.pm * BM + wr * 64 + fr, col0 = u.pn * BM + wc * 32 + 8 * fq;
        f32x4 bq[3][4];
#pragma unroll
        for (int pg = 0; pg < 2; ++pg) { const size_t off = (size_t)(row0 + (pg >> 2) * HALF + (pg & 3) * 16) * D + col0;
#pragma unroll
          for (int bj = 0; bj < 2; ++bj) { bq[pg][2 * bj] = *(const f32x4*)(base + off + bj * HALF); bq[pg][2 * bj + 1] = *(const f32x4*)(base + off + bj * HALF + 4); } }
#pragma unroll
        for (int gi = 0; gi < 8; ++gi) { const int ai = gi >> 2, m = gi & 3; float q = 0.f;
            if (gi < 6) { const int ai2 = (gi + 2) >> 2, m2 = (gi + 2) & 3; const size_t off2 = (size_t)(row0 + ai2 * HALF + m2 * 16) * D + col0;
#pragma unroll
                for (int bj = 0; bj < 2; ++bj) { bq[(gi + 2) % 3][2 * bj] = *(const f32x4*)(base + off2 + bj * HALF); bq[(gi + 2) % 3][2 * bj + 1] = *(const f32x4*)(base + off2 + bj * HALF + 4); } }
            f32x4 bc[4];
#pragma unroll
            for (int k = 0; k < 4; ++k) bc[k] = bq[gi % 3][k];
#pragma unroll
            for (int bj = 0; bj < 2; ++bj) {
                const f32x4 v0 = bc[2 * bj] + acc[ai][bj][m][0] * scale, v1 = bc[2 * bj + 1] + acc[ai][bj][m][1] * scale;
                acc[ai][bj][m][0] = v0; acc[ai][bj][m][1] = v1;
                if (xn) { const size_t offo = (size_t)(row0 + ai * HALF + m * 16) * D + col0 + bj * HALF; *(f32x4*)(out + offo) = v0; *(f32x4*)(out + offo + 4) = v1; }
                q += (v0[0] * v0[0] + v0[1] * v0[1]) + (v0[2] * v0[2] + v0[3] * v0[3]) + (v1[0] * v1[0] + v1[1] * v1[1]) + (v1[2] * v1[2] + v1[3] * v1[3]); }
            q += __shfl_xor(q, 16); q += __shfl_xor(q, 32);
            if (fq == 0) Pt[(ai * HALF + wr * 64 + m * 16 + fr) * 4 + wc] = q; }
        LDS_WAIT(); __builtin_amdgcn_s_barrier(); asm volatile("" ::: "memory");
        const int t = wid * 64 + lane;
        if (t < 256) { const float sp = (Pt[t * 4 + 0] + Pt[t * 4 + 1]) + (Pt[t * 4 + 2] + Pt[t * 4 + 3]);
            __hip_atomic_store(ss + (size_t)u.pn * M + u.pm * BM + t, sp, __ATOMIC_RELAXED, __HIP_MEMORY_SCOPE_AGENT); }
        asm volatile("s_waitcnt vmcnt(0)" ::: "memory");
        if (t < 256 && lane == 0) __hip_atomic_fetch_add(cnt + 16 * u.pm, 1u, __ATOMIC_RELAXED, __HIP_MEMORY_SCOPE_AGENT);
        if (wid == 0) {
            unsigned sp_ = 0;
            while ((unsigned)__builtin_amdgcn_readfirstlane(__hip_atomic_load(cnt + 16 * u.pm, __ATOMIC_RELAXED, __HIP_MEMORY_SCOPE_AGENT)) < 16u) { __builtin_amdgcn_s_sleep(1); if (++sp_ > (1u << 22)) break; }
            __builtin_amdgcn_fence(__ATOMIC_ACQUIRE, "agent");
        }
        asm volatile("s_waitcnt vmcnt(0) lgkmcnt(0)" ::: "memory"); __builtin_amdgcn_s_barrier(); asm volatile("" ::: "memory");
        if (t < 256) { float s4 = 0.f;
#pragma unroll
            for (int p = 0; p < 4; ++p) s4 += __hip_atomic_load(ss + (size_t)p * M + u.pm * BM + t, __ATOMIC_RELAXED, __HIP_MEMORY_SCOPE_AGENT);
            Rt[t] = 1.0f / sqrtf(s4 * (1.0f / D) + EPS); }
        f32x4 gv[4];
#pragma unroll
        for (int k = 0; k < 4; ++k) gv[k] = (f32x4){1.f, 1.f, 1.f, 1.f};
        if (!xn) {
#pragma unroll
            for (int bj = 0; bj < 2; ++bj) { gv[2 * bj] = *(const f32x4*)(gain + col0 + bj * HALF); gv[2 * bj + 1] = *(const f32x4*)(gain + col0 + bj * HALF + 4); } }
        LDS_WAIT(); __builtin_amdgcn_s_barrier(); asm volatile("" ::: "memory");
#pragma unroll
        for (int gi = 0; gi < 8; ++gi) { const int ai = gi >> 2, m = gi & 3; const int rl = ai * HALF + wr * 64 + m * 16 + fr; const float r = Rt[rl];
            const size_t off = (size_t)(u.pm * BM + rl) * D + col0;
#pragma unroll
            for (int bj = 0; bj < 2; ++bj) { const f32x4 o0 = acc[ai][bj][m][0] * r * gv[2 * bj], o1 = acc[ai][bj][m][1] * r * gv[2 * bj + 1];
                if (xn) { u32x4 w; w.x = cvt_pk_bf16(o0[0], o0[1]); w.y = cvt_pk_bf16(o0[2], o0[3]); w.z = cvt_pk_bf16(o1[0], o1[1]); w.w = cvt_pk_bf16(o1[2], o1[3]); *(u32x4*)(xn + off + bj * HALF) = w; }
                else { *(f32x4*)(out + off + bj * HALF) = o0; *(f32x4*)(out + off + bj * HALF + 4) = o1; } } }
    }
};
template <bool BASE_BF16, bool FINAL>
struct EpiResX {
    static constexpr bool AFTER_DRAIN = true;
    const float* base; const bf16* bbn; const float* brs; float* out; const float* gain; bf16* xn; float* rs_out; float* ss; unsigned* cnt; float scale; const float* cgain;
    __device__ __forceinline__ void fused(f32x4 (&acc)[2][2][4][2], const Unit& u, int wr, int wc, int fr, int fq, LAS unsigned char* lds, int wid, int lane) const {
        LAS float* Pt = (LAS float*)lds;
        LAS float* Rt = (LAS float*)(lds + 4096);
        const int row0 = u.pm * BM + wr * 64 + fr, col0 = u.pn * BM + wc * 32 + 8 * fq;
        float inv8[8];
#pragma unroll
        for (int gi = 0; gi < 8; ++gi) inv8[gi] = BASE_BF16 ? brs[row0 + (gi >> 2) * HALF + (gi & 3) * 16] : 1.0f;
        f32x4 ci[4];
#pragma unroll
        for (int k = 0; k < 4; ++k) ci[k] = (f32x4){1.f, 1.f, 1.f, 1.f};
        if (BASE_BF16 && cgain) {
#pragma unroll
            for (int k = 0; k < 4; ++k) { const f32x4 gq = *(const f32x4*)(cgain + col0 + (k >> 1) * HALF + (k & 1) * 4); ci[k] = (f32x4){1.0f / gq[0], 1.0f / gq[1], 1.0f / gq[2], 1.0f / gq[3]}; } }
        f32x4 bq[3][4]; u32x4 bqb[3][2];
#define ERX_LOAD(slot, g_) do { const size_t off_ = (size_t)(row0 + ((g_) >> 2) * HALF + ((g_) & 3) * 16) * D + col0; \
            if constexpr (BASE_BF16) { bqb[slot][0] = *(const u32x4*)(bbn + off_); bqb[slot][1] = *(const u32x4*)(bbn + off_ + HALF); } \
            else { _Pragma("unroll") for (int bj_ = 0; bj_ < 2; ++bj_) { bq[slot][2 * bj_] = *(const f32x4*)(base + off_ + bj_ * HALF); bq[slot][2 * bj_ + 1] = *(const f32x4*)(base + off_ + bj_ * HALF + 4); } } } while (0)
        ERX_LOAD(0, 0); ERX_LOAD(1, 1);
#pragma unroll
        for (int gi = 0; gi < 8; ++gi) { const int ai = gi >> 2, m = gi & 3; float q = 0.f;
            if (gi < 6) ERX_LOAD((gi + 2) % 3, gi + 2);
            f32x4 bc[4];
            if constexpr (BASE_BF16) { const float iv = inv8[gi];
#pragma unroll
                for (int bj = 0; bj < 2; ++bj) { const u32x4 w = bqb[gi % 3][bj];
                    bc[2 * bj] = (f32x4){bflo(w.x), bfhi(w.x), bflo(w.y), bfhi(w.y)} * iv * ci[2 * bj]; bc[2 * bj + 1] = (f32x4){bflo(w.z), bfhi(w.z), bflo(w.w), bfhi(w.w)} * iv * ci[2 * bj + 1]; }
            } else {
#pragma unroll
                for (int k = 0; k < 4; ++k) bc[k] = bq[gi % 3][k]; }
#pragma unroll
            for (int bj = 0; bj < 2; ++bj) {
                const f32x4 v0 = bc[2 * bj] + acc[ai][bj][m][0] * scale, v1 = bc[2 * bj + 1] + acc[ai][bj][m][1] * scale;
                acc[ai][bj][m][0] = v0; acc[ai][bj][m][1] = v1;
                q += (v0[0] * v0[0] + v0[1] * v0[1]) + (v0[2] * v0[2] + v0[3] * v0[3]) + (v1[0] * v1[0] + v1[1] * v1[1]) + (v1[2] * v1[2] + v1[3] * v1[3]); }
            q += __shfl_xor(q, 16); q += __shfl_xor(q, 32);
            if (fq == 0) Pt[(ai * HALF + wr * 64 + m * 16 + fr) * 4 + wc] = q; }
#undef ERX_LOAD
        LDS_WAIT(); __builtin_amdgcn_s_barrier(); asm volatile("" ::: "memory");
        const int t = wid * 64 + lane;
        if (t < 256) { const float sp = (Pt[t * 4 + 0] + Pt[t * 4 + 1]) + (Pt[t * 4 + 2] + Pt[t * 4 + 3]);
            __hip_atomic_store(ss + (size_t)u.pn * M + u.pm * BM + t, sp, __ATOMIC_RELAXED, __HIP_MEMORY_SCOPE_AGENT); }
        asm volatile("s_waitcnt vmcnt(0)" ::: "memory");
        if (t < 256 && lane == 0) __hip_atomic_fetch_add(cnt + 16 * u.pm, 1u, __ATOMIC_RELAXED, __HIP_MEMORY_SCOPE_AGENT);
        if (wid == 0) {
            unsigned sp_ = 0;
            while ((unsigned)__builtin_amdgcn_readfirstlane(__hip_atomic_load(cnt + 16 * u.pm, __ATOMIC_RELAXED, __HIP_MEMORY_SCOPE_AGENT)) < 16u) { __builtin_amdgcn_s_sleep(1); if (++sp_ > (1u << 22)) break; }
            __builtin_amdgcn_fence(__ATOMIC_ACQUIRE, "agent");
        }
        asm volatile("s_waitcnt vmcnt(0) lgkmcnt(0)" ::: "memory"); __builtin_amdgcn_s_barrier(); asm volatile("" ::: "memory");
        if (t < 256) { float s4 = 0.f;
#pragma unroll
            for (int p = 0; p < 4; ++p) s4 += __hip_atomic_load(ss + (size_t)p * M + u.pm * BM + t, __ATOMIC_RELAXED, __HIP_MEMORY_SCOPE_AGENT);
            const float ms = s4 * (1.0f / D) + EPS, sq = sqrtf(ms);
            Rt[t] = 1.0f / sq;
            if (!FINAL && u.pn == 0) rs_out[u.pm * BM + t] = sq; }
        f32x4 gv[4];
#pragma unroll
        for (int k = 0; k < 4; ++k) gv[k] = (f32x4){1.f, 1.f, 1.f, 1.f};
        if constexpr (FINAL) {
#pragma unroll
            for (int bj = 0; bj < 2; ++bj) { gv[2 * bj] = *(const f32x4*)(gain + col0 + bj * HALF); gv[2 * bj + 1] = *(const f32x4*)(gain + col0 + bj * HALF + 4); } }
        LDS_WAIT(); __builtin_amdgcn_s_barrier(); asm volatile("" ::: "memory");
#pragma unroll
        for (int gi = 0; gi < 8; ++gi) { const int ai = gi >> 2, m = gi & 3; const int rl = ai * HALF + wr * 64 + m * 16 + fr; const float r = Rt[rl];
            const size_t off = (size_t)(u.pm * BM + rl) * D + col0;
#pragma unroll
            for (int bj = 0; bj < 2; ++bj) { const f32x4 o0 = acc[ai][bj][m][0] * r * gv[2 * bj], o1 = acc[ai][bj][m][1] * r * gv[2 * bj + 1];
                if constexpr (!FINAL) { u32x4 w; w.x = cvt_pk_bf16(o0[0], o0[1]); w.y = cvt_pk_bf16(o0[2], o0[3]); w.z = cvt_pk_bf16(o1[0], o1[1]); w.w = cvt_pk_bf16(o1[2], o1[3]); *(u32x4*)(xn + off + bj * HALF) = w; }
                else { *(f32x4*)(out + off + bj * HALF) = o0; *(f32x4*)(out + off + bj * HALF + 4) = o1; } } }
    }
};
}

#define XB_TMO      128
#define XB_XCNT(j)  (256  + 64 * (j))
#define XB_XSUB(j)  (1280 + 64 * (j))
#define XB_XGEN(j)  (2304 + 64 * (j))
#define XB_TOP      3328
#define XB_TOPGEN   3392
#define XCD_BAR_WORDS 3456
#define XB_SPIN_CAP (1u << 18)
__device__ __forceinline__ unsigned xb_ld(unsigned* p)              { return __hip_atomic_load(p, __ATOMIC_RELAXED, __HIP_MEMORY_SCOPE_AGENT); }
__device__ __forceinline__ unsigned xb_add(unsigned* p, unsigned v) { return __hip_atomic_fetch_add(p, v, __ATOMIC_RELAXED, __HIP_MEMORY_SCOPE_AGENT); }
__device__ __forceinline__ unsigned xb_xcc_id() { return (unsigned)__builtin_amdgcn_s_getreg((3 << 11) | 20) & 0xFu; }
#define XB_SPIN(cond, bar) do { unsigned _sp = 0; while (cond) { __builtin_amdgcn_s_sleep(1); \
    if ((++_sp & 255u) == 0u) { if (xb_ld(&(bar)[XB_TMO])) break; if (_sp > XB_SPIN_CAP) { atomicAdd(&(bar)[XB_TMO], 1u); break; } } } } while (0)
struct XcdBarrier { unsigned* bar; unsigned x; volatile LAS unsigned* st; };
__device__ __forceinline__ XcdBarrier xcd_barrier_post(unsigned* bar, volatile LAS unsigned* st) {
    XcdBarrier b; b.bar = bar; b.x = xb_xcc_id(); b.st = st;
    if (threadIdx.x == 0) (void)xb_add(&bar[XB_XCNT(b.x)], 1u);
    return b;
}
__device__ __forceinline__ void xcd_barrier_complete(unsigned* bar, unsigned x, unsigned& nloc, unsigned& nx) {
    const unsigned G = gridDim.x * gridDim.y * gridDim.z;
    unsigned sum, cnt, mine, sp = 0u;
    for (;;) {
        sum = 0u; cnt = 0u; mine = 0u;
#pragma unroll
        for (unsigned j = 0; j < 16; ++j) { const unsigned c = xb_ld(&bar[XB_XCNT(j)]); sum += c; cnt += (c > 0u) ? 1u : 0u; mine = (j == x) ? c : mine; }
        if (sum == G) break;
        __builtin_amdgcn_s_sleep(1);
        if ((++sp & 255u) == 0u) { if (xb_ld(&bar[XB_TMO])) break; if (sp > XB_SPIN_CAP) { atomicAdd(&bar[XB_TMO], 1u); break; } }
    }
    nloc = mine > 0u ? mine : 1u; nx = cnt > 0u ? cnt : 1u;
}
__device__ __forceinline__ void xcd_barrier(const XcdBarrier& b) {
    asm volatile("s_waitcnt vmcnt(0)" ::: "memory");
    __syncthreads();
    if (threadIdx.x == 0) {
        unsigned* bar = b.bar;
        __builtin_amdgcn_s_waitcnt(0);
        unsigned nloc = b.st[0], nx = b.st[1];
        if (nloc == 0u) { xcd_barrier_complete(bar, b.x, nloc, nx); b.st[0] = nloc; b.st[1] = nx; }
        const unsigned old = xb_add(&bar[XB_XSUB(b.x)], 1u);
        const unsigned gen = old / nloc;
        if (old + 1u == (gen + 1u) * nloc) {
            __builtin_amdgcn_fence(__ATOMIC_RELEASE, "agent");
            asm volatile("s_waitcnt vmcnt(0)" ::: "memory");
            const unsigned og = xb_add(&bar[XB_TOP], 1u);
            const unsigned tg = og / nx;
            if (og + 1u == (tg + 1u) * nx) xb_add(&bar[XB_TOPGEN], 1u);
            else XB_SPIN(xb_ld(&bar[XB_TOPGEN]) == tg, bar);
            __builtin_amdgcn_fence(__ATOMIC_ACQUIRE, "agent");
            xb_add(&bar[XB_XGEN(b.x)], 1u);
            asm volatile("s_waitcnt vmcnt(0)" ::: "memory");
        } else {
            XB_SPIN(xb_ld(&bar[XB_XGEN(b.x)]) == gen, bar);
            __builtin_amdgcn_fence(__ATOMIC_ACQUIRE, "agent");
            asm volatile("s_waitcnt vmcnt(0)" ::: "memory");
        }
    }
    __syncthreads();
}

__device__ __forceinline__ void p0_transpose_item(const float* W, int ldw, int k0, int nsrc0, int nvalid, const float* kscale, bf16* WT, int ldk, int ndst0, LAS float* scr, int lane) {
    const int n4 = (lane & 7) * 4;
    const int n4c = n4 < nvalid ? n4 : 0;
    f32x4 tv[8]; float ksv[8];
#pragma unroll
    for (int i = 0; i < 8; ++i) { const int kk = 8 * i + (lane >> 3); tv[i] = __builtin_nontemporal_load((const f32x4*)(W + (size_t)(k0 + kk) * ldw + nsrc0 + n4c)); }
    if (kscale) {
#pragma unroll
        for (int i = 0; i < 8; ++i) ksv[i] = kscale[k0 + 8 * i + (lane >> 3)];
#pragma unroll
        for (int i = 0; i < 8; ++i) tv[i] = tv[i] * ksv[i]; }
#pragma unroll
    for (int i = 0; i < 8; ++i) { const int kk = 8 * i + (lane >> 3);
        scr[kk * 33 + n4] = tv[i].x; scr[kk * 33 + n4 + 1] = tv[i].y; scr[kk * 33 + n4 + 2] = tv[i].z; scr[kk * 33 + n4 + 3] = tv[i].w; }
    LDS_WAIT(); asm volatile("" ::: "memory");
    const int c = lane & 7;
#pragma unroll
    for (int j = 0; j < 4; ++j) { const int n = (lane >> 3) + 8 * j; const LAS float* s = scr + (8 * c) * 33 + n;
        u32x4 o; o.x = pk2(s[0 * 33], s[1 * 33]); o.y = pk2(s[2 * 33], s[3 * 33]); o.z = pk2(s[4 * 33], s[5 * 33]); o.w = pk2(s[6 * 33], s[7 * 33]);
        if (n < nvalid) *(u32x4*)(WT + (size_t)(ndst0 + n) * ldk + k0 + 8 * c) = o; }
    LDS_WAIT(); asm volatile("" ::: "memory");
}

struct Args { const float* in[21]; float* out; unsigned char* ws; int ph_lo, ph_hi; };

template <int PART>
__device__ __forceinline__ void p0_prologue(const Args& a, LAS unsigned char* lds, int gw, int NGW, int wave, int lane) {
    LAS float* scr = (LAS float*)(lds + wave * 16384);
    unsigned char* ws = a.ws;
    bf16 *GU1 = (bf16*)(ws + WS_GU1), *D1 = (bf16*)(ws + WS_D1), *GU2 = (bf16*)(ws + WS_GU2), *D2 = (bf16*)(ws + WS_D2), *WIN = (bf16*)(ws + WS_WIN), *WOUT = (bf16*)(ws + WS_WOUT), *XN = (bf16*)(ws + WS_XN);
    if constexpr (PART == 0) {
        const float* gain = a.in[1];
        f32x4 gv[4];
#pragma unroll
        for (int j = 0; j < 4; ++j) gv[j] = *((const f32x4*)gain + lane + 64 * j);
        for (int m = gw; m < M; m += 4 * NGW) {
            f32x4 v[4][4];
#pragma unroll
            for (int q = 0; q < 4; ++q) { const int mm = m + q * NGW; const f32x4* xr = (const f32x4*)(a.in[0] + (size_t)(mm < M ? mm : m) * D) + lane;
#pragma unroll
                for (int j = 0; j < 4; ++j) v[q][j] = __builtin_nontemporal_load(xr + 64 * j); }
#pragma unroll
            for (int q = 0; q < 4; ++q) { const int mm = m + q * NGW; float s = 0.f;
#pragma unroll
                for (int j = 0; j < 4; ++j) s += (v[q][j].x * v[q][j].x + v[q][j].y * v[q][j].y) + (v[q][j].z * v[q][j].z + v[q][j].w * v[q][j].w);
                const float sq0 = sqrtf(wave_sum(s) * (1.0f / D) + EPS), r = 1.0f / sq0;
                if (mm < M && lane == 0) ((float*)(ws + WS_RS0))[mm] = sq0;
                if (mm < M) { u32x2* o8 = (u32x2*)(XN + (size_t)mm * D) + lane;
#pragma unroll
                    for (int j = 0; j < 4; ++j) { u32x2 w; w.x = pk2(v[q][j].x * r * gv[j].x, v[q][j].y * r * gv[j].y); w.y = pk2(v[q][j].z * r * gv[j].z, v[q][j].w * r * gv[j].w); o8[64 * j] = w; } } }
        }
    }
    constexpr int I_GU = 16 * 88, I_DN = 44 * 32, I_IN = 16 * 113, I_OUT = 16 * 32;
    if constexpr (PART == 0) {
    for (int it = gw; it < 4 * I_GU; it += NGW) {
        int r = it; const int which = r / I_GU; r -= which * I_GU; const int kb = r / 88, nb = r % 88, j0 = 32 * nb;
        const float* W = a.in[which == 0 ? 2 : which == 1 ? 3 : which == 2 ? 17 : 18];
        const float* ks = which >= 2 ? a.in[16] : nullptr;
        bf16* WT = which >= 2 ? GU2 : GU1;
        p0_transpose_item(W, FF, 64 * kb, j0, 32, ks, WT, D, 256 * (j0 >> 7) + (j0 & 127) + 128 * (which & 1), scr, lane); }
    }
    if constexpr (PART == 1 || PART == 2) {
    for (int it = gw; it < I_DN; it += NGW) { const int kb = it / 32, nb = it % 32;
        p0_transpose_item(a.in[PART == 2 ? 19 : 4], D, 64 * kb, 32 * nb, 32, nullptr, PART == 2 ? D2 : D1, FF, 32 * nb, scr, lane); }
    }
    if constexpr (PART == 1) {
    for (int it = gw; it < I_IN + I_OUT; it += NGW) {
        int r = it;
        if (r < I_IN) { const int kb = r / 113, db = r % 113;
            const int nd = 32 * db, nsrc = db < 80 ? nd : (db < 112 ? nd + 16 : 2560), nv = db < 112 ? 32 : 16;
            p0_transpose_item(a.in[6], 3600, 64 * kb, nsrc, nv, a.in[5], WIN, D, nd, scr, lane); continue; }
        r -= I_IN;
        { const int kb = r / 32, nb = r % 32;
            p0_transpose_item(a.in[15], D, 64 * kb, 32 * nb, 32, a.in[12], WOUT, MIXD, 32 * nb, scr, lane); }
    }
    for (int it = gw; it < 16 * 32; it += NGW) { const int kb = it / 32, nb = it % 32;
        p0_transpose_item(a.in[15] + (size_t)1024 * D, D, 64 * kb, 32 * nb, 32, nullptr, (bf16*)(ws + WS_FA) + (size_t)(kb >> 2) * 1024 * 256 - (size_t)(kb >> 2) * 256, 256, 32 * nb, scr, lane); }
    { bf16* FB = (bf16*)(ws + WS_FB);
      for (int i = gw * 64 + lane; i < 4 * 256 * 256 / 4; i += NGW * 64) { const int e0 = 4 * i, g = e0 >> 16, d = e0 & 255;
          const f32x4 w = *(const f32x4*)(a.in[13] + e0), sc = *(const f32x4*)(a.in[14] + 256 * g + d);
          *(u32x2*)(FB + e0) = (u32x2){pk2(w.x * sc.x, w.y * sc.y), pk2(w.z * sc.z, w.w * sc.w)}; } }
    }
}

constexpr int SB_CC = 0, SB_BC = 17408, SB_XT = 34816, SB_XD = 39424, SB_VEC = 44032, SB_STRIDE = 45056;
constexpr int SL_MM = 90112, SL_SL = 99328, SL_END = 108032;
constexpr int P272 = 272, P144 = 144;
typedef short v4i16_t __attribute__((ext_vector_type(4)));

__device__ __forceinline__ void unpack8(const u32x4 r, float (&f)[8]) { f[0] = bflo(r.x); f[1] = bfhi(r.x); f[2] = bflo(r.y); f[3] = bfhi(r.y); f[4] = bflo(r.z); f[5] = bfhi(r.z); f[6] = bflo(r.w); f[7] = bfhi(r.w); }

__device__ __forceinline__ void conv8x4(const bf16* PROJ, size_t tok0, int tseq, int col, const float* conv_w, const float* conv_b, bf16* dst, int pitch) {
    float wbc[4][8], bbc[8];
#pragma unroll
    for (int k = 0; k < 4; ++k) { const f32x4 w0 = *(const f32x4*)(conv_w + k * CONV_DIM + col - 1024), w1 = *(const f32x4*)(conv_w + k * CONV_DIM + col - 1024 + 4);
#pragma unroll
        for (int e = 0; e < 4; ++e) { wbc[k][e] = w0[e]; wbc[k][4 + e] = w1[e]; } }
    { const f32x4 w0 = *(const f32x4*)(conv_b + col - 1024), w1 = *(const f32x4*)(conv_b + col - 1024 + 4);
#pragma unroll
        for (int e = 0; e < 4; ++e) { bbc[e] = w0[e]; bbc[4 + e] = w1[e]; } }
    u32x4 rbc[7];
#pragma unroll
    for (int i = 0; i < 7; ++i) { rbc[i] = (u32x4){0u, 0u, 0u, 0u}; if (tseq - 3 + i >= 0) rbc[i] = *(const u32x4*)(PROJ + (tok0 + tseq - 3 + i) * PROJ_LD + col); }
    float ob[4][8];
#pragma unroll
    for (int j = 0; j < 4; ++j)
#pragma unroll
        for (int e = 0; e < 8; ++e) ob[j][e] = bbc[e];
#pragma unroll
    for (int i = 0; i < 7; ++i) { float f[8]; unpack8(rbc[i], f);
#pragma unroll
        for (int j = 0; j < 4; ++j) { const int k = i - j; if (k >= 0 && k < 4) {
#pragma unroll
            for (int e = 0; e < 8; ++e) ob[j][e] += wbc[k][e] * f[e]; } } }
#pragma unroll
    for (int j = 0; j < 4; ++j) {
#pragma unroll
        for (int e = 0; e < 8; ++e) ob[j][e] = silu_f(ob[j][e]);
        u32x4 w; w.x = cvt_pk_bf16(ob[j][0], ob[j][1]); w.y = cvt_pk_bf16(ob[j][2], ob[j][3]); w.z = cvt_pk_bf16(ob[j][4], ob[j][5]); w.w = cvt_pk_bf16(ob[j][6], ob[j][7]);
        *(u32x4*)(dst + (size_t)j * pitch) = w; }
}

__device__ __forceinline__ void conv_phase(const Args& a, int G, int vc) {
    const int tid = threadIdx.x, lane = tid & 63, wave = __builtin_amdgcn_readfirstlane(tid >> 6);
    const bf16* PROJ = (const bf16*)(a.ws + WS_PROJ);
    bf16* BCG = (bf16*)a.out;
    bf16* MIX = (bf16*)(a.ws + WS_MIX);
    const float* DT = (const float*)(a.ws + WS_DT);
    float* DTV = (float*)(a.ws + WS_DTV); float* CSV = (float*)(a.ws + WS_CSV);
    const float* conv_w = a.in[7]; const float* conv_b = a.in[8];
    for (int uu = 2 * vc; uu < 512; uu += 2 * G)
    for (int unit = uu; unit < uu + 2; ++unit) {
        const int b = unit >> 6, c = (unit >> 1) & 31, g = unit & 1;
        const size_t tok0 = (size_t)b * SEQ;
        { const int cg = tid & 31, tl = tid >> 5;
          conv8x4(PROJ, tok0, c * 64 + 4 * tl, B_OFF + (cg >> 4) * 256 + g * 128 + 8 * (cg & 15), conv_w, conv_b, BCG + (size_t)unit * 16384 + (4 * tl) * 256 + 8 * cg, 256); }
#pragma unroll 1
        for (int pass = 0; pass < 2; ++pass) { const int cgx = tid & 63, tlx = (tid >> 6) + 8 * pass; const int ch = g * 512 + 8 * cgx;
          conv8x4(PROJ, tok0, c * 64 + 4 * tlx, XS_OFF + ch, conv_w, conv_b, MIX + (tok0 + c * 64 + 4 * tlx) * MIXD + ch, MIXD); }
        { const int h = 8 * g + wave; const size_t tok = tok0 + c * 64 + lane;
          const float xdt = DT[tok * 16 + h] + a.in[9][h];
          const float dtv = xdt > 20.f ? xdt : log1pf(expf(xdt));
          float cs = dtv * (-expf(a.in[10][h]));
#pragma unroll
          for (int o = 1; o < 64; o <<= 1) { const float t = __shfl_up(cs, o); if (lane >= o) cs += t; }
          DTV[tok * 16 + h] = dtv; CSV[tok * 16 + h] = cs; }
    }
}

__device__ __forceinline__ void ssd_phase(LAS unsigned char* lds, const Args& a, int G, int vc) {
    const int tid = threadIdx.x, lane = tid & 63, wave = __builtin_amdgcn_readfirstlane(tid >> 6);
    const int l16 = lane & 15, quad = lane >> 4;
    const bf16* PROJ = (const bf16*)(a.ws + WS_PROJ);
    const bf16* BCG = (const bf16*)a.out;
    const float* DTV = (const float*)(a.ws + WS_DTV); const float* CSV = (const float*)(a.ws + WS_CSV);
    bf16* MIX = (bf16*)(a.ws + WS_MIX);
    float* PSS = (float*)(a.ws + WS_PSS);
    for (int item = vc; item < 256; item += G) {
        const int b = item >> 5, h = (item >> 1) & 15, ph = item & 1, g = h >> 3;
        const float Dh = a.in[11][h];
        const int xtok = tid >> 3, xc4 = tid & 7;
        const int x_ch = h * 64 + ph * 32 + 4 * xc4;
        f32x4 accS[2]; accS[0] = (f32x4){0.f, 0.f, 0.f, 0.f}; accS[1] = accS[0];
        for (int i = tid; i < (SL_END - SL_SL) / 4; i += NTHR) ((LAS unsigned*)(lds + SL_SL))[i] = 0u;
        const size_t tok0 = (size_t)b * SEQ;
        const int ti = wave >> 1, q = wave & 1;
        const int pcol = h * 64 + ph * 32 + 16 * q + 4 * quad;
        u32x4 rbA[2][4]; u32x2 xrA[2]; float dtvA[2], csA[2]; u32x2 zrA[2];
#define SSD_LOAD_RAW(c, S) do { const bf16* ub = BCG + ((size_t)(b * 32 + (c)) * 2 + g) * 16384; \
            _Pragma("unroll") for (int k = 0; k < 4; ++k) rbA[S][k] = *(const u32x4*)(ub + (size_t)(tid + 512 * k) * 8); \
            xrA[S] = *(const u32x2*)(MIX + (tok0 + (size_t)(c) * 64 + xtok) * MIXD + x_ch); \
            dtvA[S] = DTV[(tok0 + (c) * 64 + lane) * 16 + h]; csA[S] = CSV[(tok0 + (c) * 64 + lane) * 16 + h]; \
            zrA[S] = *(const u32x2*)(PROJ + (tok0 + (size_t)(c) * 64 + 16 * ti + l16) * PROJ_LD + Z_OFF + pcol); } while (0)
        SSD_LOAD_RAW(0, 0); SSD_LOAD_RAW(1, 1);
#pragma unroll 2
        for (int c = 0; c < 32; ++c) {
            const int S = c & 1;
            const float dtv = dtvA[S], cs = csA[S]; const u32x2 xr = xrA[S];
            LAS unsigned char* sb = lds + (c & 1) * SB_STRIDE;
            const float cs63 = __shfl(cs, 63);
#pragma unroll
            for (int k = 0; k < 4; ++k) { const int pp = tid + 512 * k, row = pp >> 5, c16 = pp & 31;
                *(LAS u32x4*)(sb + (c16 < 16 ? SB_BC : SB_CC) + row * P272 + 16 * (c16 & 15)) = rbA[S][k]; }
            {
                const float sd = __shfl(dtv, xtok & 63) * __expf(cs63 - __shfl(cs, xtok & 63));
                const float f[4] = {bflo(xr.x), bfhi(xr.x), bflo(xr.y), bfhi(xr.y)};
                const unsigned xb[4] = {xr.x & 0xffffu, xr.x >> 16, xr.y & 0xffffu, xr.y >> 16};
#pragma unroll
                for (int e = 0; e < 4; ++e) {
                    *(LAS unsigned short*)(sb + SB_XT + (4 * xc4 + e) * P144 + 2 * xtok) = (unsigned short)xb[e];
                    *(LAS unsigned short*)(sb + SB_XD + (4 * xc4 + e) * P144 + 2 * xtok) = (unsigned short)f2bf(f[e] * sd); }
            }
            if (wave == 0) { ((LAS float*)(sb + SB_VEC))[lane] = cs; ((LAS float*)(sb + SB_VEC))[64 + lane] = dtv; }
            const float dec = __expf(cs63);
            LDS_WAIT(); __builtin_amdgcn_s_barrier(); asm volatile("" ::: "memory");
            const size_t otok = tok0 + (size_t)c * 64 + 16 * ti + l16;
            const float zv[4] = {bflo(zrA[S].x), bfhi(zrA[S].x), bflo(zrA[S].y), bfhi(zrA[S].y)};
            if (c + 2 < 32) SSD_LOAD_RAW(c + 2, S);
            const float cs_l = ((const LAS float*)(sb + SB_VEC))[16 * ti + l16];
            bf16x8 Cf[4];
#pragma unroll
            for (int k = 0; k < 4; ++k) Cf[k] = *(const LAS bf16x8*)(sb + SB_CC + (16 * ti + l16) * P272 + (32 * k + 8 * quad) * 2);
#pragma unroll
            for (int jj = 0; jj < 2; ++jj) {
                const int j = 2 * q + jj;
                if (j <= ti) {
                    f32x4 gacc = (f32x4){0.f, 0.f, 0.f, 0.f};
#pragma unroll
                    for (int k = 0; k < 4; ++k) {
                        const bf16x8 Aop = *(const LAS bf16x8*)(sb + SB_BC + (16 * j + l16) * P272 + (32 * k + 8 * quad) * 2);
                        gacc = __builtin_amdgcn_mfma_f32_16x16x32_bf16(Aop, Cf[k], gacc, 0, 0, 0); }
                    const f32x4 cs_s = *(const LAS f32x4*)(sb + SB_VEC + (16 * j + 4 * quad) * 4), dt_s = *(const LAS f32x4*)(sb + SB_VEC + 256 + (16 * j + 4 * quad) * 4);
                    float mv[4];
#pragma unroll
                    for (int r = 0; r < 4; ++r) { const int s_ = 16 * j + 4 * quad + r, l = 16 * ti + l16;
                        float v = gacc[r] * __expf(fminf(cs_l - cs_s[r], 0.f)) * dt_s[r];
                        v = (s_ <= l) ? v : 0.f; if (s_ == l) v += Dh; mv[r] = v; }
                    *(LAS u32x2*)(lds + SL_MM + (16 * ti + l16) * P144 + (16 * j + 4 * quad) * 2) = (u32x2){cvt_pk_bf16(mv[0], mv[1]), cvt_pk_bf16(mv[2], mv[3])};
                } else if ((j >> 1) <= (ti >> 1)) {
                    *(LAS u32x2*)(lds + SL_MM + (16 * ti + l16) * P144 + (16 * j + 4 * quad) * 2) = (u32x2){0u, 0u};
                }
            }
            f32x4 y = (f32x4){0.f, 0.f, 0.f, 0.f};
#pragma unroll
            for (int k = 0; k < 4; ++k) {
                const bf16x8 Aop = *(const LAS bf16x8*)(lds + SL_SL + (16 * q + l16) * P272 + (32 * k + 8 * quad) * 2);
                y = __builtin_amdgcn_mfma_f32_16x16x32_bf16(Aop, Cf[k], y, 0, 0, 0); }
            y = y * __expf(cs_l);
#pragma unroll
            for (int t = 0; t < 2; ++t) { const int jn = 2 * ti + t;
                accS[t] = accS[t] * dec;
#pragma unroll
                for (int kk = 0; kk < 2; ++kk) {
                    LAS unsigned char* tp = sb + SB_BC + (32 * kk + 8 * quad + (l16 >> 2)) * P272 + (16 * jn + 4 * (lane & 3)) * 2;
                    const v4i16_t lo = __builtin_amdgcn_ds_read_tr16_b64_v4i16((LAS v4i16_t*)tp), hi = __builtin_amdgcn_ds_read_tr16_b64_v4i16((LAS v4i16_t*)(tp + 4 * P272));
                    const bf16x8 Aop = __builtin_shufflevector(lo, hi, 0, 1, 2, 3, 4, 5, 6, 7);
                    const bf16x8 Bop = *(const LAS bf16x8*)(sb + SB_XD + (16 * q + l16) * P144 + (32 * kk + 8 * quad) * 2);
                    accS[t] = __builtin_amdgcn_mfma_f32_16x16x32_bf16(Aop, Bop, accS[t], 0, 0, 0); } }
            LDS_WAIT(); __builtin_amdgcn_s_barrier(); asm volatile("" ::: "memory");
            for (int kk = 0; kk <= (ti >> 1); ++kk) {
                const bf16x8 Aop = *(const LAS bf16x8*)(sb + SB_XT + (16 * q + l16) * P144 + (32 * kk + 8 * quad) * 2);
                const bf16x8 Bop = *(const LAS bf16x8*)(lds + SL_MM + (16 * ti + l16) * P144 + (32 * kk + 8 * quad) * 2);
                y = __builtin_amdgcn_mfma_f32_16x16x32_bf16(Aop, Bop, y, 0, 0, 0); }
#pragma unroll
            for (int t = 0; t < 2; ++t) { const int jn = 2 * ti + t;
                *(LAS u32x2*)(lds + SL_SL + (16 * q + l16) * P272 + (16 * jn + 4 * quad) * 2) = (u32x2){cvtpk_s(accS[t][0], accS[t][1]), cvtpk_s(accS[t][2], accS[t][3])}; }
            float v[4], ssq = 0.f;
#pragma unroll
            for (int r = 0; r < 4; ++r) { v[r] = y[r] * silu_f(zv[r]); ssq += v[r] * v[r]; }
            *(u32x2*)(MIX + otok * MIXD + pcol) = (u32x2){cvt_pk_bf16(v[0], v[1]), cvt_pk_bf16(v[2], v[3])};
            ssq += __shfl_xor(ssq, 16); ssq += __shfl_xor(ssq, 32);
            PSS[(size_t)(g * 32 + (h & 7) * 4 + ph * 2 + q) * M + otok] = ssq;
        }
        LDS_WAIT(); __builtin_amdgcn_s_barrier(); asm volatile("" ::: "memory");
#undef SSD_LOAD_RAW
    }
}

template <int WIN>
__device__ __forceinline__ void pool_quads(const bf16* PROJ, bf16* MIX, int blk, int cgp, int tr) {
    for (int i = 0; i < 4; ++i) {
        const int t0 = blk * 64 + tr * 16 + 4 * i, ts0 = t0 & (SEQ - 1);
        u32x4 r[WIN + 3];
#pragma unroll
        for (int k = 0; k < WIN + 3; ++k) { const int dt = k - (WIN - 1); r[k] = (u32x4){0u, 0u, 0u, 0u};
            if (ts0 + dt >= 0) r[k] = *(const u32x4*)(PROJ + (size_t)(t0 + dt) * PROJ_LD + U_OFF + 8 * cgp); }
        float s[8];
#pragma unroll
        for (int e = 0; e < 8; ++e) s[e] = 0.f;
#pragma unroll
        for (int k = 0; k < WIN; ++k) { float f[8]; unpack8(r[k], f);
#pragma unroll
            for (int e = 0; e < 8; ++e) s[e] += f[e]; }
#pragma unroll
        for (int j = 0; j < 4; ++j) {
            float u0[8]; unpack8(r[WIN - 1 + j], u0);
            if (j > 0) { float f[8]; unpack8(r[j - 1], f);
#pragma unroll
                for (int e = 0; e < 8; ++e) s[e] += u0[e] - f[e]; }
            const int cnt = (ts0 + j + 1) < WIN ? (ts0 + j + 1) : WIN; const float inv = 1.0f / (float)cnt;
            u32x4 o; o.x = cvt_pk_bf16(s[0] * inv - u0[0], s[1] * inv - u0[1]); o.y = cvt_pk_bf16(s[2] * inv - u0[2], s[3] * inv - u0[3]);
            o.z = cvt_pk_bf16(s[4] * inv - u0[4], s[5] * inv - u0[5]); o.w = cvt_pk_bf16(s[6] * inv - u0[6], s[7] * inv - u0[7]);
            *(u32x4*)(MIX + (size_t)(t0 + j) * MIXD + 1024 + 8 * cgp) = o; }
    }
}
__device__ __forceinline__ void pool_phase(const Args& a, int G, int vc) {
    const bf16* PROJ = (const bf16*)(a.ws + WS_PROJ);
    bf16* MIX = (bf16*)(a.ws + WS_MIX);
    const int tid = threadIdx.x, lane = tid & 63, wave = __builtin_amdgcn_readfirstlane(tid >> 6);
    const int grp = wave & 3, cgp = grp * 32 + (lane & 31), tr = (wave >> 2) * 2 + (lane >> 5);
    for (int blk = vc; blk < M / 64; blk += G) {
        if (grp == 0) pool_quads<2>(PROJ, MIX, blk, cgp, tr);
        else if (grp == 1) pool_quads<4>(PROJ, MIX, blk, cgp, tr);
        else if (grp == 2) pool_quads<8>(PROJ, MIX, blk, cgp, tr);
        else pool_quads<16>(PROJ, MIX, blk, cgp, tr);
    }
}

constexpr int N_PHASES = 9;
__global__ void __launch_bounds__(NTHR, 2) hybrid_fwd(Args args) {
    extern __shared__ __attribute__((aligned(16))) unsigned char lds_raw[];
    LAS unsigned char* lds = (LAS unsigned char*)lds_raw;
    const int tid = threadIdx.x, lane = tid & 63, wave = __builtin_amdgcn_readfirstlane(tid >> 6);
    const int G = gridDim.x; const int bx = blockIdx.x; const int vcu = (G % 8 == 0) ? (bx % 8) * (G / 8) + bx / 8 : bx;
    unsigned char* ws = args.ws;
    volatile LAS unsigned* MISC = (volatile LAS unsigned*)(lds + MISC_OFF);
    if (tid < 32) MISC[tid] = 0u;
    __syncthreads();
    const int lo = args.ph_lo, hi = args.ph_hi;
#if MK_CG_SYNC
    cg::grid_group grid = cg::this_grid();
#define GRID_BAR() do { __threadfence(); grid.sync(); } while (0)
#else
    cg::grid_group grid = cg::this_grid();
    XcdBarrier bar; bar.bar = (unsigned*)(ws + WS_CTL) + CW_BAR; bar.x = 0; bar.st = nullptr;
    if (hi - lo > 1) bar = xcd_barrier_post((unsigned*)(ws + WS_CTL) + CW_BAR, MISC + 8);
    if (lo > 1000) grid.sync();
#define GRID_BAR() xcd_barrier(bar)
#endif
#define IN(k) (lo <= (k) && (k) < hi)
#define BOTH(k) (IN(k) && IN((k) + 1))
    bf16 *GU1 = (bf16*)(ws + WS_GU1), *D1 = (bf16*)(ws + WS_D1), *GU2 = (bf16*)(ws + WS_GU2), *D2 = (bf16*)(ws + WS_D2), *WIN = (bf16*)(ws + WS_WIN), *WOUT = (bf16*)(ws + WS_WOUT);
    bf16 *XN = (bf16*)(ws + WS_XN), *HID = (bf16*)(ws + WS_HID), *PROJ = (bf16*)(ws + WS_PROJ), *MIX = (bf16*)(ws + WS_MIX);
    float *SS = (float*)(ws + WS_SS), *DTB = (float*)(ws + WS_DT), *PSS = (float*)(ws + WS_PSS);

    if (IN(0)) { p0_prologue<0>(args, lds, vcu * NWAVES + wave, G * NWAVES, wave, lane); if (BOTH(0)) GRID_BAR(); }
    if (IN(1)) {
        pg8::Gemm g{XN, GU1, M, NGU, D}; pg8::StaticOrder S; S.init(M, NGU, G, bx);
        pg8::EpiSwiglu E{HID, nullptr};
        pg8::gemm_phase<pg8::EpiSwiglu, pg8::StaticOrder, pg8::NoHook, true>(lds, g, S, E, pg8::NoHook{});
        { const int first = ((M / 256) * (NGU / 256)) % G;
          if (bx >= first) p0_prologue<1>(args, lds, (bx - first) * NWAVES + wave, (G - first) * NWAVES, wave, lane); }
        if (BOTH(1)) GRID_BAR();
    }
    if (IN(2)) {
        pg8::Gemm g{HID, D1, M, D, FF}; pg8::StaticOrder S; S.init(M, D, G, bx);
        pg8::EpiResX<true, false> E{nullptr, XN, (const float*)(ws + WS_RS0), nullptr, nullptr, XN, (float*)(ws + WS_RS1), SS, (unsigned*)(ws + WS_CTL) + CW_PANEL, 0.5f, args.in[1]};
        pg8::gemm_phase<pg8::EpiResX<true, false>, pg8::StaticOrder, pg8::NoHook, false>(lds, g, S, E, pg8::NoHook{});
        if (BOTH(2)) GRID_BAR();
    }
    if (IN(3)) {
        pg8::Gemm g{XN, WIN, M, NIN, D}; pg8::StaticOrder S; S.init(M, NIN, G, bx);
        pg8::EpiProj E{PROJ, DTB, nullptr};
        pg8::gemm_phase<pg8::EpiProj, pg8::StaticOrder, pg8::NoHook, true>(lds, g, S, E, pg8::NoHook{});
        {
            pg8::Gemm gf{(const bf16*)(ws + WS_FA), (const bf16*)(ws + WS_FB), 4096, 1024, 256}; pg8::FoldOrder SF{G == 256 ? bx - 192 : bx};
            pg8::EpiFold EF{WOUT};
            pg8::gemm_phase<pg8::EpiFold, pg8::FoldOrder, pg8::NoHook, true>(lds, gf, SF, EF, pg8::NoHook{});
        }
        if (BOTH(3)) GRID_BAR();
    }
    if (IN(4)) {
        pool_phase(args, G, vcu);
        conv_phase(args, G, vcu);
        if (BOTH(4)) GRID_BAR();
    }
    if (IN(5)) {
        ssd_phase(lds, args, G, vcu);
        if (BOTH(5)) GRID_BAR();
    }
    if (IN(6)) {
        pg8::StaticOrder S; S.init(M, D, G, bx); pg8::Unit u0;
        LAS float* TAB = (LAS float*)(lds + TAB_OFF);
        if (S.next(0, u0)) {
            const int row = tid & 255, gg = tid >> 8; float s = 0.f;
            for (int k = 0; k < 32; ++k) s += PSS[(size_t)(gg * 32 + k) * M + u0.pm * 256 + row];
            TAB[512 + gg * 256 + row] = 1.0f / sqrtf(s * (1.0f / 512.0f) + EPS);
        }
        __syncthreads();
        if (tid < 256) { const float r0 = TAB[512 + tid], r1 = TAB[768 + tid]; TAB[tid] = r0 / r1; TAB[256 + tid] = r1; }
        __syncthreads();
        pg8::Gemm g{MIX, WOUT, M, D, MIXD};
        pg8::EpiResX<true, false> E{nullptr, XN, (const float*)(ws + WS_RS1), nullptr, nullptr, XN, (float*)(ws + WS_RS2), SS, (unsigned*)(ws + WS_CTL) + CW_PANEL + 1024, 1.0f, nullptr};
        pg8::ScaleHook HK{TAB, 8, 16};
        pg8::gemm_phase<pg8::EpiResX<true, false>, pg8::StaticOrder, pg8::ScaleHook, false>(lds, g, S, E, HK);
        if (BOTH(6)) GRID_BAR();
    }
    if (IN(7)) {
        pg8::Gemm g{XN, GU2, M, NGU, D}; pg8::StaticOrder S; S.init(M, NGU, G, bx);
        pg8::EpiSwiglu E{HID, nullptr};
        pg8::gemm_phase<pg8::EpiSwiglu, pg8::StaticOrder, pg8::NoHook, true>(lds, g, S, E, pg8::NoHook{});
        { const int first = ((M / 256) * (NGU / 256)) % G;
          if (bx >= first) p0_prologue<2>(args, lds, (bx - first) * NWAVES + wave, (G - first) * NWAVES, wave, lane); }
        if (BOTH(7)) GRID_BAR();
    }
    if (IN(8)) {
        pg8::Gemm g{HID, D2, M, D, FF}; pg8::StaticOrder S; S.init(M, D, G, bx);
        pg8::EpiResX<true, true> E{nullptr, XN, (const float*)(ws + WS_RS2), args.out, args.in[20], nullptr, nullptr, SS, (unsigned*)(ws + WS_CTL) + CW_PANEL + 2048, 0.5f, nullptr};
        pg8::gemm_phase<pg8::EpiResX<true, true>, pg8::StaticOrder, pg8::NoHook, false>(lds, g, S, E, pg8::NoHook{});
    }
#undef IN
#undef BOTH
}

extern "C" void kernel_launch(void* const* d_in, const int* in_sizes, int n_in, void* d_out, int out_size, void* d_ws, size_t ws_size, hipStream_t stream) {
    static int grid = 0;
    if (grid == 0) {
        if (n_in != 21 || in_sizes[0] != M * D || out_size != M * D || ws_size < WS_END) { fprintf(stderr, "kernel_launch: unexpected shapes (n_in %d, in0 %d, out %d, ws %zu)\n", n_in, n_in > 0 ? in_sizes[0] : -1, out_size, ws_size); grid = -1; return; }
        int dev = 0, cus = 0, per_cu = 0;
        if (hipGetDevice(&dev) != hipSuccess || hipDeviceGetAttribute(&cus, hipDeviceAttributeMultiprocessorCount, dev) != hipSuccess) { grid = -1; return; }
        if (hipFuncSetAttribute((const void*)hybrid_fwd, hipFuncAttributeMaxDynamicSharedMemorySize, LDS_BYTES) != hipSuccess) { fprintf(stderr, "kernel_launch: hipFuncSetAttribute failed\n"); grid = -1; return; }
        if (hipOccupancyMaxActiveBlocksPerMultiprocessor(&per_cu, (const void*)hybrid_fwd, NTHR, LDS_BYTES) != hipSuccess || per_cu < 1) { fprintf(stderr, "kernel_launch: occupancy query says %d\n", per_cu); per_cu = 1; }
        (void)hipGetLastError();
        grid = cus;
        if (grid != 256) fprintf(stderr, "kernel_launch: %d CUs; the single-unit GEMM phases expect 256\n", grid);
    }
    if (grid < 0) return;
    (void)hipMemsetAsync((char*)d_ws + WS_CTL, 0, CTL_ZERO_BYTES, stream);
    Args a{};
    for (int i = 0; i < 21; ++i) a.in[i] = (const float*)d_in[i];
    a.out = (float*)d_out; a.ws = (unsigned char*)d_ws;
#if MK_N_LAUNCHES == 1
    a.ph_lo = 0; a.ph_hi = N_PHASES;
    void* kargs[] = {&a};
    hipError_t e = hipLaunchCooperativeKernel((const void*)hybrid_fwd, dim3(grid), dim3(NTHR), kargs, LDS_BYTES, stream);
    if (e != hipSuccess) fprintf(stderr, "kernel_launch: cooperative launch failed: %s (grid %d)\n", hipGetErrorString(e), grid);
#else
    for (int p = 0; p < N_PHASES; ++p) { a.ph_lo = p; a.ph_hi = p + 1; hipLaunchKernelGGL(hybrid_fwd, dim3(grid), dim3(NTHR), LDS_BYTES, stream, a); }
#endif
}
```

```cpp
#include <hip/hip_runtime.h>
#include <hip/hip_cooperative_groups.h>
#include <cstdio>
#include <cstdint>
namespace cg = cooperative_groups;

#ifndef MK_N_LAUNCHES
#define MK_N_LAUNCHES 1
#endif
#ifndef MK_CG_SYNC
#define MK_CG_SYNC 0
#endif

#define LAS __attribute__((address_space(3)))
#define GAS __attribute__((address_space(1)))
typedef unsigned short bf16;
typedef short bf16x8 __attribute__((ext_vector_type(8)));
typedef float f32x4 __attribute__((ext_vector_type(4)));
typedef float f32x2 __attribute__((ext_vector_type(2)));
typedef unsigned u32x4 __attribute__((ext_vector_type(4)));
typedef unsigned u32x2 __attribute__((ext_vector_type(2)));

constexpr int M = 16384, SEQ = 2048, D = 1024, FF = 2816, NGU = 2 * FF, NIN = 3840, PROJ_LD = 3584, MIXD = 2048;
constexpr int Z_OFF = 0, XS_OFF = 1024, B_OFF = 2048, C_OFF = 2304, U_OFF = 2560;
constexpr int CONV_DIM = 1536;
constexpr float EPS = 1e-6f;
constexpr int NWAVES = 8, NTHR = 512;

constexpr size_t MiB = 1u << 20;
constexpr size_t WS_CTL = 0, CTL_ZERO_BYTES = 64 * 1024;
constexpr size_t WS_SS = 64 * 1024;
constexpr size_t WS_RS0 = 448 * 1024;
constexpr size_t WS_RS1 = 320 * 1024, WS_RS2 = 384 * 1024;
constexpr size_t WS_GU1 = 1 * MiB;
constexpr size_t WS_PSS = 1 * MiB;
constexpr size_t WS_D1 = 12 * MiB;
constexpr size_t WS_DT = 12 * MiB;
constexpr size_t WS_DTV = 13 * MiB;
constexpr size_t WS_CSV = 14 * MiB;
constexpr size_t WS_GU2 = WS_D1 + 5 * MiB + 512 * 1024;
constexpr size_t WS_D2 = WS_GU2 + 11 * MiB;
constexpr size_t WS_WIN = 34 * MiB;
constexpr size_t WS_WOUT = WS_WIN + 7 * MiB + 512 * 1024;
constexpr size_t WS_PROJ = 46 * MiB;
constexpr size_t WS_HID = 46 * MiB;
constexpr size_t WS_MIX = 158 * MiB;
constexpr size_t WS_FA = 158 * MiB;
constexpr size_t WS_FB = 160 * MiB;
constexpr size_t WS_XN = 222 * MiB;
constexpr size_t WS_BCG = 222 * MiB;
constexpr size_t WS_END = 254 * MiB;
constexpr int CW_BAR = 1024;
constexpr int CW_PANEL = 8192;

constexpr int RING_BYTES = 131072;
constexpr int TAB_OFF = RING_BYTES;
constexpr int MISC_OFF = TAB_OFF + 4096;
constexpr int LDS_BYTES = 147456;

__device__ __forceinline__ unsigned f2bf(float f) { unsigned u = __builtin_bit_cast(unsigned, f); return (u + 0x7fffu + ((u >> 16) & 1u)) >> 16; }
__device__ __forceinline__ unsigned cvt_pk_bf16(float lo, float hi) { unsigned r; asm volatile("v_cvt_pk_bf16_f32 %0, %1, %2" : "=v"(r) : "v"(lo), "v"(hi)); return r; }
__device__ __forceinline__ unsigned pk2(float lo, float hi) { return cvt_pk_bf16(lo, hi); }
typedef float f32x2_t __attribute__((ext_vector_type(2))); typedef __bf16 bf16x2_t __attribute__((ext_vector_type(2)));
__device__ __forceinline__ unsigned cvtpk_s(float lo, float hi) { f32x2_t v = {lo, hi}; bf16x2_t b = __builtin_convertvector(v, bf16x2_t); return __builtin_bit_cast(unsigned, b); }
__device__ __forceinline__ __amdgpu_buffer_rsrc_t wt_rsrc(void* base, unsigned bytes) { return __builtin_amdgcn_make_buffer_rsrc(base, 0, (int)bytes, 0x00020000); }
__device__ __forceinline__ void st16_wt(__amdgpu_buffer_rsrc_t rs, size_t off, u32x4 v) { __builtin_amdgcn_raw_buffer_store_b128(v, rs, (unsigned)off, 0, 16); }
__device__ __forceinline__ float bflo(unsigned u) { return __builtin_bit_cast(float, u << 16); }
__device__ __forceinline__ float bfhi(unsigned u) { return __builtin_bit_cast(float, u & 0xffff0000u); }
__device__ __forceinline__ float silu_f(float v) { return v * __builtin_amdgcn_rcpf(1.0f + __builtin_amdgcn_exp2f(-1.44269504f * v)); }
__device__ __forceinline__ float wave_sum(float v) {
#pragma unroll
    for (int o = 1; o < 64; o <<= 1) v += __shfl_xor(v, o);
    return v;
}
#define LDS_WAIT() asm volatile("s_waitcnt lgkmcnt(0)" ::: "memory")
#define VM_WAIT() asm volatile("s_waitcnt vmcnt(0)" ::: "memory")

namespace pg8 {
constexpr int BM = 256, BK = 64, HALF = 128, HTB = HALF * BK * 2, STAGE_BYTES = 8 * HTB, NXCD = 8, WGM = 8;
__host__ __device__ __forceinline__ int lds_byte(int r, int c) { const int st = (r >> 4) * 2 + (c >> 5), rr = r & 15, cc = c & 31, ob = rr * 64 + cc * 2; return st * 1024 + (ob ^ (((ob >> 9) & 1) << 5)); }
__host__ __device__ __forceinline__ void stage_rc(int b, int& R, int& C) { const int st = b / 1024, sb = b % 1024, swz = sb ^ (((sb >> 9) & 1) << 5); R = (st >> 1) * 16 + swz / 64; C = (st & 1) * 32 + (swz % 64) / 2; }
__host__ __device__ __forceinline__ int perm32(int rho) { const int n = rho >> 4, i = rho & 15; return 8 * (i >> 2) + 4 * n + (i & 3); }

struct Unit { int pm, pn; };
struct Gemm { const bf16* A; const bf16* Bt; int M, N, K; };

struct StaticOrder {
    int nM, nN, nwg, G, c;
    __host__ __device__ void init(int M_, int N_, int G_, int c_) { nM = M_ / BM; nN = N_ / BM; nwg = nM * nN; G = G_; c = c_; }
    __host__ __device__ bool next(int i, Unit& u) const {
        const long L = (long)i * G + c; if (L >= nwg) return false;
        int wgid = (int)L; { const int q = nwg / NXCD, r = nwg % NXCD, xcd = wgid % NXCD, off = wgid / NXCD; wgid = (xcd < r ? xcd * (q + 1) : r * (q + 1) + (xcd - r) * q) + off; }
        const int nig = WGM * nN, gid = wgid / nig, fm = gid * WGM, gsz = (nM - fm) < WGM ? (nM - fm) : WGM;
        u.pm = fm + ((wgid % nig) % gsz); u.pn = (wgid % nig) / gsz; return true;
    }
};

struct FoldOrder {
    int c;
    __host__ __device__ bool next(int i, Unit& u) const { const int idx = i * 64 + c; if (c < 0 || idx >= 16) return false; u.pm = idx; u.pn = idx >> 2; return true; }
};
struct NoHook { static constexpr bool ON = false; };
struct ScaleHook { static constexpr bool ON = true; const LAS float* F; int t0, t1; };

template <class Epi, class Sched, class Hook, bool ALIGN_EPI>
__device__ __forceinline__ void gemm_phase(LAS unsigned char* lds, const Gemm g, const Sched& S, const Epi& E, const Hook& HK) {
    const int tid = threadIdx.x, wid = __builtin_amdgcn_readfirstlane(tid >> 6), lane = tid & 63, wr = wid >> 2, wc = wid & 3, fr = lane & 15, fq = lane >> 4;
    const int K = g.K, nt = K / BK;
    unsigned voffA[2], voffB[2];
#pragma unroll
    for (int i = 0; i < 2; ++i) { int R, C; stage_rc(tid * 16 + i * 8192, R, C); const int Rb = (R & ~31) + perm32(R & 31);
        voffA[i] = (unsigned)(R * K + C) * 2u; voffB[i] = (unsigned)(Rb * K + C) * 2u; }
    const size_t kstep = (size_t)(BK * 2);
    const size_t hstep = (size_t)HALF * K * 2;
    const size_t tstep = 2 * hstep;
    const unsigned ldsw = (unsigned)wid * 1024u;
    const int aoff = lds_byte(wr * 64 + fr, fq * 8), boff = lds_byte(wc * 32 + fr, fq * 8);
#define PG8_SA(b, h) (((b) * 2 + (h)) * HTB)
#define PG8_SB(b, h) ((4 + (b) * 2 + (h)) * HTB)
#define PG8_STAGE(bufoff, gbase, voff) do { _Pragma("unroll") for (int _i = 0; _i < 2; ++_i) \
        __builtin_amdgcn_global_load_lds((const unsigned*)((const char*)(gbase) + (voff)[_i]), (LAS unsigned*)(lds + (bufoff) + ldsw + _i * 8192), 16, 0, 0); } while (0)
#define PG8_LDA(dst, b, h) do { _Pragma("unroll") for (int m = 0; m < 4; ++m) _Pragma("unroll") for (int k = 0; k < 2; ++k) dst[m][k] = *(const LAS bf16x8*)(lds + PG8_SA(b, h) + aoff + m * 2048 + k * 1024); } while (0)
#define PG8_LDB(dst, b, h) do { _Pragma("unroll") for (int n = 0; n < 2; ++n) _Pragma("unroll") for (int k = 0; k < 2; ++k) dst[n][k] = *(const LAS bf16x8*)(lds + PG8_SB(b, h) + boff + n * 2048 + k * 1024); } while (0)
#define PG8_MMA(ai, bj, At, Bt) do { __builtin_amdgcn_s_setprio(1); _Pragma("unroll") for (int m = 0; m < 4; ++m) _Pragma("unroll") for (int n = 0; n < 2; ++n) _Pragma("unroll") for (int k = 0; k < 2; ++k) \
        acc[ai][bj][m][n] = __builtin_amdgcn_mfma_f32_16x16x32_bf16(Bt[n][k], At[m][k], acc[ai][bj][m][n], 0, 0, 0); __builtin_amdgcn_s_setprio(0); } while (0)
#define PG8_WAIT_V(n) asm volatile("s_waitcnt vmcnt(" #n ")" ::: "memory")
#define PG8_WAIT_L(n) asm volatile("s_waitcnt lgkmcnt(" #n ")" ::: "memory")
#define PG8_BAR __builtin_amdgcn_s_barrier()
#define PG8_SCHED __builtin_amdgcn_sched_barrier(0)
    Unit cur, nxt; int ui = 0;
    if (!S.next(0, cur)) return;
    f32x4 acc[2][2][4][2];
#pragma unroll
    for (int a = 0; a < 2; ++a)
#pragma unroll
        for (int b = 0; b < 2; ++b)
#pragma unroll
            for (int m = 0; m < 4; ++m)
#pragma unroll
                for (int n = 0; n < 2; ++n) acc[a][b][m][n] = (f32x4){0.f, 0.f, 0.f, 0.f};
    bf16x8 At[4][2], B0[2][2], B1[2][2];
    const char* cA = (const char*)g.A + (size_t)cur.pm * tstep; const char* cB = (const char*)g.Bt + (size_t)cur.pn * tstep;
    PG8_STAGE(PG8_SB(0, 0), cB, voffB); PG8_STAGE(PG8_SB(0, 1), cB + hstep, voffB); PG8_STAGE(PG8_SA(0, 0), cA, voffA); PG8_STAGE(PG8_SA(0, 1), cA + hstep, voffA);
    if (wr == 1) PG8_BAR;
    PG8_WAIT_V(2); PG8_BAR;
    PG8_STAGE(PG8_SB(1, 0), cB + kstep, voffB); PG8_STAGE(PG8_SA(1, 0), cA + kstep, voffA); PG8_STAGE(PG8_SB(1, 1), cB + hstep + kstep, voffB);
    PG8_WAIT_V(6); PG8_BAR;
    for (;;) {
        const bool has_next = S.next(ui + 1, nxt);
        const char* nA = has_next ? (const char*)g.A + (size_t)nxt.pm * tstep : cA; const char* nB = has_next ? (const char*)g.Bt + (size_t)nxt.pn * tstep : cB;
        for (int t = 0; t < nt; t += 2) {
            const bool last = (t == nt - 2);
            const char* a1 = cA + (size_t)(t + 1) * kstep;
            const char* a2 = last ? nA : cA + (size_t)(t + 2) * kstep; const char* b2 = last ? nB : cB + (size_t)(t + 2) * kstep;
            const char* a3 = a2 + kstep; const char* b3 = b2 + kstep;
            if constexpr (Hook::ON) {
                if (t == HK.t0 || t == HK.t1) {
                    const LAS float* Fp = HK.F + (t == HK.t1 ? 256 : 0);
#pragma unroll
                    for (int ai = 0; ai < 2; ++ai)
#pragma unroll
                        for (int m = 0; m < 4; ++m) { const float f = Fp[ai * HALF + wr * 64 + m * 16 + fr];
#pragma unroll
                            for (int bj = 0; bj < 2; ++bj)
#pragma unroll
                                for (int n = 0; n < 2; ++n) acc[ai][bj][m][n] = acc[ai][bj][m][n] * f; }
                }
            }
            PG8_LDB(B0, 0, 0); PG8_LDB(B1, 0, 1); PG8_SCHED; PG8_LDA(At, 0, 0); PG8_STAGE(PG8_SA(1, 1), a1 + hstep, voffA);
            PG8_WAIT_V(8); PG8_WAIT_L(0); PG8_BAR; PG8_MMA(0, 0, At, B0); PG8_MMA(0, 1, At, B1); PG8_BAR; PG8_SCHED;
            PG8_LDA(At, 0, 1); PG8_STAGE(PG8_SB(0, 0), b2, voffB); PG8_STAGE(PG8_SB(0, 1), b2 + hstep, voffB); PG8_STAGE(PG8_SA(0, 0), a2, voffA);
            PG8_WAIT_V(8); PG8_WAIT_L(0); PG8_BAR; PG8_MMA(1, 0, At, B0); PG8_MMA(1, 1, At, B1); PG8_BAR; PG8_SCHED;
            PG8_LDB(B0, 1, 0); PG8_LDB(B1, 1, 1); PG8_SCHED; PG8_LDA(At, 1, 0); PG8_STAGE(PG8_SA(0, 1), a2 + hstep, voffA);
            PG8_WAIT_V(8); PG8_WAIT_L(0); PG8_BAR; PG8_MMA(0, 0, At, B0); PG8_MMA(0, 1, At, B1); PG8_BAR; PG8_SCHED;
            PG8_LDA(At, 1, 1); PG8_STAGE(PG8_SB(1, 0), b3, voffB); PG8_STAGE(PG8_SB(1, 1), b3 + hstep, voffB); PG8_STAGE(PG8_SA(1, 0), a3, voffA);
            PG8_WAIT_V(8); PG8_WAIT_L(0); PG8_BAR; PG8_MMA(1, 0, At, B0); PG8_MMA(1, 1, At, B1); PG8_BAR; PG8_SCHED;
        }
        if constexpr (ALIGN_EPI) { if (wr == 0) PG8_BAR; }
        if constexpr (!Epi::AFTER_DRAIN) { E(acc, cur, wr, wc, fr, fq); }
        if (!has_next) break;
#pragma unroll
        for (int a = 0; a < 2; ++a)
#pragma unroll
            for (int b = 0; b < 2; ++b)
#pragma unroll
                for (int m = 0; m < 4; ++m)
#pragma unroll
                    for (int n = 0; n < 2; ++n) acc[a][b][m][n] = (f32x4){0.f, 0.f, 0.f, 0.f};
        cur = nxt; cA = nA; cB = nB; ++ui;
        if constexpr (ALIGN_EPI) { if (wr == 1) PG8_BAR; }
    }
    PG8_WAIT_V(0);
    if constexpr (!ALIGN_EPI) { if (wr == 0) PG8_BAR; }
    PG8_BAR;
    if constexpr (Epi::AFTER_DRAIN) { E.fused(acc, cur, wr, wc, fr, fq, lds, wid, lane); }
#undef PG8_SA
#undef PG8_SB
#undef PG8_STAGE
#undef PG8_LDA
#undef PG8_LDB
#undef PG8_MMA
#undef PG8_WAIT_V
#undef PG8_WAIT_L
#undef PG8_BAR
#undef PG8_SCHED
}

__device__ __forceinline__ float row_rstd4(const float* ss, int row) {
    const float s = (ss[row] + ss[M + row]) + (ss[2 * M + row] + ss[3 * M + row]);
    return 1.0f / sqrtf(s * (1.0f / D) + EPS);
}

struct EpiSwiglu {
    static constexpr bool AFTER_DRAIN = false;
    bf16* H; const float* ss;
    __device__ __forceinline__ void operator()(const f32x4 (&acc)[2][2][4][2], const Unit& u, int wr, int wc, int fr, int fq) const {
        const int row0 = u.pm * BM + wr * 64 + fr, col0 = u.pn * HALF + wc * 32 + 8 * fq;
        const __amdgpu_buffer_rsrc_t hrs = wt_rsrc(H, (unsigned)((size_t)M * FF * 2));
        float r8[8];
#pragma unroll
        for (int gi = 0; gi < 8; ++gi) r8[gi] = ss ? row_rstd4(ss, row0 + (gi >> 2) * HALF + (gi & 3) * 16) : 1.0f;
#pragma unroll
        for (int ai = 0; ai < 2; ++ai)
#pragma unroll
            for (int m = 0; m < 4; ++m) { const int row = row0 + ai * HALF + m * 16;
                const float r = r8[ai * 4 + m];
                float h[8];
#pragma unroll
                for (int n = 0; n < 2; ++n)
#pragma unroll
                    for (int j = 0; j < 4; ++j) { const float gv = acc[ai][0][m][n][j] * r, uv = acc[ai][1][m][n][j] * r; h[4 * n + j] = silu_f(gv) * uv; }
                u32x4 w; w.x = cvt_pk_bf16(h[0], h[1]); w.y = cvt_pk_bf16(h[2], h[3]); w.z = cvt_pk_bf16(h[4], h[5]); w.w = cvt_pk_bf16(h[6], h[7]);
                st16_wt(hrs, ((size_t)row * FF + col0) * 2, w); }
    }
};
struct EpiProj {
    static constexpr bool AFTER_DRAIN = false;
    bf16* P; float* DT; const float* ss;
    __device__ __forceinline__ void operator()(const f32x4 (&acc)[2][2][4][2], const Unit& u, int wr, int wc, int fr, int fq) const {
        const int row0 = u.pm * BM + wr * 64 + fr;
        float r8[8];
#pragma unroll
        for (int gi = 0; gi < 8; ++gi) r8[gi] = ss ? row_rstd4(ss, row0 + (gi >> 2) * HALF + (gi & 3) * 16) : 1.0f;
        if (u.pn < 14) {
            const int col0 = u.pn * BM + wc * 32 + 8 * fq;
#pragma unroll
            for (int ai = 0; ai < 2; ++ai)
#pragma unroll
                for (int m = 0; m < 4; ++m) { const int row = row0 + ai * HALF + m * 16; const float r = r8[ai * 4 + m];
#pragma unroll
                    for (int bj = 0; bj < 2; ++bj) { const f32x4 v0 = acc[ai][bj][m][0] * r, v1 = acc[ai][bj][m][1] * r;
                        u32x4 w; w.x = cvtpk_s(v0[0], v0[1]); w.y = cvtpk_s(v0[2], v0[3]); w.z = cvtpk_s(v1[0], v1[1]); w.w = cvtpk_s(v1[2], v1[3]);
                        st16_wt(wt_rsrc(P, (unsigned)((size_t)M * PROJ_LD * 2)), ((size_t)row * PROJ_LD + col0 + bj * HALF) * 2, w); } }
        } else if (wc == 0 && fq < 2) {
#pragma unroll
            for (int ai = 0; ai < 2; ++ai)
#pragma unroll
                for (int m = 0; m < 4; ++m) { const int row = row0 + ai * HALF + m * 16; const float r = r8[ai * 4 + m];
                    *(f32x4*)(DT + (size_t)row * 16 + 8 * fq) = acc[ai][0][m][0] * r; *(f32x4*)(DT + (size_t)row * 16 + 8 * fq + 4) = acc[ai][0][m][1] * r; }
        }
    }
};
struct EpiFold {
    static constexpr bool AFTER_DRAIN = false;
    bf16* WO;
    __device__ __forceinline__ void operator()(const f32x4 (&acc)[2][2][4][2], const Unit& u, int wr, int wc, int fr, int fq) const {
        const int g = u.pm >> 2, n0 = (u.pm & 3) * BM + wr * 64 + fr, col0 = 1024 + 256 * g + wc * 32 + 8 * fq;
#pragma unroll
        for (int ai = 0; ai < 2; ++ai)
#pragma unroll
            for (int m = 0; m < 4; ++m) { const int n = n0 + ai * HALF + m * 16;
#pragma unroll
                for (int bj = 0; bj < 2; ++bj) { const f32x4 v0 = acc[ai][bj][m][0], v1 = acc[ai][bj][m][1];
                    u32x4 w; w.x = cvtpk_s(v0[0], v0[1]); w.y = cvtpk_s(v0[2], v0[3]); w.z = cvtpk_s(v1[0], v1[1]); w.w = cvtpk_s(v1[2], v1[3]);
                    *(u32x4*)(WO + (size_t)n * MIXD + col0 + bj * HALF) = w; } }
    }
};
struct EpiRes {
    static constexpr bool AFTER_DRAIN = true;
    const float* base; float* out; bf16* xn; float* ss; float scale;
    __device__ __forceinline__ void fused(const f32x4 (&acc)[2][2][4][2], const Unit& u, int wr, int wc, int fr, int fq, LAS unsigned char* lds, int wid, int lane) const {
        LAS float* Pt = (LAS float*)lds;
        const int row0 = u.pm * BM + wr * 64 + fr, col0 = u.pn * BM + wc * 32 + 8 * fq;
        f32x4 bq[3][4];
#pragma unroll
        for (int pg = 0; pg < 2; ++pg) { const size_t off = (size_t)(row0 + (pg >> 2) * HALF + (pg & 3) * 16) * D + col0;
#pragma unroll
          for (int bj = 0; bj < 2; ++bj) { bq[pg][2 * bj] = *(const f32x4*)(base + off + bj * HALF); bq[pg][2 * bj + 1] = *(const f32x4*)(base + off + bj * HALF + 4); } }
#pragma unroll
        for (int gi = 0; gi < 8; ++gi) { const int ai = gi >> 2, m = gi & 3;
            const int row = row0 + ai * HALF + m * 16; const size_t off = (size_t)row * D + col0; float q = 0.f;
            if (gi < 6) { const int ai2 = (gi + 2) >> 2, m2 = (gi + 2) & 3; const size_t off2 = (size_t)(row0 + ai2 * HALF + m2 * 16) * D + col0;
#pragma unroll
                for (int bj = 0; bj < 2; ++bj) { bq[(gi + 2) % 3][2 * bj] = *(const f32x4*)(base + off2 + bj * HALF); bq[(gi + 2) % 3][2 * bj + 1] = *(const f32x4*)(base + off2 + bj * HALF + 4); } }
            f32x4 bc[4];
#pragma unroll
            for (int k = 0; k < 4; ++k) bc[k] = bq[gi % 3][k];
#pragma unroll
            for (int bj = 0; bj < 2; ++bj) {
                const f32x4 v0 = bc[2 * bj] + acc[ai][bj][m][0] * scale, v1 = bc[2 * bj + 1] + acc[ai][bj][m][1] * scale;
                *(f32x4*)(out + off + bj * HALF) = v0; *(f32x4*)(out + off + bj * HALF + 4) = v1;
                if (xn) { u32x4 w; w.x = cvt_pk_bf16(v0[0], v0[1]); w.y = cvt_pk_bf16(v0[2], v0[3]); w.z = cvt_pk_bf16(v1[0], v1[1]); w.w = cvt_pk_bf16(v1[2], v1[3]);
                    *(u32x4*)(xn + off + bj * HALF) = w; }
                q += (v0[0] * v0[0] + v0[1] * v0[1]) + (v0[2] * v0[2] + v0[3] * v0[3]) + (v1[0] * v1[0] + v1[1] * v1[1]) + (v1[2] * v1[2] + v1[3] * v1[3]); }
            q += __shfl_xor(q, 16); q += __shfl_xor(q, 32);
            if (fq == 0) Pt[(ai * HALF + wr * 64 + m * 16 + fr) * 4 + wc] = q; }
        LDS_WAIT(); __builtin_amdgcn_s_barrier(); asm volatile("" ::: "memory");
        const int t = wid * 64 + lane;
        if (t < 256) { const float s = (Pt[t * 4 + 0] + Pt[t * 4 + 1]) + (Pt[t * 4 + 2] + Pt[t * 4 + 3]); ss[(size_t)u.pn * M + u.pm * BM + t] = s; }
    }
};
struct EpiResNorm {
    static constexpr bool AFTER_DRAIN = true;
    const float* base; float* out; const float* gain; bf16* xn; float* ss; unsigned* cnt; float scale;
    __device__ __forceinline__ void fused(f32x4 (&acc)[2][2][4][2], const Unit& u, int wr, int wc, int fr, int fq, LAS unsigned char* lds, int wid, int lane) const {
        LAS float* Pt = (LAS float*)lds;
        LAS float* Rt = (LAS float*)(lds + 4096);
        const int row0 = u.pm * BM + wr * 64 + fr, col0 = u.pn * BM + wc * 32 + 8 * fq;
        f32x4 bq[3][4];
#pragma unroll
        for (int pg = 0; pg < 2; ++pg) { const size_t off = (size_t)(row0 + (pg >> 2) * HALF + (pg & 3) * 16) * D + col0;
#pragma unroll
          for (int bj = 0; bj < 2; ++bj) { bq[pg][2 * bj] = *(const f32x4*)(base + off + bj * HALF); bq[pg][2 * bj + 1] = *(const f32x4*)(base + off + bj * HALF + 4); } }
#pragma unroll
        for (int gi = 0; gi < 8; ++gi) { const int ai = gi >> 2, m = gi & 3; float q = 0.f;
            if (gi < 6) { const int ai2 = (gi + 2) >> 2, m2 = (gi + 2) & 3; const size_t off2 = (size_t)(row0 + ai2 * HALF + m2 * 16) * D + col0;
#pragma unroll
                for (int bj = 0; bj < 2; ++bj) { bq[(gi + 2) % 3][2 * bj] = *(const f32x4*)(base + off2 + bj * HALF); bq[(gi + 2) % 3][2 * bj + 1] = *(const f32x4*)(base + off2 + bj * HALF + 4); } }
            f32x4 bc[4];
#pragma unroll
            for (int k = 0; k < 4; ++k) bc[k] = bq[gi % 3][k];
#pragma unroll
            for (int bj = 0; bj < 2; ++bj) {
                const f32x4 v0 = bc[2 * bj] + acc[ai][bj][m][0] * scale, v1 = bc[2 * bj + 1] + acc[ai][bj][m][1] * scale;
                acc[ai][bj][m][0] = v0; acc[ai][bj][m][1] = v1;
                if (xn) { const size_t offo = (size_t)(row0 + ai * HALF + m * 16) * D + col0 + bj * HALF; *(f32x4*)(out + offo) = v0; *(f32x4*)(out + offo + 4) = v1; }
                q += (v0[0] * v0[0] + v0[1] * v0[1]) + (v0[2] * v0[2] + v0[3] * v0[3]) + (v1[0] * v1[0] + v1[1] * v1[1]) + (v1[2] * v1[2] + v1[3] * v1[3]); }
            q += __shfl_xor(q, 16); q += __shfl_xor(q, 32);
            if (fq == 0) Pt[(ai * HALF + wr * 64 + m * 16 + fr) * 4 + wc] = q; }
        LDS_WAIT(); __builtin_amdgcn_s_barrier(); asm volatile("" ::: "memory");
        const int t = wid * 64 + lane;
        if (t < 256) { const float sp = (Pt[t * 4 + 0] + Pt[t * 4 + 1]) + (Pt[t * 4 + 2] + Pt[t * 4 + 3]);
            __hip_atomic_store(ss + (size_t)u.pn * M + u.pm * BM + t, sp, __ATOMIC_RELAXED, __HIP_MEMORY_SCOPE_AGENT); }
        asm volatile("s_waitcnt vmcnt(0)" ::: "memory");
        if (t < 256 && lane == 0) __hip_atomic_fetch_add(cnt + 16 * u.pm, 1u, __ATOMIC_RELAXED, __HIP_MEMORY_SCOPE_AGENT);
        if (wid == 0) {
            unsigned sp_ = 0;
            while ((unsigned)__builtin_amdgcn_readfirstlane(__hip_atomic_load(cnt + 16 * u.pm, __ATOMIC_RELAXED, __HIP_MEMORY_SCOPE_AGENT)) < 16u) { __builtin_amdgcn_s_sleep(1); if (++sp_ > (1u << 22)) break; }
            __builtin_amdgcn_fence(__ATOMIC_ACQUIRE, "agent");
        }
        asm volatile("s_waitcnt vmcnt(0) lgkmcnt(0)" ::: "memory"); __builtin_amdgcn_s_barrier(); asm volatile("" ::: "memory");
        if (t < 256) { float s4 = 0.f;
#pragma unroll
            for (int p = 0; p < 4; ++p) s4 += __hip_atomic_load(ss + (size_t)p * M + u.pm * BM + t, __ATOMIC_RELAXED, __HIP_MEMORY_SCOPE_AGENT);
            Rt[t] = 1.0f / sqrtf(s4 * (1.0f / D) + EPS); }
        f32x4 gv[4];
#pragma unroll
        for (int k = 0; k < 4; ++k) gv[k] = (f32x4){1.f, 1.f, 1.f, 1.f};
        if (!xn) {
#pragma unroll
            for (int bj = 0; bj < 2; ++bj) { gv[2 * bj] = *(const f32x4*)(gain + col0 + bj * HALF); gv[2 * bj + 1] = *(const f32x4*)(gain + col0 + bj * HALF + 4); } }
        LDS_WAIT(); __builtin_amdgcn_s_barrier(); asm volatile("" ::: "memory");
#pragma unroll
        for (int gi = 0; gi < 8; ++gi) { const int ai = gi >> 2, m = gi & 3; const int rl = ai * HALF + wr * 64 + m * 16 + fr; const float r = Rt[rl];
            const size_t off = (size_t)(u.pm * BM + rl) * D + col0;
#pragma unroll
            for (int bj = 0; bj < 2; ++bj) { const f32x4 o0 = acc[ai][bj][m][0] * r * gv[2 * bj], o1 = acc[ai][bj][m][1] * r * gv[2 * bj + 1];
                if (xn) { u32x4 w; w.x = cvt_pk_bf16(o0[0], o0[1]); w.y = cvt_pk_bf16(o0[2], o0[3]); w.z = cvt_pk_bf16(o1[0], o1[1]); w.w = cvt_pk_bf16(o1[2], o1[3]); *(u32x4*)(xn + off + bj * HALF) = w; }
                else { *(f32x4*)(out + off + bj * HALF) = o0; *(f32x4*)(out + off + bj * HALF + 4) = o1; } } }
    }
};
template <bool BASE_BF16, bool FINAL>
struct EpiResX {
    static constexpr bool AFTER_DRAIN = true;
    const float* base; const bf16* bbn; const float* brs; float* out; const float* gain; bf16* xn; float* rs_out; float* ss; unsigned* cnt; float scale; const float* cgain;
    __device__ __forceinline__ void fused(f32x4 (&acc)[2][2][4][2], const Unit& u, int wr, int wc, int fr, int fq, LAS unsigned char* lds, int wid, int lane) const {
        LAS float* Pt = (LAS float*)lds;
        LAS float* Rt = (LAS float*)(lds + 4096);
        const int row0 = u.pm * BM + wr * 64 + fr, col0 = u.pn * BM + wc * 32 + 8 * fq;
        float inv8[8];
#pragma unroll
        for (int gi = 0; gi < 8; ++gi) inv8[gi] = BASE_BF16 ? brs[row0 + (gi >> 2) * HALF + (gi & 3) * 16] : 1.0f;
        f32x4 ci[4];
#pragma unroll
        for (int k = 0; k < 4; ++k) ci[k] = (f32x4){1.f, 1.f, 1.f, 1.f};
        if (BASE_BF16 && cgain) {
#pragma unroll
            for (int k = 0; k < 4; ++k) { const f32x4 gq = *(const f32x4*)(cgain + col0 + (k >> 1) * HALF + (k & 1) * 4); ci[k] = (f32x4){1.0f / gq[0], 1.0f / gq[1], 1.0f / gq[2], 1.0f / gq[3]}; } }
        f32x4 bq[3][4]; u32x4 bqb[3][2];
#define ERX_LOAD(slot, g_) do { const size_t off_ = (size_t)(row0 + ((g_) >> 2) * HALF + ((g_) & 3) * 16) * D + col0; \
            if constexpr (BASE_BF16) { bqb[slot][0] = *(const u32x4*)(bbn + off_); bqb[slot][1] = *(const u32x4*)(bbn + off_ + HALF); } \
            else { _Pragma("unroll") for (int bj_ = 0; bj_ < 2; ++bj_) { bq[slot][2 * bj_] = *(const f32x4*)(base + off_ + bj_ * HALF); bq[slot][2 * bj_ + 1] = *(const f32x4*)(base + off_ + bj_ * HALF + 4); } } } while (0)
        ERX_LOAD(0, 0); ERX_LOAD(1, 1);
#pragma unroll
        for (int gi = 0; gi < 8; ++gi) { const int ai = gi >> 2, m = gi & 3; float q = 0.f;
            if (gi < 6) ERX_LOAD((gi + 2) % 3, gi + 2);
            f32x4 bc[4];
            if constexpr (BASE_BF16) { const float iv = inv8[gi];
#pragma unroll
                for (int bj = 0; bj < 2; ++bj) { const u32x4 w = bqb[gi % 3][bj];
                    bc[2 * bj] = (f32x4){bflo(w.x), bfhi(w.x), bflo(w.y), bfhi(w.y)} * iv * ci[2 * bj]; bc[2 * bj + 1] = (f32x4){bflo(w.z), bfhi(w.z), bflo(w.w), bfhi(w.w)} * iv * ci[2 * bj + 1]; }
            } else {
#pragma unroll
                for (int k = 0; k < 4; ++k) bc[k] = bq[gi % 3][k]; }
#pragma unroll
            for (int bj = 0; bj < 2; ++bj) {
                const f32x4 v0 = bc[2 * bj] + acc[ai][bj][m][0] * scale, v1 = bc[2 * bj + 1] + acc[ai][bj][m][1] * scale;
                acc[ai][bj][m][0] = v0; acc[ai][bj][m][1] = v1;
                q += (v0[0] * v0[0] + v0[1] * v0[1]) + (v0[2] * v0[2] + v0[3] * v0[3]) + (v1[0] * v1[0] + v1[1] * v1[1]) + (v1[2] * v1[2] + v1[3] * v1[3]); }
            q += __shfl_xor(q, 16); q += __shfl_xor(q, 32);
            if (fq == 0) Pt[(ai * HALF + wr * 64 + m * 16 + fr) * 4 + wc] = q; }
#undef ERX_LOAD
        LDS_WAIT(); __builtin_amdgcn_s_barrier(); asm volatile("" ::: "memory");
        const int t = wid * 64 + lane;
        if (t < 256) { const float sp = (Pt[t * 4 + 0] + Pt[t * 4 + 1]) + (Pt[t * 4 + 2] + Pt[t * 4 + 3]);
            __hip_atomic_store(ss + (size_t)u.pn * M + u.pm * BM + t, sp, __ATOMIC_RELAXED, __HIP_MEMORY_SCOPE_AGENT); }
        asm volatile("s_waitcnt vmcnt(0)" ::: "memory");
        if (t < 256 && lane == 0) __hip_atomic_fetch_add(cnt + 16 * u.pm, 1u, __ATOMIC_RELAXED, __HIP_MEMORY_SCOPE_AGENT);
        if (wid == 0) {
            unsigned sp_ = 0;
            while ((unsigned)__builtin_amdgcn_readfirstlane(__hip_atomic_load(cnt + 16 * u.pm, __ATOMIC_RELAXED, __HIP_MEMORY_SCOPE_AGENT)) < 16u) { __builtin_amdgcn_s_sleep(1); if (++sp_ > (1u << 22)) break; }
            __builtin_amdgcn_fence(__ATOMIC_ACQUIRE, "agent");
        }
        asm volatile("s_waitcnt vmcnt(0) lgkmcnt(0)" ::: "memory"); __builtin_amdgcn_s_barrier(); asm volatile("" ::: "memory");
        if (t < 256) { float s4 = 0.f;
#pragma unroll
            for (int p = 0; p < 4; ++p) s4 += __hip_atomic_load(ss + (size_t)p * M + u.pm * BM + t, __ATOMIC_RELAXED, __HIP_MEMORY_SCOPE_AGENT);
            const float ms = s4 * (1.0f / D) + EPS, sq = sqrtf(ms);
            Rt[t] = 1.0f / sq;
            if (!FINAL && u.pn == 0) rs_out[u.pm * BM + t] = sq; }
        f32x4 gv[4];
#pragma unroll
        for (int k = 0; k < 4; ++k) gv[k] = (f32x4){1.f, 1.f, 1.f, 1.f};
        if constexpr (FINAL) {
#pragma unroll
            for (int bj = 0; bj < 2; ++bj) { gv[2 * bj] = *(const f32x4*)(gain + col0 + bj * HALF); gv[2 * bj + 1] = *(const f32x4*)(gain + col0 + bj * HALF + 4); } }
        LDS_WAIT(); __builtin_amdgcn_s_barrier(); asm volatile("" ::: "memory");
#pragma unroll
        for (int gi = 0; gi < 8; ++gi) { const int ai = gi >> 2, m = gi & 3; const int rl = ai * HALF + wr * 64 + m * 16 + fr; const float r = Rt[rl];
            const size_t off = (size_t)(u.pm * BM + rl) * D + col0;
#pragma unroll
            for (int bj = 0; bj < 2; ++bj) { const f32x4 o0 = acc[ai][bj][m][0] * r * gv[2 * bj], o1 = acc[ai][bj][m][1] * r * gv[2 * bj + 1];
                if constexpr (!FINAL) { u32x4 w; w.x = cvt_pk_bf16(o0[0], o0[1]); w.y = cvt_pk_bf16(o0[2], o0[3]); w.z = cvt_pk_bf16(o1[0], o1[1]); w.w = cvt_pk_bf16(o1[2], o1[3]); st16_wt(wt_rsrc(xn, (unsigned)((size_t)M * D * 2)), (off + bj * HALF) * 2, w); }
                else { *(f32x4*)(out + off + bj * HALF) = o0; *(f32x4*)(out + off + bj * HALF + 4) = o1; } } }
    }
};
}

#define XB_TMO      128
#define XB_XCNT(j)  (256  + 64 * (j))
#define XB_XSUB(j)  (1280 + 64 * (j))
#define XB_XGEN(j)  (2304 + 64 * (j))
#define XB_TOP      3328
#define XB_TOPGEN   3392
#define XCD_BAR_WORDS 3456
#define XB_SPIN_CAP (1u << 18)
__device__ __forceinline__ unsigned xb_ld(unsigned* p)              { return __hip_atomic_load(p, __ATOMIC_RELAXED, __HIP_MEMORY_SCOPE_AGENT); }
__device__ __forceinline__ unsigned xb_add(unsigned* p, unsigned v) { return __hip_atomic_fetch_add(p, v, __ATOMIC_RELAXED, __HIP_MEMORY_SCOPE_AGENT); }
__device__ __forceinline__ unsigned xb_xcc_id() { return (unsigned)__builtin_amdgcn_s_getreg((3 << 11) | 20) & 0xFu; }
#define XB_SPIN(cond, bar) do { unsigned _sp = 0; while (cond) { __builtin_amdgcn_s_sleep(1); \
    if ((++_sp & 255u) == 0u) { if (xb_ld(&(bar)[XB_TMO])) break; if (_sp > XB_SPIN_CAP) { atomicAdd(&(bar)[XB_TMO], 1u); break; } } } } while (0)
struct XcdBarrier { unsigned* bar; unsigned x; volatile LAS unsigned* st; };
__device__ __forceinline__ XcdBarrier xcd_barrier_post(unsigned* bar, volatile LAS unsigned* st) {
    XcdBarrier b; b.bar = bar; b.x = xb_xcc_id(); b.st = st;
    if (threadIdx.x == 0) (void)xb_add(&bar[XB_XCNT(b.x)], 1u);
    return b;
}
__device__ __forceinline__ void xcd_barrier_complete(unsigned* bar, unsigned x, unsigned& nloc, unsigned& nx) {
    const unsigned G = gridDim.x * gridDim.y * gridDim.z;
    unsigned sum, cnt, mine, sp = 0u;
    for (;;) {
        sum = 0u; cnt = 0u; mine = 0u;
#pragma unroll
        for (unsigned j = 0; j < 16; ++j) { const unsigned c = xb_ld(&bar[XB_XCNT(j)]); sum += c; cnt += (c > 0u) ? 1u : 0u; mine = (j == x) ? c : mine; }
        if (sum == G) break;
        __builtin_amdgcn_s_sleep(1);
        if ((++sp & 255u) == 0u) { if (xb_ld(&bar[XB_TMO])) break; if (sp > XB_SPIN_CAP) { atomicAdd(&bar[XB_TMO], 1u); break; } }
    }
    nloc = mine > 0u ? mine : 1u; nx = cnt > 0u ? cnt : 1u;
}
__device__ __forceinline__ void xcd_barrier(const XcdBarrier& b) {
    asm volatile("s_waitcnt vmcnt(0)" ::: "memory");
    __syncthreads();
    if (threadIdx.x == 0) {
        unsigned* bar = b.bar;
        __builtin_amdgcn_s_waitcnt(0);
        unsigned nloc = b.st[0], nx = b.st[1];
        if (nloc == 0u) { xcd_barrier_complete(bar, b.x, nloc, nx); b.st[0] = nloc; b.st[1] = nx; }
        const unsigned old = xb_add(&bar[XB_XSUB(b.x)], 1u);
        const unsigned gen = old / nloc;
        if (old + 1u == (gen + 1u) * nloc) {
            __builtin_amdgcn_fence(__ATOMIC_RELEASE, "agent");
            asm volatile("s_waitcnt vmcnt(0)" ::: "memory");
            const unsigned og = xb_add(&bar[XB_TOP], 1u);
            const unsigned tg = og / nx;
            if (og + 1u == (tg + 1u) * nx) xb_add(&bar[XB_TOPGEN], 1u);
            else XB_SPIN(xb_ld(&bar[XB_TOPGEN]) == tg, bar);
            __builtin_amdgcn_fence(__ATOMIC_ACQUIRE, "agent");
            xb_add(&bar[XB_XGEN(b.x)], 1u);
            asm volatile("s_waitcnt vmcnt(0)" ::: "memory");
        } else {
            XB_SPIN(xb_ld(&bar[XB_XGEN(b.x)]) == gen, bar);
            __builtin_amdgcn_fence(__ATOMIC_ACQUIRE, "agent");
            asm volatile("s_waitcnt vmcnt(0)" ::: "memory");
        }
    }
    __syncthreads();
}

__device__ __forceinline__ void p0_transpose_item(const float* W, int ldw, int k0, int nsrc0, int nvalid, const float* kscale, bf16* WT, int ldk, int ndst0, LAS float* scr, int lane) {
    const int n4 = (lane & 7) * 4;
    const int n4c = n4 < nvalid ? n4 : 0;
    f32x4 tv[8]; float ksv[8];
#pragma unroll
    for (int i = 0; i < 8; ++i) { const int kk = 8 * i + (lane >> 3); tv[i] = __builtin_nontemporal_load((const f32x4*)(W + (size_t)(k0 + kk) * ldw + nsrc0 + n4c)); }
    if (kscale) {
#pragma unroll
        for (int i = 0; i < 8; ++i) ksv[i] = kscale[k0 + 8 * i + (lane >> 3)];
#pragma unroll
        for (int i = 0; i < 8; ++i) tv[i] = tv[i] * ksv[i]; }
#pragma unroll
    for (int i = 0; i < 8; ++i) { const int kk = 8 * i + (lane >> 3);
        scr[kk * 33 + n4] = tv[i].x; scr[kk * 33 + n4 + 1] = tv[i].y; scr[kk * 33 + n4 + 2] = tv[i].z; scr[kk * 33 + n4 + 3] = tv[i].w; }
    LDS_WAIT(); asm volatile("" ::: "memory");
    const int c = lane & 7;
#pragma unroll
    for (int j = 0; j < 4; ++j) { const int n = (lane >> 3) + 8 * j; const LAS float* s = scr + (8 * c) * 33 + n;
        u32x4 o; o.x = pk2(s[0 * 33], s[1 * 33]); o.y = pk2(s[2 * 33], s[3 * 33]); o.z = pk2(s[4 * 33], s[5 * 33]); o.w = pk2(s[6 * 33], s[7 * 33]);
        if (n < nvalid) *(u32x4*)(WT + (size_t)(ndst0 + n) * ldk + k0 + 8 * c) = o; }
    LDS_WAIT(); asm volatile("" ::: "memory");
}

struct Args { const float* in[21]; float* out; unsigned char* ws; int ph_lo, ph_hi; };

template <int PART>
__device__ __forceinline__ void p0_prologue(const Args& a, LAS unsigned char* lds, int gw, int NGW, int wave, int lane) {
    LAS float* scr = (LAS float*)(lds + wave * 16384);
    unsigned char* ws = a.ws;
    bf16 *GU1 = (bf16*)(ws + WS_GU1), *D1 = (bf16*)(ws + WS_D1), *GU2 = (bf16*)(ws + WS_GU2), *D2 = (bf16*)(ws + WS_D2), *WIN = (bf16*)(ws + WS_WIN), *WOUT = (bf16*)(ws + WS_WOUT), *XN = (bf16*)(ws + WS_XN);
    if constexpr (PART == 0) {
        const float* gain = a.in[1];
        f32x4 gv[4];
#pragma unroll
        for (int j = 0; j < 4; ++j) gv[j] = *((const f32x4*)gain + lane + 64 * j);
        for (int m = gw; m < M; m += 4 * NGW) {
            f32x4 v[4][4];
#pragma unroll
            for (int q = 0; q < 4; ++q) { const int mm = m + q * NGW; const f32x4* xr = (const f32x4*)(a.in[0] + (size_t)(mm < M ? mm : m) * D) + lane;
#pragma unroll
                for (int j = 0; j < 4; ++j) v[q][j] = __builtin_nontemporal_load(xr + 64 * j); }
#pragma unroll
            for (int q = 0; q < 4; ++q) { const int mm = m + q * NGW; float s = 0.f;
#pragma unroll
                for (int j = 0; j < 4; ++j) s += (v[q][j].x * v[q][j].x + v[q][j].y * v[q][j].y) + (v[q][j].z * v[q][j].z + v[q][j].w * v[q][j].w);
                const float sq0 = sqrtf(wave_sum(s) * (1.0f / D) + EPS), r = 1.0f / sq0;
                if (mm < M && lane == 0) ((float*)(ws + WS_RS0))[mm] = sq0;
                if (mm < M) { u32x2* o8 = (u32x2*)(XN + (size_t)mm * D) + lane;
#pragma unroll
                    for (int j = 0; j < 4; ++j) { u32x2 w; w.x = pk2(v[q][j].x * r * gv[j].x, v[q][j].y * r * gv[j].y); w.y = pk2(v[q][j].z * r * gv[j].z, v[q][j].w * r * gv[j].w); o8[64 * j] = w; } } }
        }
    }
    constexpr int I_GU = 16 * 88, I_DN = 44 * 32, I_IN = 16 * 113, I_OUT = 16 * 32;
    if constexpr (PART == 0) {
    for (int it = gw; it < 4 * I_GU; it += NGW) {
        int r = it; const int which = r / I_GU; r -= which * I_GU; const int kb = r / 88, nb = r % 88, j0 = 32 * nb;
        const float* W = a.in[which == 0 ? 2 : which == 1 ? 3 : which == 2 ? 17 : 18];
        const float* ks = which >= 2 ? a.in[16] : nullptr;
        bf16* WT = which >= 2 ? GU2 : GU1;
        p0_transpose_item(W, FF, 64 * kb, j0, 32, ks, WT, D, 256 * (j0 >> 7) + (j0 & 127) + 128 * (which & 1), scr, lane); }
    }
    if constexpr (PART == 1 || PART == 2) {
    for (int it = gw; it < I_DN; it += NGW) { const int kb = it / 32, nb = it % 32;
        p0_transpose_item(a.in[PART == 2 ? 19 : 4], D, 64 * kb, 32 * nb, 32, nullptr, PART == 2 ? D2 : D1, FF, 32 * nb, scr, lane); }
    }
    if constexpr (PART == 1) {
    for (int it = gw; it < I_IN + I_OUT; it += NGW) {
        int r = it;
        if (r < I_IN) { const int kb = r / 113, db = r % 113;
            const int nd = 32 * db, nsrc = db < 80 ? nd : (db < 112 ? nd + 16 : 2560), nv = db < 112 ? 32 : 16;
            p0_transpose_item(a.in[6], 3600, 64 * kb, nsrc, nv, a.in[5], WIN, D, nd, scr, lane); continue; }
        r -= I_IN;
        { const int kb = r / 32, nb = r % 32;
            p0_transpose_item(a.in[15], D, 64 * kb, 32 * nb, 32, a.in[12], WOUT, MIXD, 32 * nb, scr, lane); }
    }
    for (int it = gw; it < 16 * 32; it += NGW) { const int kb = it / 32, nb = it % 32;
        p0_transpose_item(a.in[15] + (size_t)1024 * D, D, 64 * kb, 32 * nb, 32, nullptr, (bf16*)(ws + WS_FA) + (size_t)(kb >> 2) * 1024 * 256 - (size_t)(kb >> 2) * 256, 256, 32 * nb, scr, lane); }
    { bf16* FB = (bf16*)(ws + WS_FB);
      for (int i = gw * 64 + lane; i < 4 * 256 * 256 / 4; i += NGW * 64) { const int e0 = 4 * i, g = e0 >> 16, d = e0 & 255;
          const f32x4 w = *(const f32x4*)(a.in[13] + e0), sc = *(const f32x4*)(a.in[14] + 256 * g + d);
          *(u32x2*)(FB + e0) = (u32x2){pk2(w.x * sc.x, w.y * sc.y), pk2(w.z * sc.z, w.w * sc.w)}; } }
    }
}

constexpr int SB_CC = 0, SB_BC = 17408, SB_XT = 34816, SB_XD = 39424, SB_VEC = 44032, SB_STRIDE = 45056;
constexpr int SL_MM = 90112, SL_SL = 99328, SL_END = 108032;
constexpr int P272 = 272, P144 = 144;
typedef short v4i16_t __attribute__((ext_vector_type(4)));

__device__ __forceinline__ void unpack8(const u32x4 r, float (&f)[8]) { f[0] = bflo(r.x); f[1] = bfhi(r.x); f[2] = bflo(r.y); f[3] = bfhi(r.y); f[4] = bflo(r.z); f[5] = bfhi(r.z); f[6] = bflo(r.w); f[7] = bfhi(r.w); }

__device__ __forceinline__ void conv8x4(const bf16* PROJ, size_t tok0, int tseq, int col, const float* conv_w, const float* conv_b, bf16* dst, int pitch) {
    float wbc[4][8], bbc[8];
#pragma unroll
    for (int k = 0; k < 4; ++k) { const f32x4 w0 = *(const f32x4*)(conv_w + k * CONV_DIM + col - 1024), w1 = *(const f32x4*)(conv_w + k * CONV_DIM + col - 1024 + 4);
#pragma unroll
        for (int e = 0; e < 4; ++e) { wbc[k][e] = w0[e]; wbc[k][4 + e] = w1[e]; } }
    { const f32x4 w0 = *(const f32x4*)(conv_b + col - 1024), w1 = *(const f32x4*)(conv_b + col - 1024 + 4);
#pragma unroll
        for (int e = 0; e < 4; ++e) { bbc[e] = w0[e]; bbc[4 + e] = w1[e]; } }
    u32x4 rbc[7];
#pragma unroll
    for (int i = 0; i < 7; ++i) { rbc[i] = (u32x4){0u, 0u, 0u, 0u}; if (tseq - 3 + i >= 0) rbc[i] = *(const u32x4*)(PROJ + (tok0 + tseq - 3 + i) * PROJ_LD + col); }
    float ob[4][8];
#pragma unroll
    for (int j = 0; j < 4; ++j)
#pragma unroll
        for (int e = 0; e < 8; ++e) ob[j][e] = bbc[e];
#pragma unroll
    for (int i = 0; i < 7; ++i) { float f[8]; unpack8(rbc[i], f);
#pragma unroll
        for (int j = 0; j < 4; ++j) { const int k = i - j; if (k >= 0 && k < 4) {
#pragma unroll
            for (int e = 0; e < 8; ++e) ob[j][e] += wbc[k][e] * f[e]; } } }
#pragma unroll
    for (int j = 0; j < 4; ++j) {
#pragma unroll
        for (int e = 0; e < 8; ++e) ob[j][e] = silu_f(ob[j][e]);
        u32x4 w; w.x = cvt_pk_bf16(ob[j][0], ob[j][1]); w.y = cvt_pk_bf16(ob[j][2], ob[j][3]); w.z = cvt_pk_bf16(ob[j][4], ob[j][5]); w.w = cvt_pk_bf16(ob[j][6], ob[j][7]);
        *(u32x4*)(dst + (size_t)j * pitch) = w; }
}

__device__ __forceinline__ void conv_phase(const Args& a, int G, int vc) {
    const int tid = threadIdx.x, lane = tid & 63, wave = __builtin_amdgcn_readfirstlane(tid >> 6);
    const bf16* PROJ = (const bf16*)(a.ws + WS_PROJ);
    bf16* BCG = (bf16*)a.out;
    bf16* MIX = (bf16*)(a.ws + WS_MIX);
    const float* DT = (const float*)(a.ws + WS_DT);
    float* DTV = (float*)(a.ws + WS_DTV); float* CSV = (float*)(a.ws + WS_CSV);
    const float* conv_w = a.in[7]; const float* conv_b = a.in[8];
    for (int uu = 2 * vc; uu < 512; uu += 2 * G)
    for (int unit = uu; unit < uu + 2; ++unit) {
        const int b = unit >> 6, c = (unit >> 1) & 31, g = unit & 1;
        const size_t tok0 = (size_t)b * SEQ;
        { const int cg = tid & 31, tl = tid >> 5;
          conv8x4(PROJ, tok0, c * 64 + 4 * tl, B_OFF + (cg >> 4) * 256 + g * 128 + 8 * (cg & 15), conv_w, conv_b, BCG + (size_t)unit * 16384 + (4 * tl) * 256 + 8 * cg, 256); }
#pragma unroll 1
        for (int pass = 0; pass < 2; ++pass) { const int cgx = tid & 63, tlx = (tid >> 6) + 8 * pass; const int ch = g * 512 + 8 * cgx;
          conv8x4(PROJ, tok0, c * 64 + 4 * tlx, XS_OFF + ch, conv_w, conv_b, MIX + (tok0 + c * 64 + 4 * tlx) * MIXD + ch, MIXD); }
        { const int h = 8 * g + wave; const size_t tok = tok0 + c * 64 + lane;
          const float xdt = DT[tok * 16 + h] + a.in[9][h];
          const float dtv = xdt > 20.f ? xdt : log1pf(expf(xdt));
          float cs = dtv * (-expf(a.in[10][h]));
#pragma unroll
          for (int o = 1; o < 64; o <<= 1) { const float t = __shfl_up(cs, o); if (lane >= o) cs += t; }
          DTV[tok * 16 + h] = dtv; CSV[tok * 16 + h] = cs; }
    }
}

__device__ __forceinline__ void ssd_phase(LAS unsigned char* lds, const Args& a, int G, int vc) {
    const int tid = threadIdx.x, lane = tid & 63, wave = __builtin_amdgcn_readfirstlane(tid >> 6);
    const int l16 = lane & 15, quad = lane >> 4;
    const bf16* PROJ = (const bf16*)(a.ws + WS_PROJ);
    const bf16* BCG = (const bf16*)a.out;
    const float* DTV = (const float*)(a.ws + WS_DTV); const float* CSV = (const float*)(a.ws + WS_CSV);
    bf16* MIX = (bf16*)(a.ws + WS_MIX);
    float* PSS = (float*)(a.ws + WS_PSS);
    for (int item = vc; item < 256; item += G) {
        const int b = item >> 5, h = (item >> 1) & 15, ph = item & 1, g = h >> 3;
        const float Dh = a.in[11][h];
        const int xtok = tid >> 3, xc4 = tid & 7;
        const int x_ch = h * 64 + ph * 32 + 4 * xc4;
        f32x4 accS[2]; accS[0] = (f32x4){0.f, 0.f, 0.f, 0.f}; accS[1] = accS[0];
        for (int i = tid; i < (SL_END - SL_SL) / 4; i += NTHR) ((LAS unsigned*)(lds + SL_SL))[i] = 0u;
        const size_t tok0 = (size_t)b * SEQ;
        const int ti = wave >> 1, q = wave & 1;
        const int pcol = h * 64 + ph * 32 + 16 * q + 4 * quad;
        u32x4 rbA[2][4]; u32x2 xrA[2]; float dtvA[2], csA[2]; u32x2 zrA[2];
#define SSD_LOAD_RAW(c, S) do { const bf16* ub = BCG + ((size_t)(b * 32 + (c)) * 2 + g) * 16384; \
            _Pragma("unroll") for (int k = 0; k < 4; ++k) rbA[S][k] = *(const u32x4*)(ub + (size_t)(tid + 512 * k) * 8); \
            xrA[S] = *(const u32x2*)(MIX + (tok0 + (size_t)(c) * 64 + xtok) * MIXD + x_ch); \
            dtvA[S] = DTV[(tok0 + (c) * 64 + lane) * 16 + h]; csA[S] = CSV[(tok0 + (c) * 64 + lane) * 16 + h]; \
            zrA[S] = *(const u32x2*)(PROJ + (tok0 + (size_t)(c) * 64 + 16 * ti + l16) * PROJ_LD + Z_OFF + pcol); } while (0)
        SSD_LOAD_RAW(0, 0); SSD_LOAD_RAW(1, 1);
#pragma unroll 2
        for (int c = 0; c < 32; ++c) {
            const int S = c & 1;
            const float dtv = dtvA[S], cs = csA[S]; const u32x2 xr = xrA[S];
            LAS unsigned char* sb = lds + (c & 1) * SB_STRIDE;
            const float cs63 = __shfl(cs, 63);
#pragma unroll
            for (int k = 0; k < 4; ++k) { const int pp = tid + 512 * k, row = pp >> 5, c16 = pp & 31;
                *(LAS u32x4*)(sb + (c16 < 16 ? SB_BC : SB_CC) + row * P272 + 16 * (c16 & 15)) = rbA[S][k]; }
            {
                const float sd = __shfl(dtv, xtok & 63) * __expf(cs63 - __shfl(cs, xtok & 63));
                const float f[4] = {bflo(xr.x), bfhi(xr.x), bflo(xr.y), bfhi(xr.y)};
                const unsigned xb[4] = {xr.x & 0xffffu, xr.x >> 16, xr.y & 0xffffu, xr.y >> 16};
#pragma unroll
                for (int e = 0; e < 4; ++e) {
                    *(LAS unsigned short*)(sb + SB_XT + (4 * xc4 + e) * P144 + 2 * xtok) = (unsigned short)xb[e];
                    *(LAS unsigned short*)(sb + SB_XD + (4 * xc4 + e) * P144 + 2 * xtok) = (unsigned short)f2bf(f[e] * sd); }
            }
            if (wave == 0) { ((LAS float*)(sb + SB_VEC))[lane] = cs; ((LAS float*)(sb + SB_VEC))[64 + lane] = dtv; }
            const float dec = __expf(cs63);
            LDS_WAIT(); __builtin_amdgcn_s_barrier(); asm volatile("" ::: "memory");
            const size_t otok = tok0 + (size_t)c * 64 + 16 * ti + l16;
            const float zv[4] = {bflo(zrA[S].x), bfhi(zrA[S].x), bflo(zrA[S].y), bfhi(zrA[S].y)};
            if (c + 2 < 32) SSD_LOAD_RAW(c + 2, S);
            const float cs_l = ((const LAS float*)(sb + SB_VEC))[16 * ti + l16];
            bf16x8 Cf[4];
#pragma unroll
            for (int k = 0; k < 4; ++k) Cf[k] = *(const LAS bf16x8*)(sb + SB_CC + (16 * ti + l16) * P272 + (32 * k + 8 * quad) * 2);
#pragma unroll
            for (int jj = 0; jj < 2; ++jj) {
                const int j = 2 * q + jj;
                if (j <= ti) {
                    f32x4 gacc = (f32x4){0.f, 0.f, 0.f, 0.f};
#pragma unroll
                    for (int k = 0; k < 4; ++k) {
                        const bf16x8 Aop = *(const LAS bf16x8*)(sb + SB_BC + (16 * j + l16) * P272 + (32 * k + 8 * quad) * 2);
                        gacc = __builtin_amdgcn_mfma_f32_16x16x32_bf16(Aop, Cf[k], gacc, 0, 0, 0); }
                    const f32x4 cs_s = *(const LAS f32x4*)(sb + SB_VEC + (16 * j + 4 * quad) * 4), dt_s = *(const LAS f32x4*)(sb + SB_VEC + 256 + (16 * j + 4 * quad) * 4);
                    float mv[4];
#pragma unroll
                    for (int r = 0; r < 4; ++r) { const int s_ = 16 * j + 4 * quad + r, l = 16 * ti + l16;
                        float v = gacc[r] * __expf(fminf(cs_l - cs_s[r], 0.f)) * dt_s[r];
                        v = (s_ <= l) ? v : 0.f; if (s_ == l) v += Dh; mv[r] = v; }
                    *(LAS u32x2*)(lds + SL_MM + (16 * ti + l16) * P144 + (16 * j + 4 * quad) * 2) = (u32x2){cvt_pk_bf16(mv[0], mv[1]), cvt_pk_bf16(mv[2], mv[3])};
                } else if ((j >> 1) <= (ti >> 1)) {
                    *(LAS u32x2*)(lds + SL_MM + (16 * ti + l16) * P144 + (16 * j + 4 * quad) * 2) = (u32x2){0u, 0u};
                }
            }
            f32x4 y = (f32x4){0.f, 0.f, 0.f, 0.f};
#pragma unroll
            for (int k = 0; k < 4; ++k) {
                const bf16x8 Aop = *(const LAS bf16x8*)(lds + SL_SL + (16 * q + l16) * P272 + (32 * k + 8 * quad) * 2);
                y = __builtin_amdgcn_mfma_f32_16x16x32_bf16(Aop, Cf[k], y, 0, 0, 0); }
            y = y * __expf(cs_l);
#pragma unroll
            for (int t = 0; t < 2; ++t) { const int jn = 2 * ti + t;
                accS[t] = accS[t] * dec;
#pragma unroll
                for (int kk = 0; kk < 2; ++kk) {
                    LAS unsigned char* tp = sb + SB_BC + (32 * kk + 8 * quad + (l16 >> 2)) * P272 + (16 * jn + 4 * (lane & 3)) * 2;
                    const v4i16_t lo = __builtin_amdgcn_ds_read_tr16_b64_v4i16((LAS v4i16_t*)tp), hi = __builtin_amdgcn_ds_read_tr16_b64_v4i16((LAS v4i16_t*)(tp + 4 * P272));
                    const bf16x8 Aop = __builtin_shufflevector(lo, hi, 0, 1, 2, 3, 4, 5, 6, 7);
                    const bf16x8 Bop = *(const LAS bf16x8*)(sb + SB_XD + (16 * q + l16) * P144 + (32 * kk + 8 * quad) * 2);
                    accS[t] = __builtin_amdgcn_mfma_f32_16x16x32_bf16(Aop, Bop, accS[t], 0, 0, 0); } }
            LDS_WAIT(); __builtin_amdgcn_s_barrier(); asm volatile("" ::: "memory");
            for (int kk = 0; kk <= (ti >> 1); ++kk) {
                const bf16x8 Aop = *(const LAS bf16x8*)(sb + SB_XT + (16 * q + l16) * P144 + (32 * kk + 8 * quad) * 2);
                const bf16x8 Bop = *(const LAS bf16x8*)(lds + SL_MM + (16 * ti + l16) * P144 + (32 * kk + 8 * quad) * 2);
                y = __builtin_amdgcn_mfma_f32_16x16x32_bf16(Aop, Bop, y, 0, 0, 0); }
#pragma unroll
            for (int t = 0; t < 2; ++t) { const int jn = 2 * ti + t;
                *(LAS u32x2*)(lds + SL_SL + (16 * q + l16) * P272 + (16 * jn + 4 * quad) * 2) = (u32x2){cvtpk_s(accS[t][0], accS[t][1]), cvtpk_s(accS[t][2], accS[t][3])}; }
            float v[4], ssq = 0.f;
#pragma unroll
            for (int r = 0; r < 4; ++r) { v[r] = y[r] * silu_f(zv[r]); ssq += v[r] * v[r]; }
            *(u32x2*)(MIX + otok * MIXD + pcol) = (u32x2){cvt_pk_bf16(v[0], v[1]), cvt_pk_bf16(v[2], v[3])};
            ssq += __shfl_xor(ssq, 16); ssq += __shfl_xor(ssq, 32);
            PSS[(size_t)(g * 32 + (h & 7) * 4 + ph * 2 + q) * M + otok] = ssq;
        }
        LDS_WAIT(); __builtin_amdgcn_s_barrier(); asm volatile("" ::: "memory");
#undef SSD_LOAD_RAW
    }
}

template <int WIN>
__device__ __forceinline__ void pool_quads(const bf16* PROJ, bf16* MIX, int blk, int cgp, int tr) {
    for (int i = 0; i < 4; ++i) {
        const int t0 = blk * 64 + tr * 16 + 4 * i, ts0 = t0 & (SEQ - 1);
        u32x4 r[WIN + 3];
#pragma unroll
        for (int k = 0; k < WIN + 3; ++k) { const int dt = k - (WIN - 1); r[k] = (u32x4){0u, 0u, 0u, 0u};
            if (ts0 + dt >= 0) r[k] = *(const u32x4*)(PROJ + (size_t)(t0 + dt) * PROJ_LD + U_OFF + 8 * cgp); }
        float s[8];
#pragma unroll
        for (int e = 0; e < 8; ++e) s[e] = 0.f;
#pragma unroll
        for (int k = 0; k < WIN; ++k) { float f[8]; unpack8(r[k], f);
#pragma unroll
            for (int e = 0; e < 8; ++e) s[e] += f[e]; }
#pragma unroll
        for (int j = 0; j < 4; ++j) {
            float u0[8]; unpack8(r[WIN - 1 + j], u0);
            if (j > 0) { float f[8]; unpack8(r[j - 1], f);
#pragma unroll
                for (int e = 0; e < 8; ++e) s[e] += u0[e] - f[e]; }
            const int cnt = (ts0 + j + 1) < WIN ? (ts0 + j + 1) : WIN; const float inv = 1.0f / (float)cnt;
            u32x4 o; o.x = cvt_pk_bf16(s[0] * inv - u0[0], s[1] * inv - u0[1]); o.y = cvt_pk_bf16(s[2] * inv - u0[2], s[3] * inv - u0[3]);
            o.z = cvt_pk_bf16(s[4] * inv - u0[4], s[5] * inv - u0[5]); o.w = cvt_pk_bf16(s[6] * inv - u0[6], s[7] * inv - u0[7]);
            *(u32x4*)(MIX + (size_t)(t0 + j) * MIXD + 1024 + 8 * cgp) = o; }
    }
}
__device__ __forceinline__ void pool_phase(const Args& a, int G, int vc) {
    const bf16* PROJ = (const bf16*)(a.ws + WS_PROJ);
    bf16* MIX = (bf16*)(a.ws + WS_MIX);
    const int tid = threadIdx.x, lane = tid & 63, wave = __builtin_amdgcn_readfirstlane(tid >> 6);
    const int grp = wave & 3, cgp = grp * 32 + (lane & 31), tr = (wave >> 2) * 2 + (lane >> 5);
    for (int blk = vc; blk < M / 64; blk += G) {
        if (grp == 0) pool_quads<2>(PROJ, MIX, blk, cgp, tr);
        else if (grp == 1) pool_quads<4>(PROJ, MIX, blk, cgp, tr);
        else if (grp == 2) pool_quads<8>(PROJ, MIX, blk, cgp, tr);
        else pool_quads<16>(PROJ, MIX, blk, cgp, tr);
    }
}

constexpr int N_PHASES = 9;
__global__ void __launch_bounds__(NTHR, 2) hybrid_fwd(Args args) {
    extern __shared__ __attribute__((aligned(16))) unsigned char lds_raw[];
    LAS unsigned char* lds = (LAS unsigned char*)lds_raw;
    const int tid = threadIdx.x, lane = tid & 63, wave = __builtin_amdgcn_readfirstlane(tid >> 6);
    const int G = gridDim.x; const int bx = blockIdx.x; const int vcu = (G % 8 == 0) ? (bx % 8) * (G / 8) + bx / 8 : bx;
    unsigned char* ws = args.ws;
    volatile LAS unsigned* MISC = (volatile LAS unsigned*)(lds + MISC_OFF);
    if (tid < 32) MISC[tid] = 0u;
    __syncthreads();
    const int lo = args.ph_lo, hi = args.ph_hi;
#if MK_CG_SYNC
    cg::grid_group grid = cg::this_grid();
#define GRID_BAR() do { __threadfence(); grid.sync(); } while (0)
#else
    cg::grid_group grid = cg::this_grid();
    XcdBarrier bar; bar.bar = (unsigned*)(ws + WS_CTL) + CW_BAR; bar.x = 0; bar.st = nullptr;
    if (hi - lo > 1) bar = xcd_barrier_post((unsigned*)(ws + WS_CTL) + CW_BAR, MISC + 8);
    if (lo > 1000) grid.sync();
#define GRID_BAR() xcd_barrier(bar)
#endif
#define IN(k) (lo <= (k) && (k) < hi)
#define BOTH(k) (IN(k) && IN((k) + 1))
    bf16 *GU1 = (bf16*)(ws + WS_GU1), *D1 = (bf16*)(ws + WS_D1), *GU2 = (bf16*)(ws + WS_GU2), *D2 = (bf16*)(ws + WS_D2), *WIN = (bf16*)(ws + WS_WIN), *WOUT = (bf16*)(ws + WS_WOUT);
    bf16 *XN = (bf16*)(ws + WS_XN), *HID = (bf16*)(ws + WS_HID), *PROJ = (bf16*)(ws + WS_PROJ), *MIX = (bf16*)(ws + WS_MIX);
    float *SS = (float*)(ws + WS_SS), *DTB = (float*)(ws + WS_DT), *PSS = (float*)(ws + WS_PSS);

    if (IN(0)) { p0_prologue<0>(args, lds, vcu * NWAVES + wave, G * NWAVES, wave, lane); if (BOTH(0)) GRID_BAR(); }
    if (IN(1)) {
        pg8::Gemm g{XN, GU1, M, NGU, D}; pg8::StaticOrder S; S.init(M, NGU, G, bx);
        pg8::EpiSwiglu E{HID, nullptr};
        pg8::gemm_phase<pg8::EpiSwiglu, pg8::StaticOrder, pg8::NoHook, true>(lds, g, S, E, pg8::NoHook{});
        { const int first = ((M / 256) * (NGU / 256)) % G;
          if (bx >= first) p0_prologue<1>(args, lds, (bx - first) * NWAVES + wave, (G - first) * NWAVES, wave, lane); }
        if (BOTH(1)) GRID_BAR();
    }
    if (IN(2)) {
        pg8::Gemm g{HID, D1, M, D, FF}; pg8::StaticOrder S; S.init(M, D, G, bx);
        pg8::EpiResX<true, false> E{nullptr, XN, (const float*)(ws + WS_RS0), nullptr, nullptr, XN, (float*)(ws + WS_RS1), SS, (unsigned*)(ws + WS_CTL) + CW_PANEL, 0.5f, args.in[1]};
        pg8::gemm_phase<pg8::EpiResX<true, false>, pg8::StaticOrder, pg8::NoHook, false>(lds, g, S, E, pg8::NoHook{});
        if (BOTH(2)) GRID_BAR();
    }
    if (IN(3)) {
        pg8::Gemm g{XN, WIN, M, NIN, D}; pg8::StaticOrder S; S.init(M, NIN, G, bx);
        pg8::EpiProj E{PROJ, DTB, nullptr};
        pg8::gemm_phase<pg8::EpiProj, pg8::StaticOrder, pg8::NoHook, true>(lds, g, S, E, pg8::NoHook{});
        {
            pg8::Gemm gf{(const bf16*)(ws + WS_FA), (const bf16*)(ws + WS_FB), 4096, 1024, 256}; pg8::FoldOrder SF{G == 256 ? bx - 192 : bx};
            pg8::EpiFold EF{WOUT};
            pg8::gemm_phase<pg8::EpiFold, pg8::FoldOrder, pg8::NoHook, true>(lds, gf, SF, EF, pg8::NoHook{});
        }
        if (BOTH(3)) GRID_BAR();
    }
    if (IN(4)) {
        pool_phase(args, G, vcu);
        conv_phase(args, G, vcu);
        if (BOTH(4)) GRID_BAR();
    }
    if (IN(5)) {
        ssd_phase(lds, args, G, vcu);
        if (BOTH(5)) GRID_BAR();
    }
    if (IN(6)) {
        pg8::StaticOrder S; S.init(M, D, G, bx); pg8::Unit u0;
        LAS float* TAB = (LAS float*)(lds + TAB_OFF);
        if (S.next(0, u0)) {
            const int row = tid & 255, gg = tid >> 8; float s = 0.f;
            for (int k = 0; k < 32; ++k) s += PSS[(size_t)(gg * 32 + k) * M + u0.pm * 256 + row];
            TAB[512 + gg * 256 + row] = 1.0f / sqrtf(s * (1.0f / 512.0f) + EPS);
        }
        __syncthreads();
        if (tid < 256) { const float r0 = TAB[512 + tid], r1 = TAB[768 + tid]; TAB[tid] = r0 / r1; TAB[256 + tid] = r1; }
        __syncthreads();
        pg8::Gemm g{MIX, WOUT, M, D, MIXD};
        pg8::EpiResX<true, false> E{nullptr, XN, (const float*)(ws + WS_RS1), nullptr, nullptr, XN, (float*)(ws + WS_RS2), SS, (unsigned*)(ws + WS_CTL) + CW_PANEL + 1024, 1.0f, nullptr};
        pg8::ScaleHook HK{TAB, 8, 16};
        pg8::gemm_phase<pg8::EpiResX<true, false>, pg8::StaticOrder, pg8::ScaleHook, false>(lds, g, S, E, HK);
        if (BOTH(6)) GRID_BAR();
    }
    if (IN(7)) {
        pg8::Gemm g{XN, GU2, M, NGU, D}; pg8::StaticOrder S; S.init(M, NGU, G, bx);
        pg8::EpiSwiglu E{HID, nullptr};
        pg8::gemm_phase<pg8::EpiSwiglu, pg8::StaticOrder, pg8::NoHook, true>(lds, g, S, E, pg8::NoHook{});
        { const int first = ((M / 256) * (NGU / 256)) % G;
          if (bx >= first) p0_prologue<2>(args, lds, (bx - first) * NWAVES + wave, (G - first) * NWAVES, wave, lane); }
        if (BOTH(7)) GRID_BAR();
    }
    if (IN(8)) {
        pg8::Gemm g{HID, D2, M, D, FF}; pg8::StaticOrder S; S.init(M, D, G, bx);
        pg8::EpiResX<true, true> E{nullptr, XN, (const float*)(ws + WS_RS2), args.out, args.in[20], nullptr, nullptr, SS, (unsigned*)(ws + WS_CTL) + CW_PANEL + 2048, 0.5f, nullptr};
        pg8::gemm_phase<pg8::EpiResX<true, true>, pg8::StaticOrder, pg8::NoHook, false>(lds, g, S, E, pg8::NoHook{});
    }
#undef IN
#undef BOTH
}

extern "C" void kernel_launch(void* const* d_in, const int* in_sizes, int n_in, void* d_out, int out_size, void* d_ws, size_t ws_size, hipStream_t stream) {
    static int grid = 0;
    if (grid == 0) {
        if (n_in != 21 || in_sizes[0] != M * D || out_size != M * D || ws_size < WS_END) { fprintf(stderr, "kernel_launch: unexpected shapes (n_in %d, in0 %d, out %d, ws %zu)\n", n_in, n_in > 0 ? in_sizes[0] : -1, out_size, ws_size); grid = -1; return; }
        int dev = 0, cus = 0, per_cu = 0;
        if (hipGetDevice(&dev) != hipSuccess || hipDeviceGetAttribute(&cus, hipDeviceAttributeMultiprocessorCount, dev) != hipSuccess) { grid = -1; return; }
        if (hipFuncSetAttribute((const void*)hybrid_fwd, hipFuncAttributeMaxDynamicSharedMemorySize, LDS_BYTES) != hipSuccess) { fprintf(stderr, "kernel_launch: hipFuncSetAttribute failed\n"); grid = -1; return; }
        if (hipOccupancyMaxActiveBlocksPerMultiprocessor(&per_cu, (const void*)hybrid_fwd, NTHR, LDS_BYTES) != hipSuccess || per_cu < 1) { fprintf(stderr, "kernel_launch: occupancy query says %d\n", per_cu); per_cu = 1; }
        (void)hipGetLastError();
        grid = cus;
        if (grid != 256) fprintf(stderr, "kernel_launch: %d CUs; the single-unit GEMM phases expect 256\n", grid);
    }
    if (grid < 0) return;
    (void)hipMemsetAsync((char*)d_ws + WS_CTL, 0, CTL_ZERO_BYTES, stream);
    Args a{};
    for (int i = 0; i < 21; ++i) a.in[i] = (const float*)d_in[i];
    a.out = (float*)d_out; a.ws = (unsigned char*)d_ws;
#if MK_N_LAUNCHES == 1
    a.ph_lo = 0; a.ph_hi = N_PHASES;
    void* kargs[] = {&a};
    hipError_t e = hipLaunchCooperativeKernel((const void*)hybrid_fwd, dim3(grid), dim3(NTHR), kargs, LDS_BYTES, stream);
    if (e != hipSuccess) fprintf(stderr, "kernel_launch: cooperative launch failed: %s (grid %d)\n", hipGetErrorString(e), grid);
#else
    for (int p = 0; p < N_PHASES; ++p) { a.ph_lo = p; a.ph_hi = p + 1; hipLaunchKernelGGL(hybrid_fwd, dim3(grid), dim3(NTHR), LDS_BYTES, stream, a); }
#endif
}
```

```cpp
#include <hip/hip_runtime.h>
#include <hip/hip_cooperative_groups.h>
#include <cstdio>
#include <cstdint>
namespace cg = cooperative_groups;

#ifndef MK_N_LAUNCHES
#define MK_N_LAUNCHES 1
#endif
#ifndef MK_CG_SYNC
#define MK_CG_SYNC 0
#endif

#define LAS __attribute__((address_space(3)))
#define GAS __attribute__((address_space(1)))
typedef unsigned short bf16;
typedef short bf16x8 __attribute__((ext_vector_type(8)));
typedef float f32x4 __attribute__((ext_vector_type(4)));
typedef float f32x2 __attribute__((ext_vector_type(2)));
typedef unsigned u32x4 __attribute__((ext_vector_type(4)));
typedef unsigned u32x2 __attribute__((ext_vector_type(2)));

constexpr int M = 16384, SEQ = 2048, D = 1024, FF = 2816, NGU = 2 * FF, NIN = 3840, PROJ_LD = 3584, MIXD = 2048;
constexpr int Z_OFF = 0, XS_OFF = 1024, B_OFF = 2048, C_OFF = 2304, U_OFF = 2560;
constexpr int CONV_DIM = 1536;
constexpr float EPS = 1e-6f;
constexpr int NWAVES = 8, NTHR = 512;

constexpr size_t MiB = 1u << 20;
constexpr size_t WS_CTL = 0, CTL_ZERO_BYTES = 64 * 1024;
constexpr size_t WS_SS = 64 * 1024;
constexpr size_t WS_RS0 = 448 * 1024;
constexpr size_t WS_RS1 = 320 * 1024, WS_RS2 = 384 * 1024;
constexpr size_t WS_GU1 = 1 * MiB;
constexpr size_t WS_PSS = 1 * MiB;
constexpr size_t WS_D1 = 12 * MiB;
constexpr size_t WS_DT = 12 * MiB;
constexpr size_t WS_DTV = 13 * MiB;
constexpr size_t WS_CSV = 14 * MiB;
constexpr size_t WS_GU2 = WS_D1 + 5 * MiB + 512 * 1024;
constexpr size_t WS_D2 = WS_GU2 + 11 * MiB;
constexpr size_t WS_WIN = 34 * MiB;
constexpr size_t WS_WOUT = WS_WIN + 7 * MiB + 512 * 1024;
constexpr size_t WS_PROJ = 46 * MiB;
constexpr size_t WS_HID = 46 * MiB;
constexpr size_t WS_MIX = 158 * MiB;
constexpr size_t WS_FA = 158 * MiB;
constexpr size_t WS_FB = 160 * MiB;
constexpr size_t WS_XN = 222 * MiB;
constexpr size_t WS_BCG = 222 * MiB;
constexpr size_t WS_END = 254 * MiB;
constexpr int CW_BAR = 1024;
constexpr int CW_PANEL = 8192;

constexpr int RING_BYTES = 131072;
constexpr int TAB_OFF = RING_BYTES;
constexpr int MISC_OFF = TAB_OFF + 4096;
constexpr int LDS_BYTES = 147456;

__device__ __forceinline__ unsigned f2bf(float f) { unsigned u = __builtin_bit_cast(unsigned, f); return (u + 0x7fffu + ((u >> 16) & 1u)) >> 16; }
__device__ __forceinline__ unsigned cvt_pk_bf16(float lo, float hi) { unsigned r; asm volatile("v_cvt_pk_bf16_f32 %0, %1, %2" : "=v"(r) : "v"(lo), "v"(hi)); return r; }
__device__ __forceinline__ unsigned pk2(float lo, float hi) { return cvt_pk_bf16(lo, hi); }
typedef float f32x2_t __attribute__((ext_vector_type(2))); typedef __bf16 bf16x2_t __attribute__((ext_vector_type(2)));
__device__ __forceinline__ unsigned cvtpk_s(float lo, float hi) { f32x2_t v = {lo, hi}; bf16x2_t b = __builtin_convertvector(v, bf16x2_t); return __builtin_bit_cast(unsigned, b); }
__device__ __forceinline__ __amdgpu_buffer_rsrc_t wt_rsrc(void* base, unsigned bytes) { return __builtin_amdgcn_make_buffer_rsrc(base, 0, (int)bytes, 0x00020000); }
__device__ __forceinline__ void st16_wt(__amdgpu_buffer_rsrc_t rs, size_t off, u32x4 v) { __builtin_amdgcn_raw_buffer_store_b128(v, rs, (unsigned)off, 0, 16); }
__device__ __forceinline__ float bflo(unsigned u) { return __builtin_bit_cast(float, u << 16); }
__device__ __forceinline__ float bfhi(unsigned u) { return __builtin_bit_cast(float, u & 0xffff0000u); }
__device__ __forceinline__ float silu_f(float v) { return v * __builtin_amdgcn_rcpf(1.0f + __builtin_amdgcn_exp2f(-1.44269504f * v)); }
__device__ __forceinline__ float wave_sum(float v) {
#pragma unroll
    for (int o = 1; o < 64; o <<= 1) v += __shfl_xor(v, o);
    return v;
}
#define LDS_WAIT() asm volatile("s_waitcnt lgkmcnt(0)" ::: "memory")
#define VM_WAIT() asm volatile("s_waitcnt vmcnt(0)" ::: "memory")

namespace pg8 {
constexpr int BM = 256, BK = 64, HALF = 128, HTB = HALF * BK * 2, STAGE_BYTES = 8 * HTB, NXCD = 8, WGM = 4;
__host__ __device__ __forceinline__ int lds_byte(int r, int c) { const int st = (r >> 4) * 2 + (c >> 5), rr = r & 15, cc = c & 31, ob = rr * 64 + cc * 2; return st * 1024 + (ob ^ (((ob >> 9) & 1) << 5)); }
__host__ __device__ __forceinline__ void stage_rc(int b, int& R, int& C) { const int st = b / 1024, sb = b % 1024, swz = sb ^ (((sb >> 9) & 1) << 5); R = (st >> 1) * 16 + swz / 64; C = (st & 1) * 32 + (swz % 64) / 2; }
__host__ __device__ __forceinline__ int perm32(int rho) { const int n = rho >> 4, i = rho & 15; return 8 * (i >> 2) + 4 * n + (i & 3); }

struct Unit { int pm, pn; };
struct Gemm { const bf16* A; const bf16* Bt; int M, N, K; };

struct StaticOrder {
    int nM, nN, nwg, G, c;
    __host__ __device__ void init(int M_, int N_, int G_, int c_) { nM = M_ / BM; nN = N_ / BM; nwg = nM * nN; G = G_; c = c_; }
    __host__ __device__ bool next(int i, Unit& u) const {
        const long L = (long)i * G + c; if (L >= nwg) return false;
        int wgid = (int)L; { const int q = nwg / NXCD, r = nwg % NXCD, xcd = wgid % NXCD, off = wgid / NXCD; wgid = (xcd < r ? xcd * (q + 1) : r * (q + 1) + (xcd - r) * q) + off; }
        const int nig = WGM * nN, gid = wgid / nig, fm = gid * WGM, gsz = (nM - fm) < WGM ? (nM - fm) : WGM;
        u.pm = fm + ((wgid % nig) % gsz); u.pn = (wgid % nig) / gsz; return true;
    }
};

struct FoldOrder {
    int c;
    __host__ __device__ bool next(int i, Unit& u) const { const int idx = i * 64 + c; if (c < 0 || idx >= 16) return false; u.pm = idx; u.pn = idx >> 2; return true; }
};
struct NoHook { static constexpr bool ON = false; };
struct ScaleHook { static constexpr bool ON = true; const LAS float* F; int t0, t1; };

template <class Epi, class Sched, class Hook, bool ALIGN_EPI>
__device__ __forceinline__ void gemm_phase(LAS unsigned char* lds, const Gemm g, const Sched& S, const Epi& E, const Hook& HK) {
    const int tid = threadIdx.x, wid = __builtin_amdgcn_readfirstlane(tid >> 6), lane = tid & 63, wr = wid >> 2, wc = wid & 3, fr = lane & 15, fq = lane >> 4;
    const int K = g.K, nt = K / BK;
    unsigned voffA[2], voffB[2];
#pragma unroll
    for (int i = 0; i < 2; ++i) { int R, C; stage_rc(tid * 16 + i * 8192, R, C); const int Rb = (R & ~31) + perm32(R & 31);
        voffA[i] = (unsigned)(R * K + C) * 2u; voffB[i] = (unsigned)(Rb * K + C) * 2u; }
    const size_t kstep = (size_t)(BK * 2);
    const size_t hstep = (size_t)HALF * K * 2;
    const size_t tstep = 2 * hstep;
    const unsigned ldsw = (unsigned)wid * 1024u;
    const int aoff = lds_byte(wr * 64 + fr, fq * 8), boff = lds_byte(wc * 32 + fr, fq * 8);
#define PG8_SA(b, h) (((b) * 2 + (h)) * HTB)
#define PG8_SB(b, h) ((4 + (b) * 2 + (h)) * HTB)
#define PG8_STAGE(bufoff, gbase, voff) do { _Pragma("unroll") for (int _i = 0; _i < 2; ++_i) \
        __builtin_amdgcn_global_load_lds((const unsigned*)((const char*)(gbase) + (voff)[_i]), (LAS unsigned*)(lds + (bufoff) + ldsw + _i * 8192), 16, 0, 0); } while (0)
#define PG8_LDA(dst, b, h) do { _Pragma("unroll") for (int m = 0; m < 4; ++m) _Pragma("unroll") for (int k = 0; k < 2; ++k) dst[m][k] = *(const LAS bf16x8*)(lds + PG8_SA(b, h) + aoff + m * 2048 + k * 1024); } while (0)
#define PG8_LDB(dst, b, h) do { _Pragma("unroll") for (int n = 0; n < 2; ++n) _Pragma("unroll") for (int k = 0; k < 2; ++k) dst[n][k] = *(const LAS bf16x8*)(lds + PG8_SB(b, h) + boff + n * 2048 + k * 1024); } while (0)
#define PG8_MMA(ai, bj, At, Bt) do { __builtin_amdgcn_s_setprio(1); _Pragma("unroll") for (int m = 0; m < 4; ++m) _Pragma("unroll") for (int n = 0; n < 2; ++n) _Pragma("unroll") for (int k = 0; k < 2; ++k) \
        acc[ai][bj][m][n] = __builtin_amdgcn_mfma_f32_16x16x32_bf16(Bt[n][k], At[m][k], acc[ai][bj][m][n], 0, 0, 0); __builtin_amdgcn_s_setprio(0); } while (0)
#define PG8_WAIT_V(n) asm volatile("s_waitcnt vmcnt(" #n ")" ::: "memory")
#define PG8_WAIT_L(n) asm volatile("s_waitcnt lgkmcnt(" #n ")" ::: "memory")
#define PG8_BAR __builtin_amdgcn_s_barrier()
#define PG8_SCHED __builtin_amdgcn_sched_barrier(0)
    Unit cur, nxt; int ui = 0;
    if (!S.next(0, cur)) return;
    f32x4 acc[2][2][4][2];
#pragma unroll
    for (int a = 0; a < 2; ++a)
#pragma unroll
        for (int b = 0; b < 2; ++b)
#pragma unroll
            for (int m = 0; m < 4; ++m)
#pragma unroll
                for (int n = 0; n < 2; ++n) acc[a][b][m][n] = (f32x4){0.f, 0.f, 0.f, 0.f};
    bf16x8 At[4][2], B0[2][2], B1[2][2];
    const char* cA = (const char*)g.A + (size_t)cur.pm * tstep; const char* cB = (const char*)g.Bt + (size_t)cur.pn * tstep;
    PG8_STAGE(PG8_SB(0, 0), cB, voffB); PG8_STAGE(PG8_SB(0, 1), cB + hstep, voffB); PG8_STAGE(PG8_SA(0, 0), cA, voffA); PG8_STAGE(PG8_SA(0, 1), cA + hstep, voffA);
    if (wr == 1) PG8_BAR;
    PG8_WAIT_V(2); PG8_BAR;
    PG8_STAGE(PG8_SB(1, 0), cB + kstep, voffB); PG8_STAGE(PG8_SA(1, 0), cA + kstep, voffA); PG8_STAGE(PG8_SB(1, 1), cB + hstep + kstep, voffB);
    PG8_WAIT_V(6); PG8_BAR;
    for (;;) {
        const bool has_next = S.next(ui + 1, nxt);
        const char* nA = has_next ? (const char*)g.A + (size_t)nxt.pm * tstep : cA; const char* nB = has_next ? (const char*)g.Bt + (size_t)nxt.pn * tstep : cB;
        for (int t = 0; t < nt; t += 2) {
            const bool last = (t == nt - 2);
            const char* a1 = cA + (size_t)(t + 1) * kstep;
            const char* a2 = last ? nA : cA + (size_t)(t + 2) * kstep; const char* b2 = last ? nB : cB + (size_t)(t + 2) * kstep;
            const char* a3 = a2 + kstep; const char* b3 = b2 + kstep;
            if constexpr (Hook::ON) {
                if (t == HK.t0 || t == HK.t1) {
                    const LAS float* Fp = HK.F + (t == HK.t1 ? 256 : 0);
#pragma unroll
                    for (int ai = 0; ai < 2; ++ai)
#pragma unroll
                        for (int m = 0; m < 4; ++m) { const float f = Fp[ai * HALF + wr * 64 + m * 16 + fr];
#pragma unroll
                            for (int bj = 0; bj < 2; ++bj)
#pragma unroll
                                for (int n = 0; n < 2; ++n) acc[ai][bj][m][n] = acc[ai][bj][m][n] * f; }
                }
            }
            PG8_LDB(B0, 0, 0); PG8_LDB(B1, 0, 1); PG8_SCHED; PG8_LDA(At, 0, 0); PG8_STAGE(PG8_SA(1, 1), a1 + hstep, voffA);
            PG8_WAIT_V(8); PG8_WAIT_L(0); PG8_BAR; PG8_MMA(0, 0, At, B0); PG8_MMA(0, 1, At, B1); PG8_BAR; PG8_SCHED;
            PG8_LDA(At, 0, 1); PG8_STAGE(PG8_SB(0, 0), b2, voffB); PG8_STAGE(PG8_SB(0, 1), b2 + hstep, voffB); PG8_STAGE(PG8_SA(0, 0), a2, voffA);
            PG8_WAIT_V(8); PG8_WAIT_L(0); PG8_BAR; PG8_MMA(1, 0, At, B0); PG8_MMA(1, 1, At, B1); PG8_BAR; PG8_SCHED;
            PG8_LDB(B0, 1, 0); PG8_LDB(B1, 1, 1); PG8_SCHED; PG8_LDA(At, 1, 0); PG8_STAGE(PG8_SA(0, 1), a2 + hstep, voffA);
            PG8_WAIT_V(8); PG8_WAIT_L(0); PG8_BAR; PG8_MMA(0, 0, At, B0); PG8_MMA(0, 1, At, B1); PG8_BAR; PG8_SCHED;
            PG8_LDA(At, 1, 1); PG8_STAGE(PG8_SB(1, 0), b3, voffB); PG8_STAGE(PG8_SB(1, 1), b3 + hstep, voffB); PG8_STAGE(PG8_SA(1, 0), a3, voffA);
            PG8_WAIT_V(8); PG8_WAIT_L(0); PG8_BAR; PG8_MMA(1, 0, At, B0); PG8_MMA(1, 1, At, B1); PG8_BAR; PG8_SCHED;
        }
        if constexpr (ALIGN_EPI) { if (wr == 0) PG8_BAR; }
        if constexpr (!Epi::AFTER_DRAIN) { E(acc, cur, wr, wc, fr, fq); }
        if (!has_next) break;
#pragma unroll
        for (int a = 0; a < 2; ++a)
#pragma unroll
            for (int b = 0; b < 2; ++b)
#pragma unroll
                for (int m = 0; m < 4; ++m)
#pragma unroll
                    for (int n = 0; n < 2; ++n) acc[a][b][m][n] = (f32x4){0.f, 0.f, 0.f, 0.f};
        cur = nxt; cA = nA; cB = nB; ++ui;
        if constexpr (ALIGN_EPI) { if (wr == 1) PG8_BAR; }
    }
    PG8_WAIT_V(0);
    if constexpr (!ALIGN_EPI) { if (wr == 0) PG8_BAR; }
    PG8_BAR;
    if constexpr (Epi::AFTER_DRAIN) { E.fused(acc, cur, wr, wc, fr, fq, lds, wid, lane); }
#undef PG8_SA
#undef PG8_SB
#undef PG8_STAGE
#undef PG8_LDA
#undef PG8_LDB
#undef PG8_MMA
#undef PG8_WAIT_V
#undef PG8_WAIT_L
#undef PG8_BAR
#undef PG8_SCHED
}

__device__ __forceinline__ float row_rstd4(const float* ss, int row) {
    const float s = (ss[row] + ss[M + row]) + (ss[2 * M + row] + ss[3 * M + row]);
    return 1.0f / sqrtf(s * (1.0f / D) + EPS);
}

struct EpiSwiglu {
    static constexpr bool AFTER_DRAIN = false;
    bf16* H; const float* ss;
    __device__ __forceinline__ void operator()(const f32x4 (&acc)[2][2][4][2], const Unit& u, int wr, int wc, int fr, int fq) const {
        const int row0 = u.pm * BM + wr * 64 + fr, col0 = u.pn * HALF + wc * 32 + 8 * fq;
        const __amdgpu_buffer_rsrc_t hrs = wt_rsrc(H, (unsigned)((size_t)M * FF * 2));
        float r8[8];
#pragma unroll
        for (int gi = 0; gi < 8; ++gi) r8[gi] = ss ? row_rstd4(ss, row0 + (gi >> 2) * HALF + (gi & 3) * 16) : 1.0f;
#pragma unroll
        for (int ai = 0; ai < 2; ++ai)
#pragma unroll
            for (int m = 0; m < 4; ++m) { const int row = row0 + ai * HALF + m * 16;
                const float r = r8[ai * 4 + m];
                float h[8];
#pragma unroll
                for (int n = 0; n < 2; ++n)
#pragma unroll
                    for (int j = 0; j < 4; ++j) { const float gv = acc[ai][0][m][n][j] * r, uv = acc[ai][1][m][n][j] * r; h[4 * n + j] = silu_f(gv) * uv; }
                u32x4 w; w.x = cvt_pk_bf16(h[0], h[1]); w.y = cvt_pk_bf16(h[2], h[3]); w.z = cvt_pk_bf16(h[4], h[5]); w.w = cvt_pk_bf16(h[6], h[7]);
                st16_wt(hrs, ((size_t)row * FF + col0) * 2, w); }
    }
};
struct EpiProj {
    static constexpr bool AFTER_DRAIN = false;
    bf16* P; float* DT; const float* ss;
    __device__ __forceinline__ void operator()(const f32x4 (&acc)[2][2][4][2], const Unit& u, int wr, int wc, int fr, int fq) const {
        const int row0 = u.pm * BM + wr * 64 + fr;
        float r8[8];
#pragma unroll
        for (int gi = 0; gi < 8; ++gi) r8[gi] = ss ? row_rstd4(ss, row0 + (gi >> 2) * HALF + (gi & 3) * 16) : 1.0f;
        if (u.pn < 14) {
            const int col0 = u.pn * BM + wc * 32 + 8 * fq;
#pragma unroll
            for (int ai = 0; ai < 2; ++ai)
#pragma unroll
                for (int m = 0; m < 4; ++m) { const int row = row0 + ai * HALF + m * 16; const float r = r8[ai * 4 + m];
#pragma unroll
                    for (int bj = 0; bj < 2; ++bj) { const f32x4 v0 = acc[ai][bj][m][0] * r, v1 = acc[ai][bj][m][1] * r;
                        u32x4 w; w.x = cvtpk_s(v0[0], v0[1]); w.y = cvtpk_s(v0[2], v0[3]); w.z = cvtpk_s(v1[0], v1[1]); w.w = cvtpk_s(v1[2], v1[3]);
                        st16_wt(wt_rsrc(P, (unsigned)((size_t)M * PROJ_LD * 2)), ((size_t)row * PROJ_LD + col0 + bj * HALF) * 2, w); } }
        } else if (wc == 0 && fq < 2) {
#pragma unroll
            for (int ai = 0; ai < 2; ++ai)
#pragma unroll
                for (int m = 0; m < 4; ++m) { const int row = row0 + ai * HALF + m * 16; const float r = r8[ai * 4 + m];
                    *(f32x4*)(DT + (size_t)row * 16 + 8 * fq) = acc[ai][0][m][0] * r; *(f32x4*)(DT + (size_t)row * 16 + 8 * fq + 4) = acc[ai][0][m][1] * r; }
        }
    }
};
struct EpiFold {
    static constexpr bool AFTER_DRAIN = false;
    bf16* WO;
    __device__ __forceinline__ void operator()(const f32x4 (&acc)[2][2][4][2], const Unit& u, int wr, int wc, int fr, int fq) const {
        const int g = u.pm >> 2, n0 = (u.pm & 3) * BM + wr * 64 + fr, col0 = 1024 + 256 * g + wc * 32 + 8 * fq;
#pragma unroll
        for (int ai = 0; ai < 2; ++ai)
#pragma unroll
            for (int m = 0; m < 4; ++m) { const int n = n0 + ai * HALF + m * 16;
#pragma unroll
                for (int bj = 0; bj < 2; ++bj) { const f32x4 v0 = acc[ai][bj][m][0], v1 = acc[ai][bj][m][1];
                    u32x4 w; w.x = cvtpk_s(v0[0], v0[1]); w.y = cvtpk_s(v0[2], v0[3]); w.z = cvtpk_s(v1[0], v1[1]); w.w = cvtpk_s(v1[2], v1[3]);
                    *(u32x4*)(WO + (size_t)n * MIXD + col0 + bj * HALF) = w; } }
    }
};
struct EpiRes {
    static constexpr bool AFTER_DRAIN = true;
    const float* base; float* out; bf16* xn; float* ss; float scale;
    __device__ __forceinline__ void fused(const f32x4 (&acc)[2][2][4][2], const Unit& u, int wr, int wc, int fr, int fq, LAS unsigned char* lds, int wid, int lane) const {
        LAS float* Pt = (LAS float*)lds;
        const int row0 = u.pm * BM + wr * 64 + fr, col0 = u.pn * BM + wc * 32 + 8 * fq;
        f32x4 bq[3][4];
#pragma unroll
        for (int pg = 0; pg < 2; ++pg) { const size_t off = (size_t)(row0 + (pg >> 2) * HALF + (pg & 3) * 16) * D + col0;
#pragma unroll
          for (int bj = 0; bj < 2; ++bj) { bq[pg][2 * bj] = *(const f32x4*)(base + off + bj * HALF); bq[pg][2 * bj + 1] = *(const f32x4*)(base + off + bj * HALF + 4); } }
#pragma unroll
        for (int gi = 0; gi < 8; ++gi) { const int ai = gi >> 2, m = gi & 3;
            const int row = row0 + ai * HALF + m * 16; const size_t off = (size_t)row * D + col0; float q = 0.f;
            if (gi < 6) { const int ai2 = (gi + 2) >> 2, m2 = (gi + 2) & 3; const size_t off2 = (size_t)(row0 + ai2 * HALF + m2 * 16) * D + col0;
#pragma unroll
                for (int bj = 0; bj < 2; ++bj) { bq[(gi + 2) % 3][2 * bj] = *(const f32x4*)(base + off2 + bj * HALF); bq[(gi + 2) % 3][2 * bj + 1] = *(const f32x4*)(base + off2 + bj * HALF + 4); } }
            f32x4 bc[4];
#pragma unroll
            for (int k = 0; k < 4; ++k) bc[k] = bq[gi % 3][k];
#pragma unroll
            for (int bj = 0; bj < 2; ++bj) {
                const f32x4 v0 = bc[2 * bj] + acc[ai][bj][m][0] * scale, v1 = bc[2 * bj + 1] + acc[ai][bj][m][1] * scale;
                *(f32x4*)(out + off + bj * HALF) = v0; *(f32x4*)(out + off + bj * HALF + 4) = v1;
                if (xn) { u32x4 w; w.x = cvt_pk_bf16(v0[0], v0[1]); w.y = cvt_pk_bf16(v0[2], v0[3]); w.z = cvt_pk_bf16(v1[0], v1[1]); w.w = cvt_pk_bf16(v1[2], v1[3]);
                    *(u32x4*)(xn + off + bj * HALF) = w; }
                q += (v0[0] * v0[0] + v0[1] * v0[1]) + (v0[2] * v0[2] + v0[3] * v0[3]) + (v1[0] * v1[0] + v1[1] * v1[1]) + (v1[2] * v1[2] + v1[3] * v1[3]); }
            q += __shfl_xor(q, 16); q += __shfl_xor(q, 32);
            if (fq == 0) Pt[(ai * HALF + wr * 64 + m * 16 + fr) * 4 + wc] = q; }
        LDS_WAIT(); __builtin_amdgcn_s_barrier(); asm volatile("" ::: "memory");
        const int t = wid * 64 + lane;
        if (t < 256) { const float s = (Pt[t * 4 + 0] + Pt[t * 4 + 1]) + (Pt[t * 4 + 2] + Pt[t * 4 + 3]); ss[(size_t)u.pn * M + u.pm * BM + t] = s; }
    }
};
struct EpiResNorm {
    static constexpr bool AFTER_DRAIN = true;
    const float* base; float* out; const float* gain; bf16* xn; float* ss; unsigned* cnt; float scale;
    __device__ __forceinline__ void fused(f32x4 (&acc)[2][2][4][2], const Unit& u, int wr, int wc, int fr, int fq, LAS unsigned char* lds, int wid, int lane) const {
        LAS float* Pt = (LAS float*)lds;
        LAS float* Rt = (LAS float*)(lds + 4096);
        const int row0 = u.pm * BM + wr * 64 + fr, col0 = u.pn * BM + wc * 32 + 8 * fq;
        f32x4 bq[3][4];
#pragma unroll
        for (int pg = 0; pg < 2; ++pg) { const size_t off = (size_t)(row0 + (pg >> 2) * HALF + (pg & 3) * 16) * D + col0;
#pragma unroll
          for (int bj = 0; bj < 2; ++bj) { bq[pg][2 * bj] = *(const f32x4*)(base + off + bj * HALF); bq[pg][2 * bj + 1] = *(const f32x4*)(base + off + bj * HALF + 4); } }
#pragma unroll
        for (int gi = 0; gi < 8; ++gi) { const int ai = gi >> 2, m = gi & 3; float q = 0.f;
            if (gi < 6) { const int ai2 = (gi + 2) >> 2, m2 = (gi + 2) & 3; const size_t off2 = (size_t)(row0 + ai2 * HALF + m2 * 16) * D + col0;
#pragma unroll
                for (int bj = 0; bj < 2; ++bj) { bq[(gi + 2) % 3][2 * bj] = *(const f32x4*)(base + off2 + bj * HALF); bq[(gi + 2) % 3][2 * bj + 1] = *(const f32x4*)(base + off2 + bj * HALF + 4); } }
            f32x4 bc[4];
#pragma unroll
            for (int k = 0; k < 4; ++k) bc[k] = bq[gi % 3][k];
#pragma unroll
            for (int bj = 0; bj < 2; ++bj) {
                const f32x4 v0 = bc[2 * bj] + acc[ai][bj][m][0] * scale, v1 = bc[2 * bj + 1] + acc[ai][bj][m][1] * scale;
                acc[ai][bj][m][0] = v0; acc[ai][bj][m][1] = v1;
                if (xn) { const size_t offo = (size_t)(row0 + ai * HALF + m * 16) * D + col0 + bj * HALF; *(f32x4*)(out + offo) = v0; *(f32x4*)(out + offo + 4) = v1; }
                q += (v0[0] * v0[0] + v0[1] * v0[1]) + (v0[2] * v0[2] + v0[3] * v0[3]) + (v1[0] * v1[0] + v1[1] * v1[1]) + (v1[2] * v1[2] + v1[3] * v1[3]); }
            q += __shfl_xor(q, 16); q += __shfl_xor(q, 32);
            if (fq == 0) Pt[(ai * HALF + wr * 64 + m * 16 + fr) * 4 + wc] = q; }
        LDS_WAIT(); __builtin_amdgcn_s_barrier(); asm volatile("" ::: "memory");
        const int t = wid * 64 + lane;
        if (t < 256) { const float sp = (Pt[t * 4 + 0] + Pt[t * 4 + 1]) + (Pt[t * 4 + 2] + Pt[t * 4 + 3]);
            __hip_atomic_store(ss + (size_t)u.pn * M + u.pm * BM + t, sp, __ATOMIC_RELAXED, __HIP_MEMORY_SCOPE_AGENT); }
        asm volatile("s_waitcnt vmcnt(0)" ::: "memory");
        if (t < 256 && lane == 0) __hip_atomic_fetch_add(cnt + 16 * u.pm, 1u, __ATOMIC_RELAXED, __HIP_MEMORY_SCOPE_AGENT);
        if (wid == 0) {
            unsigned sp_ = 0;
            while ((unsigned)__builtin_amdgcn_readfirstlane(__hip_atomic_load(cnt + 16 * u.pm, __ATOMIC_RELAXED, __HIP_MEMORY_SCOPE_AGENT)) < 16u) { __builtin_amdgcn_s_sleep(1); if (++sp_ > (1u << 22)) break; }
            __builtin_amdgcn_fence(__ATOMIC_ACQUIRE, "agent");
        }
        asm volatile("s_waitcnt vmcnt(0) lgkmcnt(0)" ::: "memory"); __builtin_amdgcn_s_barrier(); asm volatile("" ::: "memory");
        if (t < 256) { float s4 = 0.f;
#pragma unroll
            for (int p = 0; p < 4; ++p) s4 += __hip_atomic_load(ss + (size_t)p * M + u.pm * BM + t, __ATOMIC_RELAXED, __HIP_MEMORY_SCOPE_AGENT);
            Rt[t] = 1.0f / sqrtf(s4 * (1.0f / D) + EPS); }
        f32x4 gv[4];
#pragma unroll
        for (int k = 0; k < 4; ++k) gv[k] = (f32x4){1.f, 1.f, 1.f, 1.f};
        if (!xn) {
#pragma unroll
            for (int bj = 0; bj < 2; ++bj) { gv[2 * bj] = *(const f32x4*)(gain + col0 + bj * HALF); gv[2 * bj + 1] = *(const f32x4*)(gain + col0 + bj * HALF + 4); } }
        LDS_WAIT(); __builtin_amdgcn_s_barrier(); asm volatile("" ::: "memory");
#pragma unroll
        for (int gi = 0; gi < 8; ++gi) { const int ai = gi >> 2, m = gi & 3; const int rl = ai * HALF + wr * 64 + m * 16 + fr; const float r = Rt[rl];
            const size_t off = (size_t)(u.pm * BM + rl) * D + col0;
#pragma unroll
            for (int bj = 0; bj < 2; ++bj) { const f32x4 o0 = acc[ai][bj][m][0] * r * gv[2 * bj], o1 = acc[ai][bj][m][1] * r * gv[2 * bj + 1];
                if (xn) { u32x4 w; w.x = cvt_pk_bf16(o0[0], o0[1]); w.y = cvt_pk_bf16(o0[2], o0[3]); w.z = cvt_pk_bf16(o1[0], o1[1]); w.w = cvt_pk_bf16(o1[2], o1[3]); *(u32x4*)(xn + off + bj * HALF) = w; }
                else { *(f32x4*)(out + off + bj * HALF) = o0; *(f32x4*)(out + off + bj * HALF + 4) = o1; } } }
    }
};
template <bool BASE_BF16, bool FINAL>
struct EpiResX {
    static constexpr bool AFTER_DRAIN = true;
    const float* base; const bf16* bbn; const float* brs; float* out; const float* gain; bf16* xn; float* rs_out; float* ss; unsigned* cnt; float scale; const float* cgain;
    __device__ __forceinline__ void fused(f32x4 (&acc)[2][2][4][2], const Unit& u, int wr, int wc, int fr, int fq, LAS unsigned char* lds, int wid, int lane) const {
        LAS float* Pt = (LAS float*)lds;
        LAS float* Rt = (LAS float*)(lds + 4096);
        const int row0 = u.pm * BM + wr * 64 + fr, col0 = u.pn * BM + wc * 32 + 8 * fq;
        float inv8[8];
#pragma unroll
        for (int gi = 0; gi < 8; ++gi) inv8[gi] = BASE_BF16 ? brs[row0 + (gi >> 2) * HALF + (gi & 3) * 16] : 1.0f;
        f32x4 ci[4];
#pragma unroll
        for (int k = 0; k < 4; ++k) ci[k] = (f32x4){1.f, 1.f, 1.f, 1.f};
        if (BASE_BF16 && cgain) {
#pragma unroll
            for (int k = 0; k < 4; ++k) { const f32x4 gq = *(const f32x4*)(cgain + col0 + (k >> 1) * HALF + (k & 1) * 4); ci[k] = (f32x4){1.0f / gq[0], 1.0f / gq[1], 1.0f / gq[2], 1.0f / gq[3]}; } }
        f32x4 bq[3][4]; u32x4 bqb[3][2];
#define ERX_LOAD(slot, g_) do { const size_t off_ = (size_t)(row0 + ((g_) >> 2) * HALF + ((g_) & 3) * 16) * D + col0; \
            if constexpr (BASE_BF16) { bqb[slot][0] = *(const u32x4*)(bbn + off_); bqb[slot][1] = *(const u32x4*)(bbn + off_ + HALF); } \
            else { _Pragma("unroll") for (int bj_ = 0; bj_ < 2; ++bj_) { bq[slot][2 * bj_] = *(const f32x4*)(base + off_ + bj_ * HALF); bq[slot][2 * bj_ + 1] = *(const f32x4*)(base + off_ + bj_ * HALF + 4); } } } while (0)
        ERX_LOAD(0, 0); ERX_LOAD(1, 1);
#pragma unroll
        for (int gi = 0; gi < 8; ++gi) { const int ai = gi >> 2, m = gi & 3; float q = 0.f;
            if (gi < 6) ERX_LOAD((gi + 2) % 3, gi + 2);
            f32x4 bc[4];
            if constexpr (BASE_BF16) { const float iv = inv8[gi];
#pragma unroll
                for (int bj = 0; bj < 2; ++bj) { const u32x4 w = bqb[gi % 3][bj];
                    bc[2 * bj] = (f32x4){bflo(w.x), bfhi(w.x), bflo(w.y), bfhi(w.y)} * iv * ci[2 * bj]; bc[2 * bj + 1] = (f32x4){bflo(w.z), bfhi(w.z), bflo(w.w), bfhi(w.w)} * iv * ci[2 * bj + 1]; }
            } else {
#pragma unroll
                for (int k = 0; k < 4; ++k) bc[k] = bq[gi % 3][k]; }
#pragma unroll
            for (int bj = 0; bj < 2; ++bj) {
                const f32x4 v0 = bc[2 * bj] + acc[ai][bj][m][0] * scale, v1 = bc[2 * bj + 1] + acc[ai][bj][m][1] * scale;
                acc[ai][bj][m][0] = v0; acc[ai][bj][m][1] = v1;
                q += (v0[0] * v0[0] + v0[1] * v0[1]) + (v0[2] * v0[2] + v0[3] * v0[3]) + (v1[0] * v1[0] + v1[1] * v1[1]) + (v1[2] * v1[2] + v1[3] * v1[3]); }
            q += __shfl_xor(q, 16); q += __shfl_xor(q, 32);
            if (fq == 0) Pt[(ai * HALF + wr * 64 + m * 16 + fr) * 4 + wc] = q; }
#undef ERX_LOAD
        LDS_WAIT(); __builtin_amdgcn_s_barrier(); asm volatile("" ::: "memory");
        const int t = wid * 64 + lane;
        if (t < 256) { const float sp = (Pt[t * 4 + 0] + Pt[t * 4 + 1]) + (Pt[t * 4 + 2] + Pt[t * 4 + 3]);
            __hip_atomic_store(ss + (size_t)u.pn * M + u.pm * BM + t, sp, __ATOMIC_RELAXED, __HIP_MEMORY_SCOPE_AGENT); }
        asm volatile("s_waitcnt vmcnt(0)" ::: "memory");
        if (t < 256 && lane == 0) __hip_atomic_fetch_add(cnt + 16 * u.pm, 1u, __ATOMIC_RELAXED, __HIP_MEMORY_SCOPE_AGENT);
        if (wid == 0) {
            unsigned sp_ = 0;
            while ((unsigned)__builtin_amdgcn_readfirstlane(__hip_atomic_load(cnt + 16 * u.pm, __ATOMIC_RELAXED, __HIP_MEMORY_SCOPE_AGENT)) < 16u) { __builtin_amdgcn_s_sleep(1); if (++sp_ > (1u << 22)) break; }
            __builtin_amdgcn_fence(__ATOMIC_ACQUIRE, "agent");
        }
        asm volatile("s_waitcnt vmcnt(0) lgkmcnt(0)" ::: "memory"); __builtin_amdgcn_s_barrier(); asm volatile("" ::: "memory");
        if (t < 256) { float s4 = 0.f;
#pragma unroll
            for (int p = 0; p < 4; ++p) s4 += __hip_atomic_load(ss + (size_t)p * M + u.pm * BM + t, __ATOMIC_RELAXED, __HIP_MEMORY_SCOPE_AGENT);
            const float ms = s4 * (1.0f / D) + EPS, sq = sqrtf(ms);
            Rt[t] = 1.0f / sq;
            if (!FINAL && u.pn == 0) rs_out[u.pm * BM + t] = sq; }
        f32x4 gv[4];
#pragma unroll
        for (int k = 0; k < 4; ++k) gv[k] = (f32x4){1.f, 1.f, 1.f, 1.f};
        if constexpr (FINAL) {
#pragma unroll
            for (int bj = 0; bj < 2; ++bj) { gv[2 * bj] = *(const f32x4*)(gain + col0 + bj * HALF); gv[2 * bj + 1] = *(const f32x4*)(gain + col0 + bj * HALF + 4); } }
        LDS_WAIT(); __builtin_amdgcn_s_barrier(); asm volatile("" ::: "memory");
#pragma unroll
        for (int gi = 0; gi < 8; ++gi) { const int ai = gi >> 2, m = gi & 3; const int rl = ai * HALF + wr * 64 + m * 16 + fr; const float r = Rt[rl];
            const size_t off = (size_t)(u.pm * BM + rl) * D + col0;
#pragma unroll
            for (int bj = 0; bj < 2; ++bj) { const f32x4 o0 = acc[ai][bj][m][0] * r * gv[2 * bj], o1 = acc[ai][bj][m][1] * r * gv[2 * bj + 1];
                if constexpr (!FINAL) { u32x4 w; w.x = cvt_pk_bf16(o0[0], o0[1]); w.y = cvt_pk_bf16(o0[2], o0[3]); w.z = cvt_pk_bf16(o1[0], o1[1]); w.w = cvt_pk_bf16(o1[2], o1[3]); st16_wt(wt_rsrc(xn, (unsigned)((size_t)M * D * 2)), (off + bj * HALF) * 2, w); }
                else { *(f32x4*)(out + off + bj * HALF) = o0; *(f32x4*)(out + off + bj * HALF + 4) = o1; } } }
    }
};
}

#define XB_TMO      128
#define XB_XCNT(j)  (256  + 64 * (j))
#define XB_XSUB(j)  (1280 + 64 * (j))
#define XB_XGEN(j)  (2304 + 64 * (j))
#define XB_TOP      3328
#define XB_TOPGEN   3392
#define XCD_BAR_WORDS 3456
#define XB_SPIN_CAP (1u << 18)
__device__ __forceinline__ unsigned xb_ld(unsigned* p)              { return __hip_atomic_load(p, __ATOMIC_RELAXED, __HIP_MEMORY_SCOPE_AGENT); }
__device__ __forceinline__ unsigned xb_add(unsigned* p, unsigned v) { return __hip_atomic_fetch_add(p, v, __ATOMIC_RELAXED, __HIP_MEMORY_SCOPE_AGENT); }
__device__ __forceinline__ unsigned xb_xcc_id() { return (unsigned)__builtin_amdgcn_s_getreg((3 << 11) | 20) & 0xFu; }
#define XB_SPIN(cond, bar) do { unsigned _sp = 0; while (cond) { __builtin_amdgcn_s_sleep(1); \
    if ((++_sp & 255u) == 0u) { if (xb_ld(&(bar)[XB_TMO])) break; if (_sp > XB_SPIN_CAP) { atomicAdd(&(bar)[XB_TMO], 1u); break; } } } } while (0)
struct XcdBarrier { unsigned* bar; unsigned x; volatile LAS unsigned* st; };
__device__ __forceinline__ XcdBarrier xcd_barrier_post(unsigned* bar, volatile LAS unsigned* st) {
    XcdBarrier b; b.bar = bar; b.x = xb_xcc_id(); b.st = st;
    if (threadIdx.x == 0) (void)xb_add(&bar[XB_XCNT(b.x)], 1u);
    return b;
}
__device__ __forceinline__ void xcd_barrier_complete(unsigned* bar, unsigned x, unsigned& nloc, unsigned& nx) {
    const unsigned G = gridDim.x * gridDim.y * gridDim.z;
    unsigned sum, cnt, mine, sp = 0u;
    for (;;) {
        sum = 0u; cnt = 0u; mine = 0u;
#pragma unroll
        for (unsigned j = 0; j < 16; ++j) { const unsigned c = xb_ld(&bar[XB_XCNT(j)]); sum += c; cnt += (c > 0u) ? 1u : 0u; mine = (j == x) ? c : mine; }
        if (sum == G) break;
        __builtin_amdgcn_s_sleep(1);
        if ((++sp & 255u) == 0u) { if (xb_ld(&bar[XB_TMO])) break; if (sp > XB_SPIN_CAP) { atomicAdd(&bar[XB_TMO], 1u); break; } }
    }
    nloc = mine > 0u ? mine : 1u; nx = cnt > 0u ? cnt : 1u;
}
__device__ __forceinline__ void xcd_barrier(const XcdBarrier& b) {
    asm volatile("s_waitcnt vmcnt(0)" ::: "memory");
    __syncthreads();
    if (threadIdx.x == 0) {
        unsigned* bar = b.bar;
        __builtin_amdgcn_s_waitcnt(0);
        unsigned nloc = b.st[0], nx = b.st[1];
        if (nloc == 0u) { xcd_barrier_complete(bar, b.x, nloc, nx); b.st[0] = nloc; b.st[1] = nx; }
        const unsigned old = xb_add(&bar[XB_XSUB(b.x)], 1u);
        const unsigned gen = old / nloc;
        if (old + 1u == (gen + 1u) * nloc) {
            __builtin_amdgcn_fence(__ATOMIC_RELEASE, "agent");
            asm volatile("s_waitcnt vmcnt(0)" ::: "memory");
            const unsigned og = xb_add(&bar[XB_TOP], 1u);
            const unsigned tg = og / nx;
            if (og + 1u == (tg + 1u) * nx) xb_add(&bar[XB_TOPGEN], 1u);
            else XB_SPIN(xb_ld(&bar[XB_TOPGEN]) == tg, bar);
            __builtin_amdgcn_fence(__ATOMIC_ACQUIRE, "agent");
            xb_add(&bar[XB_XGEN(b.x)], 1u);
            asm volatile("s_waitcnt vmcnt(0)" ::: "memory");
        } else {
            XB_SPIN(xb_ld(&bar[XB_XGEN(b.x)]) == gen, bar);
            __builtin_amdgcn_fence(__ATOMIC_ACQUIRE, "agent");
            asm volatile("s_waitcnt vmcnt(0)" ::: "memory");
        }
    }
    __syncthreads();
}

__device__ __forceinline__ void p0_transpose_item(const float* W, int ldw, int k0, int nsrc0, int nvalid, const float* kscale, bf16* WT, int ldk, int ndst0, LAS float* scr, int lane) {
    const int n4 = (lane & 7) * 4;
    const int n4c = n4 < nvalid ? n4 : 0;
    f32x4 tv[8]; float ksv[8];
#pragma unroll
    for (int i = 0; i < 8; ++i) { const int kk = 8 * i + (lane >> 3); tv[i] = __builtin_nontemporal_load((const f32x4*)(W + (size_t)(k0 + kk) * ldw + nsrc0 + n4c)); }
    if (kscale) {
#pragma unroll
        for (int i = 0; i < 8; ++i) ksv[i] = kscale[k0 + 8 * i + (lane >> 3)];
#pragma unroll
        for (int i = 0; i < 8; ++i) tv[i] = tv[i] * ksv[i]; }
#pragma unroll
    for (int i = 0; i < 8; ++i) { const int kk = 8 * i + (lane >> 3);
        scr[kk * 33 + n4] = tv[i].x; scr[kk * 33 + n4 + 1] = tv[i].y; scr[kk * 33 + n4 + 2] = tv[i].z; scr[kk * 33 + n4 + 3] = tv[i].w; }
    LDS_WAIT(); asm volatile("" ::: "memory");
    const int c = lane & 7;
#pragma unroll
    for (int j = 0; j < 4; ++j) { const int n = (lane >> 3) + 8 * j; const LAS float* s = scr + (8 * c) * 33 + n;
        u32x4 o; o.x = pk2(s[0 * 33], s[1 * 33]); o.y = pk2(s[2 * 33], s[3 * 33]); o.z = pk2(s[4 * 33], s[5 * 33]); o.w = pk2(s[6 * 33], s[7 * 33]);
        if (n < nvalid) *(u32x4*)(WT + (size_t)(ndst0 + n) * ldk + k0 + 8 * c) = o; }
    LDS_WAIT(); asm volatile("" ::: "memory");
}

struct Args { const float* in[21]; float* out; unsigned char* ws; int ph_lo, ph_hi; };

template <int PART>
__device__ __forceinline__ void p0_prologue(const Args& a, LAS unsigned char* lds, int gw, int NGW, int wave, int lane) {
    LAS float* scr = (LAS float*)(lds + wave * 16384);
    unsigned char* ws = a.ws;
    bf16 *GU1 = (bf16*)(ws + WS_GU1), *D1 = (bf16*)(ws + WS_D1), *GU2 = (bf16*)(ws + WS_GU2), *D2 = (bf16*)(ws + WS_D2), *WIN = (bf16*)(ws + WS_WIN), *WOUT = (bf16*)(ws + WS_WOUT), *XN = (bf16*)(ws + WS_XN);
    if constexpr (PART == 0) {
        const float* gain = a.in[1];
        f32x4 gv[4];
#pragma unroll
        for (int j = 0; j < 4; ++j) gv[j] = *((const f32x4*)gain + lane + 64 * j);
        for (int m = gw; m < M; m += 4 * NGW) {
            f32x4 v[4][4];
#pragma unroll
            for (int q = 0; q < 4; ++q) { const int mm = m + q * NGW; const f32x4* xr = (const f32x4*)(a.in[0] + (size_t)(mm < M ? mm : m) * D) + lane;
#pragma unroll
                for (int j = 0; j < 4; ++j) v[q][j] = __builtin_nontemporal_load(xr + 64 * j); }
#pragma unroll
            for (int q = 0; q < 4; ++q) { const int mm = m + q * NGW; float s = 0.f;
#pragma unroll
                for (int j = 0; j < 4; ++j) s += (v[q][j].x * v[q][j].x + v[q][j].y * v[q][j].y) + (v[q][j].z * v[q][j].z + v[q][j].w * v[q][j].w);
                const float sq0 = sqrtf(wave_sum(s) * (1.0f / D) + EPS), r = 1.0f / sq0;
                if (mm < M && lane == 0) ((float*)(ws + WS_RS0))[mm] = sq0;
                if (mm < M) { u32x2* o8 = (u32x2*)(XN + (size_t)mm * D) + lane;
#pragma unroll
                    for (int j = 0; j < 4; ++j) { u32x2 w; w.x = pk2(v[q][j].x * r * gv[j].x, v[q][j].y * r * gv[j].y); w.y = pk2(v[q][j].z * r * gv[j].z, v[q][j].w * r * gv[j].w); o8[64 * j] = w; } } }
        }
    }
    constexpr int I_GU = 16 * 88, I_DN = 44 * 32, I_IN = 16 * 113, I_OUT = 16 * 32;
    if constexpr (PART == 0) {
    for (int it = gw; it < 4 * I_GU; it += NGW) {
        int r = it; const int which = r / I_GU; r -= which * I_GU; const int kb = r / 88, nb = r % 88, j0 = 32 * nb;
        const float* W = a.in[which == 0 ? 2 : which == 1 ? 3 : which == 2 ? 17 : 18];
        const float* ks = which >= 2 ? a.in[16] : nullptr;
        bf16* WT = which >= 2 ? GU2 : GU1;
        p0_transpose_item(W, FF, 64 * kb, j0, 32, ks, WT, D, 256 * (j0 >> 7) + (j0 & 127) + 128 * (which & 1), scr, lane); }
    }
    if constexpr (PART == 1 || PART == 2) {
    for (int it = gw; it < I_DN; it += NGW) { const int kb = it / 32, nb = it % 32;
        p0_transpose_item(a.in[PART == 2 ? 19 : 4], D, 64 * kb, 32 * nb, 32, nullptr, PART == 2 ? D2 : D1, FF, 32 * nb, scr, lane); }
    }
    if constexpr (PART == 1) {
    for (int it = gw; it < I_IN + I_OUT; it += NGW) {
        int r = it;
        if (r < I_IN) { const int kb = r / 113, db = r % 113;
            const int nd = 32 * db, nsrc = db < 80 ? nd : (db < 112 ? nd + 16 : 2560), nv = db < 112 ? 32 : 16;
            p0_transpose_item(a.in[6], 3600, 64 * kb, nsrc, nv, a.in[5], WIN, D, nd, scr, lane); continue; }
        r -= I_IN;
        { const int kb = r / 32, nb = r % 32;
            p0_transpose_item(a.in[15], D, 64 * kb, 32 * nb, 32, a.in[12], WOUT, MIXD, 32 * nb, scr, lane); }
    }
    for (int it = gw; it < 16 * 32; it += NGW) { const int kb = it / 32, nb = it % 32;
        p0_transpose_item(a.in[15] + (size_t)1024 * D, D, 64 * kb, 32 * nb, 32, nullptr, (bf16*)(ws + WS_FA) + (size_t)(kb >> 2) * 1024 * 256 - (size_t)(kb >> 2) * 256, 256, 32 * nb, scr, lane); }
    { bf16* FB = (bf16*)(ws + WS_FB);
      for (int i = gw * 64 + lane; i < 4 * 256 * 256 / 4; i += NGW * 64) { const int e0 = 4 * i, g = e0 >> 16, d = e0 & 255;
          const f32x4 w = *(const f32x4*)(a.in[13] + e0), sc = *(const f32x4*)(a.in[14] + 256 * g + d);
          *(u32x2*)(FB + e0) = (u32x2){pk2(w.x * sc.x, w.y * sc.y), pk2(w.z * sc.z, w.w * sc.w)}; } }
    }
}

constexpr int SB_CC = 0, SB_BC = 17408, SB_XT = 34816, SB_XD = 39424, SB_VEC = 44032, SB_STRIDE = 45056;
constexpr int SL_MM = 90112, SL_SL = 99328, SL_END = 108032;
constexpr int P272 = 272, P144 = 144;
typedef short v4i16_t __attribute__((ext_vector_type(4)));

__device__ __forceinline__ void unpack8(const u32x4 r, float (&f)[8]) { f[0] = bflo(r.x); f[1] = bfhi(r.x); f[2] = bflo(r.y); f[3] = bfhi(r.y); f[4] = bflo(r.z); f[5] = bfhi(r.z); f[6] = bflo(r.w); f[7] = bfhi(r.w); }

__device__ __forceinline__ void conv8x4(const bf16* PROJ, size_t tok0, int tseq, int col, const float* conv_w, const float* conv_b, bf16* dst, int pitch) {
    float wbc[4][8], bbc[8];
#pragma unroll
    for (int k = 0; k < 4; ++k) { const f32x4 w0 = *(const f32x4*)(conv_w + k * CONV_DIM + col - 1024), w1 = *(const f32x4*)(conv_w + k * CONV_DIM + col - 1024 + 4);
#pragma unroll
        for (int e = 0; e < 4; ++e) { wbc[k][e] = w0[e]; wbc[k][4 + e] = w1[e]; } }
    { const f32x4 w0 = *(const f32x4*)(conv_b + col - 1024), w1 = *(const f32x4*)(conv_b + col - 1024 + 4);
#pragma unroll
        for (int e = 0; e < 4; ++e) { bbc[e] = w0[e]; bbc[4 + e] = w1[e]; } }
    u32x4 rbc[7];
#pragma unroll
    for (int i = 0; i < 7; ++i) { rbc[i] = (u32x4){0u, 0u, 0u, 0u}; if (tseq - 3 + i >= 0) rbc[i] = *(const u32x4*)(PROJ + (tok0 + tseq - 3 + i) * PROJ_LD + col); }
    float ob[4][8];
#pragma unroll
    for (int j = 0; j < 4; ++j)
#pragma unroll
        for (int e = 0; e < 8; ++e) ob[j][e] = bbc[e];
#pragma unroll
    for (int i = 0; i < 7; ++i) { float f[8]; unpack8(rbc[i], f);
#pragma unroll
        for (int j = 0; j < 4; ++j) { const int k = i - j; if (k >= 0 && k < 4) {
#pragma unroll
            for (int e = 0; e < 8; ++e) ob[j][e] += wbc[k][e] * f[e]; } } }
#pragma unroll
    for (int j = 0; j < 4; ++j) {
#pragma unroll
        for (int e = 0; e < 8; ++e) ob[j][e] = silu_f(ob[j][e]);
        u32x4 w; w.x = cvt_pk_bf16(ob[j][0], ob[j][1]); w.y = cvt_pk_bf16(ob[j][2], ob[j][3]); w.z = cvt_pk_bf16(ob[j][4], ob[j][5]); w.w = cvt_pk_bf16(ob[j][6], ob[j][7]);
        *(u32x4*)(dst + (size_t)j * pitch) = w; }
}

__device__ __forceinline__ void conv_phase(const Args& a, int G, int vc) {
    const int tid = threadIdx.x, lane = tid & 63, wave = __builtin_amdgcn_readfirstlane(tid >> 6);
    const bf16* PROJ = (const bf16*)(a.ws + WS_PROJ);
    bf16* BCG = (bf16*)a.out;
    bf16* MIX = (bf16*)(a.ws + WS_MIX);
    const float* DT = (const float*)(a.ws + WS_DT);
    float* DTV = (float*)(a.ws + WS_DTV); float* CSV = (float*)(a.ws + WS_CSV);
    const float* conv_w = a.in[7]; const float* conv_b = a.in[8];
    for (int uu = 2 * vc; uu < 512; uu += 2 * G)
    for (int unit = uu; unit < uu + 2; ++unit) {
        const int b = unit >> 6, c = (unit >> 1) & 31, g = unit & 1;
        const size_t tok0 = (size_t)b * SEQ;
        { const int cg = tid & 31, tl = tid >> 5;
          conv8x4(PROJ, tok0, c * 64 + 4 * tl, B_OFF + (cg >> 4) * 256 + g * 128 + 8 * (cg & 15), conv_w, conv_b, BCG + (size_t)unit * 16384 + (4 * tl) * 256 + 8 * cg, 256); }
#pragma unroll 1
        for (int pass = 0; pass < 2; ++pass) { const int cgx = tid & 63, tlx = (tid >> 6) + 8 * pass; const int ch = g * 512 + 8 * cgx;
          conv8x4(PROJ, tok0, c * 64 + 4 * tlx, XS_OFF + ch, conv_w, conv_b, MIX + (tok0 + c * 64 + 4 * tlx) * MIXD + ch, MIXD); }
        { const int h = 8 * g + wave; const size_t tok = tok0 + c * 64 + lane;
          const float xdt = DT[tok * 16 + h] + a.in[9][h];
          const float dtv = xdt > 20.f ? xdt : log1pf(expf(xdt));
          float cs = dtv * (-expf(a.in[10][h]));
#pragma unroll
          for (int o = 1; o < 64; o <<= 1) { const float t = __shfl_up(cs, o); if (lane >= o) cs += t; }
          DTV[tok * 16 + h] = dtv; CSV[tok * 16 + h] = cs; }
    }
}

__device__ __forceinline__ void ssd_phase(LAS unsigned char* lds, const Args& a, int G, int vc) {
    const int tid = threadIdx.x, lane = tid & 63, wave = __builtin_amdgcn_readfirstlane(tid >> 6);
    const int l16 = lane & 15, quad = lane >> 4;
    const bf16* PROJ = (const bf16*)(a.ws + WS_PROJ);
    const bf16* BCG = (const bf16*)a.out;
    const float* DTV = (const float*)(a.ws + WS_DTV); const float* CSV = (const float*)(a.ws + WS_CSV);
    bf16* MIX = (bf16*)(a.ws + WS_MIX);
    float* PSS = (float*)(a.ws + WS_PSS);
    for (int item = vc; item < 256; item += G) {
        const int b = item >> 5, h = (item >> 1) & 15, ph = item & 1, g = h >> 3;
        const float Dh = a.in[11][h];
        const int xtok = tid >> 3, xc4 = tid & 7;
        const int x_ch = h * 64 + ph * 32 + 4 * xc4;
        f32x4 accS[2]; accS[0] = (f32x4){0.f, 0.f, 0.f, 0.f}; accS[1] = accS[0];
        for (int i = tid; i < (SL_END - SL_SL) / 4; i += NTHR) ((LAS unsigned*)(lds + SL_SL))[i] = 0u;
        const size_t tok0 = (size_t)b * SEQ;
        const int ti = wave >> 1, q = wave & 1;
        const int pcol = h * 64 + ph * 32 + 16 * q + 4 * quad;
        u32x4 rbA[2][4]; u32x2 xrA[2]; float dtvA[2], csA[2]; u32x2 zrA[2];
#define SSD_LOAD_RAW(c, S) do { const bf16* ub = BCG + ((size_t)(b * 32 + (c)) * 2 + g) * 16384; \
            _Pragma("unroll") for (int k = 0; k < 4; ++k) rbA[S][k] = *(const u32x4*)(ub + (size_t)(tid + 512 * k) * 8); \
            xrA[S] = *(const u32x2*)(MIX + (tok0 + (size_t)(c) * 64 + xtok) * MIXD + x_ch); \
            dtvA[S] = DTV[(tok0 + (c) * 64 + lane) * 16 + h]; csA[S] = CSV[(tok0 + (c) * 64 + lane) * 16 + h]; \
            zrA[S] = *(const u32x2*)(PROJ + (tok0 + (size_t)(c) * 64 + 16 * ti + l16) * PROJ_LD + Z_OFF + pcol); } while (0)
        SSD_LOAD_RAW(0, 0); SSD_LOAD_RAW(1, 1);
#pragma unroll 2
        for (int c = 0; c < 32; ++c) {
            const int S = c & 1;
            const float dtv = dtvA[S], cs = csA[S]; const u32x2 xr = xrA[S];
            LAS unsigned char* sb = lds + (c & 1) * SB_STRIDE;
            const float cs63 = __shfl(cs, 63);
#pragma unroll
            for (int k = 0; k < 4; ++k) { const int pp = tid + 512 * k, row = pp >> 5, c16 = pp & 31;
                *(LAS u32x4*)(sb + (c16 < 16 ? SB_BC : SB_CC) + row * P272 + 16 * (c16 & 15)) = rbA[S][k]; }
            {
                const float sd = __shfl(dtv, xtok & 63) * __expf(cs63 - __shfl(cs, xtok & 63));
                const float f[4] = {bflo(xr.x), bfhi(xr.x), bflo(xr.y), bfhi(xr.y)};
                const unsigned xb[4] = {xr.x & 0xffffu, xr.x >> 16, xr.y & 0xffffu, xr.y >> 16};
#pragma unroll
                for (int e = 0; e < 4; ++e) {
                    *(LAS unsigned short*)(sb + SB_XT + (4 * xc4 + e) * P144 + 2 * xtok) = (unsigned short)xb[e];
                    *(LAS unsigned short*)(sb + SB_XD + (4 * xc4 + e) * P144 + 2 * xtok) = (unsigned short)f2bf(f[e] * sd); }
            }
            if (wave == 0) { ((LAS float*)(sb + SB_VEC))[lane] = cs; ((LAS float*)(sb + SB_VEC))[64 + lane] = dtv; }
            const float dec = __expf(cs63);
            LDS_WAIT(); __builtin_amdgcn_s_barrier(); asm volatile("" ::: "memory");
            const size_t otok = tok0 + (size_t)c * 64 + 16 * ti + l16;
            const float zv[4] = {bflo(zrA[S].x), bfhi(zrA[S].x), bflo(zrA[S].y), bfhi(zrA[S].y)};
            if (c + 2 < 32) SSD_LOAD_RAW(c + 2, S);
            const float cs_l = ((const LAS float*)(sb + SB_VEC))[16 * ti + l16];
            bf16x8 Cf[4];
#pragma unroll
            for (int k = 0; k < 4; ++k) Cf[k] = *(const LAS bf16x8*)(sb + SB_CC + (16 * ti + l16) * P272 + (32 * k + 8 * quad) * 2);
#pragma unroll
            for (int jj = 0; jj < 2; ++jj) {
                const int j = 2 * q + jj;
                if (j <= ti) {
                    f32x4 gacc = (f32x4){0.f, 0.f, 0.f, 0.f};
#pragma unroll
                    for (int k = 0; k < 4; ++k) {
                        const bf16x8 Aop = *(const LAS bf16x8*)(sb + SB_BC + (16 * j + l16) * P272 + (32 * k + 8 * quad) * 2);
                        gacc = __builtin_amdgcn_mfma_f32_16x16x32_bf16(Aop, Cf[k], gacc, 0, 0, 0); }
                    const f32x4 cs_s = *(const LAS f32x4*)(sb + SB_VEC + (16 * j + 4 * quad) * 4), dt_s = *(const LAS f32x4*)(sb + SB_VEC + 256 + (16 * j + 4 * quad) * 4);
                    float mv[4];
#pragma unroll
                    for (int r = 0; r < 4; ++r) { const int s_ = 16 * j + 4 * quad + r, l = 16 * ti + l16;
                        float v = gacc[r] * __expf(fminf(cs_l - cs_s[r], 0.f)) * dt_s[r];
                        v = (s_ <= l) ? v : 0.f; if (s_ == l) v += Dh; mv[r] = v; }
                    *(LAS u32x2*)(lds + SL_MM + (16 * ti + l16) * P144 + (16 * j + 4 * quad) * 2) = (u32x2){cvt_pk_bf16(mv[0], mv[1]), cvt_pk_bf16(mv[2], mv[3])};
                } else if ((j >> 1) <= (ti >> 1)) {
                    *(LAS u32x2*)(lds + SL_MM + (16 * ti + l16) * P144 + (16 * j + 4 * quad) * 2) = (u32x2){0u, 0u};
                }
            }
            f32x4 y = (f32x4){0.f, 0.f, 0.f, 0.f};
#pragma unroll
            for (int k = 0; k < 4; ++k) {
                const bf16x8 Aop = *(const LAS bf16x8*)(lds + SL_SL + (16 * q + l16) * P272 + (32 * k + 8 * quad) * 2);
                y = __builtin_amdgcn_mfma_f32_16x16x32_bf16(Aop, Cf[k], y, 0, 0, 0); }
            y = y * __expf(cs_l);
#pragma unroll
            for (int t = 0; t < 2; ++t) { const int jn = 2 * ti + t;
                accS[t] = accS[t] * dec;
#pragma unroll
                for (int kk = 0; kk < 2; ++kk) {
                    LAS unsigned char* tp = sb + SB_BC + (32 * kk + 8 * quad + (l16 >> 2)) * P272 + (16 * jn + 4 * (lane & 3)) * 2;
                    const v4i16_t lo = __builtin_amdgcn_ds_read_tr16_b64_v4i16((LAS v4i16_t*)tp), hi = __builtin_amdgcn_ds_read_tr16_b64_v4i16((LAS v4i16_t*)(tp + 4 * P272));
                    const bf16x8 Aop = __builtin_shufflevector(lo, hi, 0, 1, 2, 3, 4, 5, 6, 7);
                    const bf16x8 Bop = *(const LAS bf16x8*)(sb + SB_XD + (16 * q + l16) * P144 + (32 * kk + 8 * quad) * 2);
                    accS[t] = __builtin_amdgcn_mfma_f32_16x16x32_bf16(Aop, Bop, accS[t], 0, 0, 0); } }
            LDS_WAIT(); __builtin_amdgcn_s_barrier(); asm volatile("" ::: "memory");
            for (int kk = 0; kk <= (ti >> 1); ++kk) {
                const bf16x8 Aop = *(const LAS bf16x8*)(sb + SB_XT + (16 * q + l16) * P144 + (32 * kk + 8 * quad) * 2);
                const bf16x8 Bop = *(const LAS bf16x8*)(lds + SL_MM + (16 * ti + l16) * P144 + (32 * kk + 8 * quad) * 2);
                y = __builtin_amdgcn_mfma_f32_16x16x32_bf16(Aop, Bop, y, 0, 0, 0); }
#pragma unroll
            for (int t = 0; t < 2; ++t) { const int jn = 2 * ti + t;
                *(LAS u32x2*)(lds + SL_SL + (16 * q + l16) * P272 + (16 * jn + 4 * quad) * 2) = (u32x2){cvtpk_s(accS[t][0], accS[t][1]), cvtpk_s(accS[t][2], accS[t][3])}; }
            float v[4], ssq = 0.f;
#pragma unroll
            for (int r = 0; r < 4; ++r) { v[r] = y[r] * silu_f(zv[r]); ssq += v[r] * v[r]; }
            *(u32x2*)(MIX + otok * MIXD + pcol) = (u32x2){cvt_pk_bf16(v[0], v[1]), cvt_pk_bf16(v[2], v[3])};
            ssq += __shfl_xor(ssq, 16); ssq += __shfl_xor(ssq, 32);
            PSS[(size_t)(g * 32 + (h & 7) * 4 + ph * 2 + q) * M + otok] = ssq;
        }
        LDS_WAIT(); __builtin_amdgcn_s_barrier(); asm volatile("" ::: "memory");
#undef SSD_LOAD_RAW
    }
}

template <int WIN>
__device__ __forceinline__ void pool_quads(const bf16* PROJ, bf16* MIX, int blk, int cgp, int tr) {
    for (int i = 0; i < 4; ++i) {
        const int t0 = blk * 64 + tr * 16 + 4 * i, ts0 = t0 & (SEQ - 1);
        u32x4 r[WIN + 3];
#pragma unroll
        for (int k = 0; k < WIN + 3; ++k) { const int dt = k - (WIN - 1); r[k] = (u32x4){0u, 0u, 0u, 0u};
            if (ts0 + dt >= 0) r[k] = *(const u32x4*)(PROJ + (size_t)(t0 + dt) * PROJ_LD + U_OFF + 8 * cgp); }
        float s[8];
#pragma unroll
        for (int e = 0; e < 8; ++e) s[e] = 0.f;
#pragma unroll
        for (int k = 0; k < WIN; ++k) { float f[8]; unpack8(r[k], f);
#pragma unroll
            for (int e = 0; e < 8; ++e) s[e] += f[e]; }
#pragma unroll
        for (int j = 0; j < 4; ++j) {
            float u0[8]; unpack8(r[WIN - 1 + j], u0);
            if (j > 0) { float f[8]; unpack8(r[j - 1], f);
#pragma unroll
                for (int e = 0; e < 8; ++e) s[e] += u0[e] - f[e]; }
            const int cnt = (ts0 + j + 1) < WIN ? (ts0 + j + 1) : WIN; const float inv = 1.0f / (float)cnt;
            u32x4 o; o.x = cvt_pk_bf16(s[0] * inv - u0[0], s[1] * inv - u0[1]); o.y = cvt_pk_bf16(s[2] * inv - u0[2], s[3] * inv - u0[3]);
            o.z = cvt_pk_bf16(s[4] * inv - u0[4], s[5] * inv - u0[5]); o.w = cvt_pk_bf16(s[6] * inv - u0[6], s[7] * inv - u0[7]);
            *(u32x4*)(MIX + (size_t)(t0 + j) * MIXD + 1024 + 8 * cgp) = o; }
    }
}
__device__ __forceinline__ void pool_phase(const Args& a, int G, int vc) {
    const bf16* PROJ = (const bf16*)(a.ws + WS_PROJ);
    bf16* MIX = (bf16*)(a.ws + WS_MIX);
    const int tid = threadIdx.x, lane = tid & 63, wave = __builtin_amdgcn_readfirstlane(tid >> 6);
    const int grp = wave & 3, cgp = grp * 32 + (lane & 31), tr = (wave >> 2) * 2 + (lane >> 5);
    for (int blk = vc; blk < M / 64; blk += G) {
        if (grp == 0) pool_quads<2>(PROJ, MIX, blk, cgp, tr);
        else if (grp == 1) pool_quads<4>(PROJ, MIX, blk, cgp, tr);
        else if (grp == 2) pool_quads<8>(PROJ, MIX, blk, cgp, tr);
        else pool_quads<16>(PROJ, MIX, blk, cgp, tr);
    }
}

constexpr int N_PHASES = 9;
__global__ void __launch_bounds__(NTHR, 2) hybrid_fwd(Args args) {
    extern __shared__ __attribute__((aligned(16))) unsigned char lds_raw[];
    LAS unsigned char* lds = (LAS unsigned char*)lds_raw;
    const int tid = threadIdx.x, lane = tid & 63, wave = __builtin_amdgcn_readfirstlane(tid >> 6);
    const int G = gridDim.x; const int bx = blockIdx.x; const int vcu = (G % 8 == 0) ? (bx % 8) * (G / 8) + bx / 8 : bx;
    unsigned char* ws = args.ws;
    volatile LAS unsigned* MISC = (volatile LAS unsigned*)(lds + MISC_OFF);
    if (tid < 32) MISC[tid] = 0u;
    __syncthreads();
    const int lo = args.ph_lo, hi = args.ph_hi;
#if MK_CG_SYNC
    cg::grid_group grid = cg::this_grid();
#define GRID_BAR() do { __threadfence(); grid.sync(); } while (0)
#else
    cg::grid_group grid = cg::this_grid();
    XcdBarrier bar; bar.bar = (unsigned*)(ws + WS_CTL) + CW_BAR; bar.x = 0; bar.st = nullptr;
    if (hi - lo > 1) bar = xcd_barrier_post((unsigned*)(ws + WS_CTL) + CW_BAR, MISC + 8);
    if (lo > 1000) grid.sync();
#define GRID_BAR() xcd_barrier(bar)
#endif
#define IN(k) (lo <= (k) && (k) < hi)
#define BOTH(k) (IN(k) && IN((k) + 1))
    bf16 *GU1 = (bf16*)(ws + WS_GU1), *D1 = (bf16*)(ws + WS_D1), *GU2 = (bf16*)(ws + WS_GU2), *D2 = (bf16*)(ws + WS_D2), *WIN = (bf16*)(ws + WS_WIN), *WOUT = (bf16*)(ws + WS_WOUT);
    bf16 *XN = (bf16*)(ws + WS_XN), *HID = (bf16*)(ws + WS_HID), *PROJ = (bf16*)(ws + WS_PROJ), *MIX = (bf16*)(ws + WS_MIX);
    float *SS = (float*)(ws + WS_SS), *DTB = (float*)(ws + WS_DT), *PSS = (float*)(ws + WS_PSS);

    if (IN(0)) { p0_prologue<0>(args, lds, vcu * NWAVES + wave, G * NWAVES, wave, lane); if (BOTH(0)) GRID_BAR(); }
    if (IN(1)) {
        pg8::Gemm g{XN, GU1, M, NGU, D}; pg8::StaticOrder S; S.init(M, NGU, G, bx);
        pg8::EpiSwiglu E{HID, nullptr};
        pg8::gemm_phase<pg8::EpiSwiglu, pg8::StaticOrder, pg8::NoHook, true>(lds, g, S, E, pg8::NoHook{});
        { const int first = ((M / 256) * (NGU / 256)) % G;
          if (bx >= first) p0_prologue<1>(args, lds, (bx - first) * NWAVES + wave, (G - first) * NWAVES, wave, lane); }
        if (BOTH(1)) GRID_BAR();
    }
    if (IN(2)) {
        pg8::Gemm g{HID, D1, M, D, FF}; pg8::StaticOrder S; S.init(M, D, G, bx);
        pg8::EpiResX<true, false> E{nullptr, XN, (const float*)(ws + WS_RS0), nullptr, nullptr, XN, (float*)(ws + WS_RS1), SS, (unsigned*)(ws + WS_CTL) + CW_PANEL, 0.5f, args.in[1]};
        pg8::gemm_phase<pg8::EpiResX<true, false>, pg8::StaticOrder, pg8::NoHook, false>(lds, g, S, E, pg8::NoHook{});
        if (BOTH(2)) GRID_BAR();
    }
    if (IN(3)) {
        pg8::Gemm g{XN, WIN, M, NIN, D}; pg8::StaticOrder S; S.init(M, NIN, G, bx);
        pg8::EpiProj E{PROJ, DTB, nullptr};
        pg8::gemm_phase<pg8::EpiProj, pg8::StaticOrder, pg8::NoHook, true>(lds, g, S, E, pg8::NoHook{});
        {
            pg8::Gemm gf{(const bf16*)(ws + WS_FA), (const bf16*)(ws + WS_FB), 4096, 1024, 256}; pg8::FoldOrder SF{G == 256 ? bx - 192 : bx};
            pg8::EpiFold EF{WOUT};
            pg8::gemm_phase<pg8::EpiFold, pg8::FoldOrder, pg8::NoHook, true>(lds, gf, SF, EF, pg8::NoHook{});
        }
        if (BOTH(3)) GRID_BAR();
    }
    if (IN(4)) {
        pool_phase(args, G, vcu);
        conv_phase(args, G, vcu);
        if (BOTH(4)) GRID_BAR();
    }
    if (IN(5)) {
        ssd_phase(lds, args, G, vcu);
        if (BOTH(5)) GRID_BAR();
    }
    if (IN(6)) {
        pg8::StaticOrder S; S.init(M, D, G, bx); pg8::Unit u0;
        LAS float* TAB = (LAS float*)(lds + TAB_OFF);
        if (S.next(0, u0)) {
            const int row = tid & 255, gg = tid >> 8; float s = 0.f;
            for (int k = 0; k < 32; ++k) s += PSS[(size_t)(gg * 32 + k) * M + u0.pm * 256 + row];
            TAB[512 + gg * 256 + row] = 1.0f / sqrtf(s * (1.0f / 512.0f) + EPS);
        }
        __syncthreads();
        if (tid < 256) { const float r0 = TAB[512 + tid], r1 = TAB[768 + tid]; TAB[tid] = r0 / r1; TAB[256 + tid] = r1; }
        __syncthreads();
        pg8::Gemm g{MIX, WOUT, M, D, MIXD};
        pg8::EpiResX<true, false> E{nullptr, XN, (const float*)(ws + WS_RS1), nullptr, nullptr, XN, (float*)(ws + WS_RS2), SS, (unsigned*)(ws + WS_CTL) + CW_PANEL + 1024, 1.0f, nullptr};
        pg8::ScaleHook HK{TAB, 8, 16};
        pg8::gemm_phase<pg8::EpiResX<true, false>, pg8::StaticOrder, pg8::ScaleHook, false>(lds, g, S, E, HK);
        if (BOTH(6)) GRID_BAR();
    }
    if (IN(7)) {
        pg8::Gemm g{XN, GU2, M, NGU, D}; pg8::StaticOrder S; S.init(M, NGU, G, bx);
        pg8::EpiSwiglu E{HID, nullptr};
        pg8::gemm_phase<pg8::EpiSwiglu, pg8::StaticOrder, pg8::NoHook, true>(lds, g, S, E, pg8::NoHook{});
        { const int first = ((M / 256) * (NGU / 256)) % G;
          if (bx >= first) p0_prologue<2>(args, lds, (bx - first) * NWAVES + wave, (G - first) * NWAVES, wave, lane); }
        if (BOTH(7)) GRID_BAR();
    }
    if (IN(8)) {
        pg8::Gemm g{HID, D2, M, D, FF}; pg8::StaticOrder S; S.init(M, D, G, bx);
        pg8::EpiResX<true, true> E{nullptr, XN, (const float*)(ws + WS_RS2), args.out, args.in[20], nullptr, nullptr, SS, (unsigned*)(ws + WS_CTL) + CW_PANEL + 2048, 0.5f, nullptr};
        pg8::gemm_phase<pg8::EpiResX<true, true>, pg8::StaticOrder, pg8::NoHook, false>(lds, g, S, E, pg8::NoHook{});
    }
#undef IN
#undef BOTH
}

extern "C" void kernel_launch(void* const* d_in, const int* in_sizes, int n_in, void* d_out, int out_size, void* d_ws, size_t ws_size, hipStream_t stream) {
    static int grid = 0;
    if (grid == 0) {
        if (n_in != 21 || in_sizes[0] != M * D || out_size != M * D || ws_size < WS_END) { fprintf(stderr, "kernel_launch: unexpected shapes (n_in %d, in0 %d, out %d, ws %zu)\n", n_in, n_in > 0 ? in_sizes[0] : -1, out_size, ws_size); grid = -1; return; }
        int dev = 0, cus = 0, per_cu = 0;
        if (hipGetDevice(&dev) != hipSuccess || hipDeviceGetAttribute(&cus, hipDeviceAttributeMultiprocessorCount, dev) != hipSuccess) { grid = -1; return; }
        if (hipFuncSetAttribute((const void*)hybrid_fwd, hipFuncAttributeMaxDynamicSharedMemorySize, LDS_BYTES) != hipSuccess) { fprintf(stderr, "kernel_launch: hipFuncSetAttribute failed\n"); grid = -1; return; }
        if (hipOccupancyMaxActiveBlocksPerMultiprocessor(&per_cu, (const void*)hybrid_fwd, NTHR, LDS_BYTES) != hipSuccess || per_cu < 1) { fprintf(stderr, "kernel_launch: occupancy query says %d\n", per_cu); per_cu = 1; }
        (void)hipGetLastError();
        grid = cus;
        if (grid != 256) fprintf(stderr, "kernel_launch: %d CUs; the single-unit GEMM phases expect 256\n", grid);
    }
    if (grid < 0) return;
    (void)hipMemsetAsync((char*)d_ws + WS_CTL, 0, CTL_ZERO_BYTES, stream);
    Args a{};
    for (int i = 0; i < 21; ++i) a.in[i] = (const float*)d_in[i];
    a.out = (float*)d_out; a.ws = (unsigned char*)d_ws;
#if MK_N_LAUNCHES == 1
    a.ph_lo = 0; a.ph_hi = N_PHASES;
    void* kargs[] = {&a};
    hipError_t e = hipLaunchCooperativeKernel((const void*)hybrid_fwd, dim3(grid), dim3(NTHR), kargs, LDS_BYTES, stream);
    if (e != hipSuccess) fprintf(stderr, "kernel_launch: cooperative launch failed: %s (grid %d)\n", hipGetErrorString(e), grid);
#else
    for (int p = 0; p < N_PHASES; ++p) { a.ph_lo = p; a.ph_hi = p + 1; hipLaunchKernelGGL(hybrid_fwd, dim3(grid), dim3(NTHR), LDS_BYTES, stream, a); }
#endif
}
```

```cpp
#include <hip/hip_runtime.h>
#include <hip/hip_cooperative_groups.h>
#include <cstdio>
#include <cstdint>
namespace cg = cooperative_groups;

#ifndef MK_N_LAUNCHES
#define MK_N_LAUNCHES 1
#endif
#ifndef MK_CG_SYNC
#define MK_CG_SYNC 0
#endif

#define LAS __attribute__((address_space(3)))
#define GAS __attribute__((address_space(1)))
typedef unsigned short bf16;
typedef short bf16x8 __attribute__((ext_vector_type(8)));
typedef float f32x4 __attribute__((ext_vector_type(4)));
typedef float f32x2 __attribute__((ext_vector_type(2)));
typedef unsigned u32x4 __attribute__((ext_vector_type(4)));
typedef unsigned u32x2 __attribute__((ext_vector_type(2)));

constexpr int M = 16384, SEQ = 2048, D = 1024, FF = 2816, NGU = 2 * FF, NIN = 3840, PROJ_LD = 3584, MIXD = 2048;
constexpr int Z_OFF = 0, XS_OFF = 1024, B_OFF = 2048, C_OFF = 2304, U_OFF = 2560;
constexpr int CONV_DIM = 1536;
constexpr float EPS = 1e-6f;
constexpr int NWAVES = 8, NTHR = 512;

constexpr size_t MiB = 1u << 20;
constexpr size_t WS_CTL = 0, CTL_ZERO_BYTES = 64 * 1024;
constexpr size_t WS_SS = 64 * 1024;
constexpr size_t WS_RS0 = 448 * 1024;
constexpr size_t WS_RS1 = 320 * 1024, WS_RS2 = 384 * 1024;
constexpr size_t WS_GU1 = 1 * MiB;
constexpr size_t WS_PSS = 1 * MiB;
constexpr size_t WS_D1 = 12 * MiB;
constexpr size_t WS_DT = 12 * MiB;
constexpr size_t WS_DTV = 13 * MiB;
constexpr size_t WS_CSV = 14 * MiB;
constexpr size_t WS_GU2 = WS_D1 + 5 * MiB + 512 * 1024;
constexpr size_t WS_D2 = WS_GU2 + 11 * MiB;
constexpr size_t WS_WIN = 34 * MiB;
constexpr size_t WS_WOUT = WS_WIN + 7 * MiB + 512 * 1024;
constexpr size_t WS_PROJ = 46 * MiB;
constexpr size_t WS_HID = 46 * MiB;
constexpr size_t WS_MIX = 158 * MiB;
constexpr size_t WS_FA = 158 * MiB;
constexpr size_t WS_FB = 160 * MiB;
constexpr size_t WS_XN = 222 * MiB;
constexpr size_t WS_BCG = 222 * MiB;
constexpr size_t WS_END = 254 * MiB;
constexpr int CW_BAR = 1024;
constexpr int CW_PANEL = 8192;

constexpr int RING_BYTES = 131072;
constexpr int TAB_OFF = RING_BYTES;
constexpr int MISC_OFF = TAB_OFF + 4096;
constexpr int LDS_BYTES = 147456;

__device__ __forceinline__ unsigned f2bf(float f) { unsigned u = __builtin_bit_cast(unsigned, f); return (u + 0x7fffu + ((u >> 16) & 1u)) >> 16; }
__device__ __forceinline__ unsigned cvt_pk_bf16(float lo, float hi) { unsigned r; asm volatile("v_cvt_pk_bf16_f32 %0, %1, %2" : "=v"(r) : "v"(lo), "v"(hi)); return r; }
__device__ __forceinline__ unsigned pk2(float lo, float hi) { return cvt_pk_bf16(lo, hi); }
typedef float f32x2_t __attribute__((ext_vector_type(2))); typedef __bf16 bf16x2_t __attribute__((ext_vector_type(2)));
__device__ __forceinline__ unsigned cvtpk_s(float lo, float hi) { f32x2_t v = {lo, hi}; bf16x2_t b = __builtin_convertvector(v, bf16x2_t); return __builtin_bit_cast(unsigned, b); }
__device__ __forceinline__ __amdgpu_buffer_rsrc_t wt_rsrc(void* base, unsigned bytes) { return __builtin_amdgcn_make_buffer_rsrc(base, 0, (int)bytes, 0x00020000); }
__device__ __forceinline__ void st16_wt(__amdgpu_buffer_rsrc_t rs, size_t off, u32x4 v) { __builtin_amdgcn_raw_buffer_store_b128(v, rs, (unsigned)off, 0, 16); }
__device__ __forceinline__ float bflo(unsigned u) { return __builtin_bit_cast(float, u << 16); }
__device__ __forceinline__ float bfhi(unsigned u) { return __builtin_bit_cast(float, u & 0xffff0000u); }
__device__ __forceinline__ float silu_f(float v) { return v * __builtin_amdgcn_rcpf(1.0f + __builtin_amdgcn_exp2f(-1.44269504f * v)); }
__device__ __forceinline__ float wave_sum(float v) {
#pragma unroll
    for (int o = 1; o < 64; o <<= 1) v += __shfl_xor(v, o);
    return v;
}
#define LDS_WAIT() asm volatile("s_waitcnt lgkmcnt(0)" ::: "memory")
#define VM_WAIT() asm volatile("s_waitcnt vmcnt(0)" ::: "memory")

namespace pg8 {
constexpr int BM = 256, BK = 64, HALF = 128, HTB = HALF * BK * 2, STAGE_BYTES = 8 * HTB, NXCD = 8, WGM = 4;
__host__ __device__ __forceinline__ int lds_byte(int r, int c) { const int st = (r >> 4) * 2 + (c >> 5), rr = r & 15, cc = c & 31, ob = rr * 64 + cc * 2; return st * 1024 + (ob ^ (((ob >> 9) & 1) << 5)); }
__host__ __device__ __forceinline__ void stage_rc(int b, int& R, int& C) { const int st = b / 1024, sb = b % 1024, swz = sb ^ (((sb >> 9) & 1) << 5); R = (st >> 1) * 16 + swz / 64; C = (st & 1) * 32 + (swz % 64) / 2; }
__host__ __device__ __forceinline__ int perm32(int rho) { const int n = rho >> 4, i = rho & 15; return 8 * (i >> 2) + 4 * n + (i & 3); }

struct Unit { int pm, pn; };
struct Gemm { const bf16* A; const bf16* Bt; int M, N, K; };

struct StaticOrder {
    int nM, nN, nwg, G, c;
    __host__ __device__ void init(int M_, int N_, int G_, int c_) { nM = M_ / BM; nN = N_ / BM; nwg = nM * nN; G = G_; c = c_; }
    __host__ __device__ bool next(int i, Unit& u) const {
        const long L = (long)i * G + c; if (L >= nwg) return false;
        int wgid = (int)L; { const int q = nwg / NXCD, r = nwg % NXCD, xcd = wgid % NXCD, off = wgid / NXCD; wgid = (xcd < r ? xcd * (q + 1) : r * (q + 1) + (xcd - r) * q) + off; }
        const int nig = WGM * nN, gid = wgid / nig, fm = gid * WGM, gsz = (nM - fm) < WGM ? (nM - fm) : WGM;
        u.pm = fm + ((wgid % nig) % gsz); u.pn = (wgid % nig) / gsz; return true;
    }
};

struct FoldOrder {
    int c;
    __host__ __device__ bool next(int i, Unit& u) const { const int idx = i * 64 + c; if (c < 0 || idx >= 16) return false; u.pm = idx; u.pn = idx >> 2; return true; }
};
struct NoHook { static constexpr bool ON = false; };
struct ScaleHook { static constexpr bool ON = true; const LAS float* F; int t0, t1; };

template <class Epi, class Sched, class Hook, bool ALIGN_EPI>
__device__ __forceinline__ void gemm_phase(LAS unsigned char* lds, const Gemm g, const Sched& S, const Epi& E, const Hook& HK) {
    const int tid = threadIdx.x, wid = __builtin_amdgcn_readfirstlane(tid >> 6), lane = tid & 63, wr = wid >> 2, wc = wid & 3, fr = lane & 15, fq = lane >> 4;
    const int K = g.K, nt = K / BK;
    unsigned voffA[2], voffB[2];
#pragma unroll
    for (int i = 0; i < 2; ++i) { int R, C; stage_rc(tid * 16 + i * 8192, R, C); const int Rb = (R & ~31) + perm32(R & 31);
        voffA[i] = (unsigned)(R * K + C) * 2u; voffB[i] = (unsigned)(Rb * K + C) * 2u; }
    const size_t kstep = (size_t)(BK * 2);
    const size_t hstep = (size_t)HALF * K * 2;
    const size_t tstep = 2 * hstep;
    const unsigned ldsw = (unsigned)wid * 1024u;
    const int aoff = lds_byte(wr * 64 + fr, fq * 8), boff = lds_byte(wc * 32 + fr, fq * 8);
#define PG8_SA(b, h) (((b) * 2 + (h)) * HTB)
#define PG8_SB(b, h) ((4 + (b) * 2 + (h)) * HTB)
#define PG8_STAGE(bufoff, gbase, voff) do { _Pragma("unroll") for (int _i = 0; _i < 2; ++_i) \
        __builtin_amdgcn_global_load_lds((const unsigned*)((const char*)(gbase) + (voff)[_i]), (LAS unsigned*)(lds + (bufoff) + ldsw + _i * 8192), 16, 0, 0); } while (0)
#define PG8_LDA(dst, b, h) do { _Pragma("unroll") for (int m = 0; m < 4; ++m) _Pragma("unroll") for (int k = 0; k < 2; ++k) dst[m][k] = *(const LAS bf16x8*)(lds + PG8_SA(b, h) + aoff + m * 2048 + k * 1024); } while (0)
#define PG8_LDB(dst, b, h) do { _Pragma("unroll") for (int n = 0; n < 2; ++n) _Pragma("unroll") for (int k = 0; k < 2; ++k) dst[n][k] = *(const LAS bf16x8*)(lds + PG8_SB(b, h) + boff + n * 2048 + k * 1024); } while (0)
#define PG8_MMA(ai, bj, At, Bt) do { __builtin_amdgcn_s_setprio(1); _Pragma("unroll") for (int m = 0; m < 4; ++m) _Pragma("unroll") for (int n = 0; n < 2; ++n) _Pragma("unroll") for (int k = 0; k < 2; ++k) \
        acc[ai][bj][m][n] = __builtin_amdgcn_mfma_f32_16x16x32_bf16(Bt[n][k], At[m][k], acc[ai][bj][m][n], 0, 0, 0); __builtin_amdgcn_s_setprio(0); } while (0)
#define PG8_WAIT_V(n) asm volatile("s_waitcnt vmcnt(" #n ")" ::: "memory")
#define PG8_WAIT_L(n) asm volatile("s_waitcnt lgkmcnt(" #n ")" ::: "memory")
#define PG8_BAR __builtin_amdgcn_s_barrier()
#define PG8_SCHED __builtin_amdgcn_sched_barrier(0)
    Unit cur, nxt; int ui = 0;
    if (!S.next(0, cur)) return;
    f32x4 acc[2][2][4][2];
#pragma unroll
    for (int a = 0; a < 2; ++a)
#pragma unroll
        for (int b = 0; b < 2; ++b)
#pragma unroll
            for (int m = 0; m < 4; ++m)
#pragma unroll
                for (int n = 0; n < 2; ++n) acc[a][b][m][n] = (f32x4){0.f, 0.f, 0.f, 0.f};
    bf16x8 At[4][2], B0[2][2], B1[2][2];
    const char* cA = (const char*)g.A + (size_t)cur.pm * tstep; const char* cB = (const char*)g.Bt + (size_t)cur.pn * tstep;
    PG8_STAGE(PG8_SB(0, 0), cB, voffB); PG8_STAGE(PG8_SB(0, 1), cB + hstep, voffB); PG8_STAGE(PG8_SA(0, 0), cA, voffA); PG8_STAGE(PG8_SA(0, 1), cA + hstep, voffA);
    if (wr == 1) PG8_BAR;
    PG8_WAIT_V(2); PG8_BAR;
    PG8_STAGE(PG8_SB(1, 0), cB + kstep, voffB); PG8_STAGE(PG8_SA(1, 0), cA + kstep, voffA); PG8_STAGE(PG8_SB(1, 1), cB + hstep + kstep, voffB);
    PG8_WAIT_V(6); PG8_BAR;
    for (;;) {
        const bool has_next = S.next(ui + 1, nxt);
        const char* nA = has_next ? (const char*)g.A + (size_t)nxt.pm * tstep : cA; const char* nB = has_next ? (const char*)g.Bt + (size_t)nxt.pn * tstep : cB;
        for (int t = 0; t < nt; t += 2) {
            const bool last = (t == nt - 2);
            const char* a1 = cA + (size_t)(t + 1) * kstep;
            const char* a2 = last ? nA : cA + (size_t)(t + 2) * kstep; const char* b2 = last ? nB : cB + (size_t)(t + 2) * kstep;
            const char* a3 = a2 + kstep; const char* b3 = b2 + kstep;
            if constexpr (Hook::ON) {
                if (t == HK.t0 || t == HK.t1) {
                    const LAS float* Fp = HK.F + (t == HK.t1 ? 256 : 0);
#pragma unroll
                    for (int ai = 0; ai < 2; ++ai)
#pragma unroll
                        for (int m = 0; m < 4; ++m) { const float f = Fp[ai * HALF + wr * 64 + m * 16 + fr];
#pragma unroll
                            for (int bj = 0; bj < 2; ++bj)
#pragma unroll
                                for (int n = 0; n < 2; ++n) acc[ai][bj][m][n] = acc[ai][bj][m][n] * f; }
                }
            }
            PG8_LDB(B0, 0, 0); PG8_LDB(B1, 0, 1); PG8_SCHED; PG8_LDA(At, 0, 0); PG8_STAGE(PG8_SA(1, 1), a1 + hstep, voffA);
            PG8_WAIT_V(8); PG8_WAIT_L(0); PG8_BAR; PG8_MMA(0, 0, At, B0); PG8_MMA(0, 1, At, B1); PG8_BAR; PG8_SCHED;
            PG8_LDA(At, 0, 1); PG8_STAGE(PG8_SB(0, 0), b2, voffB); PG8_STAGE(PG8_SB(0, 1), b2 + hstep, voffB); PG8_STAGE(PG8_SA(0, 0), a2, voffA);
            PG8_WAIT_V(8); PG8_WAIT_L(0); PG8_BAR; PG8_MMA(1, 0, At, B0); PG8_MMA(1, 1, At, B1); PG8_BAR; PG8_SCHED;
            PG8_LDB(B0, 1, 0); PG8_LDB(B1, 1, 1); PG8_SCHED; PG8_LDA(At, 1, 0); PG8_STAGE(PG8_SA(0, 1), a2 + hstep, voffA);
            PG8_WAIT_V(8); PG8_WAIT_L(0); PG8_BAR; PG8_MMA(0, 0, At, B0); PG8_MMA(0, 1, At, B1); PG8_BAR; PG8_SCHED;
            PG8_LDA(At, 1, 1); PG8_STAGE(PG8_SB(1, 0), b3, voffB); PG8_STAGE(PG8_SB(1, 1), b3 + hstep, voffB); PG8_STAGE(PG8_SA(1, 0), a3, voffA);
            PG8_WAIT_V(8); PG8_WAIT_L(0); PG8_BAR; PG8_MMA(1, 0, At, B0); PG8_MMA(1, 1, At, B1); PG8_BAR; PG8_SCHED;
        }
        if constexpr (ALIGN_EPI) { if (wr == 0) PG8_BAR; }
        if constexpr (!Epi::AFTER_DRAIN) { E(acc, cur, wr, wc, fr, fq); }
        if (!has_next) break;
#pragma unroll
        for (int a = 0; a < 2; ++a)
#pragma unroll
            for (int b = 0; b < 2; ++b)
#pragma unroll
                for (int m = 0; m < 4; ++m)
#pragma unroll
                    for (int n = 0; n < 2; ++n) acc[a][b][m][n] = (f32x4){0.f, 0.f, 0.f, 0.f};
        cur = nxt; cA = nA; cB = nB; ++ui;
        if constexpr (ALIGN_EPI) { if (wr == 1) PG8_BAR; }
    }
    PG8_WAIT_V(0);
    if constexpr (!ALIGN_EPI) { if (wr == 0) PG8_BAR; }
    PG8_BAR;
    if constexpr (Epi::AFTER_DRAIN) { E.fused(acc, cur, wr, wc, fr, fq, lds, wid, lane); }
#undef PG8_SA
#undef PG8_SB
#undef PG8_STAGE
#undef PG8_LDA
#undef PG8_LDB
#undef PG8_MMA
#undef PG8_WAIT_V
#undef PG8_WAIT_L
#undef PG8_BAR
#undef PG8_SCHED
}

__device__ __forceinline__ float row_rstd4(const float* ss, int row) {
    const float s = (ss[row] + ss[M + row]) + (ss[2 * M + row] + ss[3 * M + row]);
    return 1.0f / sqrtf(s * (1.0f / D) + EPS);
}

struct EpiSwiglu {
    static constexpr bool AFTER_DRAIN = false;
    bf16* H; const float* ss;
    __device__ __forceinline__ void operator()(const f32x4 (&acc)[2][2][4][2], const Unit& u, int wr, int wc, int fr, int fq) const {
        const int row0 = u.pm * BM + wr * 64 + fr, col0 = u.pn * HALF + wc * 32 + 8 * fq;
        const __amdgpu_buffer_rsrc_t hrs = wt_rsrc(H, (unsigned)((size_t)M * FF * 2));
        float r8[8];
#pragma unroll
        for (int gi = 0; gi < 8; ++gi) r8[gi] = ss ? row_rstd4(ss, row0 + (gi >> 2) * HALF + (gi & 3) * 16) : 1.0f;
#pragma unroll
        for (int ai = 0; ai < 2; ++ai)
#pragma unroll
            for (int m = 0; m < 4; ++m) { const int row = row0 + ai * HALF + m * 16;
                const float r = r8[ai * 4 + m];
                float h[8];
#pragma unroll
                for (int n = 0; n < 2; ++n)
#pragma unroll
                    for (int j = 0; j < 4; ++j) { const float gv = acc[ai][0][m][n][j] * r, uv = acc[ai][1][m][n][j] * r; h[4 * n + j] = silu_f(gv) * uv; }
                u32x4 w; w.x = cvt_pk_bf16(h[0], h[1]); w.y = cvt_pk_bf16(h[2], h[3]); w.z = cvt_pk_bf16(h[4], h[5]); w.w = cvt_pk_bf16(h[6], h[7]);
                st16_wt(hrs, ((size_t)row * FF + col0) * 2, w); }
    }
};
struct EpiProj {
    static constexpr bool AFTER_DRAIN = false;
    bf16* P; float* DT; const float* ss;
    __device__ __forceinline__ void operator()(const f32x4 (&acc)[2][2][4][2], const Unit& u, int wr, int wc, int fr, int fq) const {
        const int row0 = u.pm * BM + wr * 64 + fr;
        float r8[8];
#pragma unroll
        for (int gi = 0; gi < 8; ++gi) r8[gi] = ss ? row_rstd4(ss, row0 + (gi >> 2) * HALF + (gi & 3) * 16) : 1.0f;
        if (u.pn < 14) {
            const int col0 = u.pn * BM + wc * 32 + 8 * fq;
#pragma unroll
            for (int ai = 0; ai < 2; ++ai)
#pragma unroll
                for (int m = 0; m < 4; ++m) { const int row = row0 + ai * HALF + m * 16; const float r = r8[ai * 4 + m];
#pragma unroll
                    for (int bj = 0; bj < 2; ++bj) { const f32x4 v0 = acc[ai][bj][m][0] * r, v1 = acc[ai][bj][m][1] * r;
                        u32x4 w; w.x = cvtpk_s(v0[0], v0[1]); w.y = cvtpk_s(v0[2], v0[3]); w.z = cvtpk_s(v1[0], v1[1]); w.w = cvtpk_s(v1[2], v1[3]);
                        st16_wt(wt_rsrc(P, (unsigned)((size_t)M * PROJ_LD * 2)), ((size_t)row * PROJ_LD + col0 + bj * HALF) * 2, w); } }
        } else if (wc == 0 && fq < 2) {
#pragma unroll
            for (int ai = 0; ai < 2; ++ai)
#pragma unroll
                for (int m = 0; m < 4; ++m) { const int row = row0 + ai * HALF + m * 16; const float r = r8[ai * 4 + m];
                    *(f32x4*)(DT + (size_t)row * 16 + 8 * fq) = acc[ai][0][m][0] * r; *(f32x4*)(DT + (size_t)row * 16 + 8 * fq + 4) = acc[ai][0][m][1] * r; }
        }
    }
};
struct EpiFold {
    static constexpr bool AFTER_DRAIN = false;
    bf16* WO;
    __device__ __forceinline__ void operator()(const f32x4 (&acc)[2][2][4][2], const Unit& u, int wr, int wc, int fr, int fq) const {
        const int g = u.pm >> 2, n0 = (u.pm & 3) * BM + wr * 64 + fr, col0 = 1024 + 256 * g + wc * 32 + 8 * fq;
#pragma unroll
        for (int ai = 0; ai < 2; ++ai)
#pragma unroll
            for (int m = 0; m < 4; ++m) { const int n = n0 + ai * HALF + m * 16;
#pragma unroll
                for (int bj = 0; bj < 2; ++bj) { const f32x4 v0 = acc[ai][bj][m][0], v1 = acc[ai][bj][m][1];
                    u32x4 w; w.x = cvtpk_s(v0[0], v0[1]); w.y = cvtpk_s(v0[2], v0[3]); w.z = cvtpk_s(v1[0], v1[1]); w.w = cvtpk_s(v1[2], v1[3]);
                    *(u32x4*)(WO + (size_t)n * MIXD + col0 + bj * HALF) = w; } }
    }
};
struct EpiRes {
    static constexpr bool AFTER_DRAIN = true;
    const float* base; float* out; bf16* xn; float* ss; float scale;
    __device__ __forceinline__ void fused(const f32x4 (&acc)[2][2][4][2], const Unit& u, int wr, int wc, int fr, int fq, LAS unsigned char* lds, int wid, int lane) const {
        LAS float* Pt = (LAS float*)lds;
        const int row0 = u.pm * BM + wr * 64 + fr, col0 = u.pn * BM + wc * 32 + 8 * fq;
        f32x4 bq[3][4];
#pragma unroll
        for (int pg = 0; pg < 2; ++pg) { const size_t off = (size_t)(row0 + (pg >> 2) * HALF + (pg & 3) * 16) * D + col0;
#pragma unroll
          for (int bj = 0; bj < 2; ++bj) { bq[pg][2 * bj] = *(const f32x4*)(base + off + bj * HALF); bq[pg][2 * bj + 1] = *(const f32x4*)(base + off + bj * HALF + 4); } }
#pragma unroll
        for (int gi = 0; gi < 8; ++gi) { const int ai = gi >> 2, m = gi & 3;
            const int row = row0 + ai * HALF + m * 16; const size_t off = (size_t)row * D + col0; float q = 0.f;
            if (gi < 6) { const int ai2 = (gi + 2) >> 2, m2 = (gi + 2) & 3; const size_t off2 = (size_t)(row0 + ai2 * HALF + m2 * 16) * D + col0;
#pragma unroll
                for (int bj = 0; bj < 2; ++bj) { bq[(gi + 2) % 3][2 * bj] = *(const f32x4*)(base + off2 + bj * HALF); bq[(gi + 2) % 3][2 * bj + 1] = *(const f32x4*)(base + off2 + bj * HALF + 4); } }
            f32x4 bc[4];
#pragma unroll
            for (int k = 0; k < 4; ++k) bc[k] = bq[gi % 3][k];
#pragma unroll
            for (int bj = 0; bj < 2; ++bj) {
                const f32x4 v0 = bc[2 * bj] + acc[ai][bj][m][0] * scale, v1 = bc[2 * bj + 1] + acc[ai][bj][m][1] * scale;
                *(f32x4*)(out + off + bj * HALF) = v0; *(f32x4*)(out + off + bj * HALF + 4) = v1;
                if (xn) { u32x4 w; w.x = cvt_pk_bf16(v0[0], v0[1]); w.y = cvt_pk_bf16(v0[2], v0[3]); w.z = cvt_pk_bf16(v1[0], v1[1]); w.w = cvt_pk_bf16(v1[2], v1[3]);
                    *(u32x4*)(xn + off + bj * HALF) = w; }
                q += (v0[0] * v0[0] + v0[1] * v0[1]) + (v0[2] * v0[2] + v0[3] * v0[3]) + (v1[0] * v1[0] + v1[1] * v1[1]) + (v1[2] * v1[2] + v1[3] * v1[3]); }
            q += __shfl_xor(q, 16); q += __shfl_xor(q, 32);
            if (fq == 0) Pt[(ai * HALF + wr * 64 + m * 16 + fr) * 4 + wc] = q; }
        LDS_WAIT(); __builtin_amdgcn_s_barrier(); asm volatile("" ::: "memory");
        const int t = wid * 64 + lane;
        if (t < 256) { const float s = (Pt[t * 4 + 0] + Pt[t * 4 + 1]) + (Pt[t * 4 + 2] + Pt[t * 4 + 3]); ss[(size_t)u.pn * M + u.pm * BM + t] = s; }
    }
};
struct EpiResNorm {
    static constexpr bool AFTER_DRAIN = true;
    const float* base; float* out; const float* gain; bf16* xn; float* ss; unsigned* cnt; float scale;
    __device__ __forceinline__ void fused(f32x4 (&acc)[2][2][4][2], const Unit& u, int wr, int wc, int fr, int fq, LAS unsigned char* lds, int wid, int lane) const {
        LAS float* Pt = (LAS float*)lds;
        LAS float* Rt = (LAS float*)(lds + 4096);
        const int row0 = u.pm * BM + wr * 64 + fr, col0 = u.pn * BM + wc * 32 + 8 * fq;
        f32x4 bq[3][4];
#pragma unroll
        for (int pg = 0; pg < 2; ++pg) { const size_t off = (size_t)(row0 + (pg >> 2) * HALF + (pg & 3) * 16) * D + col0;
#pragma unroll
          for (int bj = 0; bj < 2; ++bj) { bq[pg][2 * bj] = *(const f32x4*)(base + off + bj * HALF); bq[pg][2 * bj + 1] = *(const f32x4*)(base + off + bj * HALF + 4); } }
#pragma unroll
        for (int gi = 0; gi < 8; ++gi) { const int ai = gi >> 2, m = gi & 3; float q = 0.f;
            if (gi < 6) { const int ai2 = (gi + 2) >> 2, m2 = (gi + 2) & 3; const size_t off2 = (size_t)(row0 + ai2 * HALF + m2 * 16) * D + col0;
#pragma unroll
                for (int bj = 0; bj < 2; ++bj) { bq[(gi + 2) % 3][2 * bj] = *(const f32x4*)(base + off2 + bj * HALF); bq[(gi + 2) % 3][2 * bj + 1] = *(const f32x4*)(base + off2 + bj * HALF + 4); } }
            f32x4 bc[4];
#pragma unroll
            for (int k = 0; k < 4; ++k) bc[k] = bq[gi % 3][k];
#pragma unroll
            for (int bj = 0; bj < 2; ++bj) {
                const f32x4 v0 = bc[2 * bj] + acc[ai][bj][m][0] * scale, v1 = bc[2 * bj + 1] + acc[ai][bj][m][1] * scale;
                acc[ai][bj][m][0] = v0; acc[ai][bj][m][1] = v1;
                if (xn) { const size_t offo = (size_t)(row0 + ai * HALF + m * 16) * D + col0 + bj * HALF; *(f32x4*)(out + offo) = v0; *(f32x4*)(out + offo + 4) = v1; }
                q += (v0[0] * v0[0] + v0[1] * v0[1]) + (v0[2] * v0[2] + v0[3] * v0[3]) + (v1[0] * v1[0] + v1[1] * v1[1]) + (v1[2] * v1[2] + v1[3] * v1[3]); }
            q += __shfl_xor(q, 16); q += __shfl_xor(q, 32);
            if (fq == 0) Pt[(ai * HALF + wr * 64 + m * 16 + fr) * 4 + wc] = q; }
        LDS_WAIT(); __builtin_amdgcn_s_barrier(); asm volatile("" ::: "memory");
        const int t = wid * 64 + lane;
        if (t < 256) { const float sp = (Pt[t * 4 + 0] + Pt[t * 4 + 1]) + (Pt[t * 4 + 2] + Pt[t * 4 + 3]);
            __hip_atomic_store(ss + (size_t)u.pn * M + u.pm * BM + t, sp, __ATOMIC_RELAXED, __HIP_MEMORY_SCOPE_AGENT); }
        asm volatile("s_waitcnt vmcnt(0)" ::: "memory");
        if (t < 256 && lane == 0) __hip_atomic_fetch_add(cnt + 16 * u.pm, 1u, __ATOMIC_RELAXED, __HIP_MEMORY_SCOPE_AGENT);
        if (wid == 0) {
            unsigned sp_ = 0;
            while ((unsigned)__builtin_amdgcn_readfirstlane(__hip_atomic_load(cnt + 16 * u.pm, __ATOMIC_RELAXED, __HIP_MEMORY_SCOPE_AGENT)) < 16u) { __builtin_amdgcn_s_sleep(1); if (++sp_ > (1u << 22)) break; }
            __builtin_amdgcn_fence(__ATOMIC_ACQUIRE, "agent");
        }
        asm volatile("s_waitcnt vmcnt(0) lgkmcnt(0)" ::: "memory"); __builtin_amdgcn_s_barrier(); asm volatile("" ::: "memory");
        if (t < 256) { float s4 = 0.f;
#pragma unroll
            for (int p = 0; p < 4; ++p) s4 += __hip_atomic_load(ss + (size_t)p * M + u.pm * BM + t, __ATOMIC_RELAXED, __HIP_MEMORY_SCOPE_AGENT);
            Rt[t] = 1.0f / sqrtf(s4 * (1.0f / D) + EPS); }
        f32x4 gv[4];
#pragma unroll
        for (int k = 0; k < 4; ++k) gv[k] = (f32x4){1.f, 1.f, 1.f, 1.f};
        if (!xn) {
#pragma unroll
            for (int bj = 0; bj < 2; ++bj) { gv[2 * bj] = *(const f32x4*)(gain + col0 + bj * HALF); gv[2 * bj + 1] = *(const f32x4*)(gain + col0 + bj * HALF + 4); } }
        LDS_WAIT(); __builtin_amdgcn_s_barrier(); asm volatile("" ::: "memory");
#pragma unroll
        for (int gi = 0; gi < 8; ++gi) { const int ai = gi >> 2, m = gi & 3; const int rl = ai * HALF + wr * 64 + m * 16 + fr; const float r = Rt[rl];
            const size_t off = (size_t)(u.pm * BM + rl) * D + col0;
#pragma unroll
            for (int bj = 0; bj < 2; ++bj) { const f32x4 o0 = acc[ai][bj][m][0] * r * gv[2 * bj], o1 = acc[ai][bj][m][1] * r * gv[2 * bj + 1];
                if (xn) { u32x4 w; w.x = cvt_pk_bf16(o0[0], o0[1]); w.y = cvt_pk_bf16(o0[2], o0[3]); w.z = cvt_pk_bf16(o1[0], o1[1]); w.w = cvt_pk_bf16(o1[2], o1[3]); *(u32x4*)(xn + off + bj * HALF) = w; }
                else { *(f32x4*)(out + off + bj * HALF) = o0; *(f32x4*)(out + off + bj * HALF + 4) = o1; } } }
    }
};
template <bool BASE_BF16, bool FINAL>
struct EpiResX {
    static constexpr bool AFTER_DRAIN = true;
    const float* base; const bf16* bbn; const float* brs; float* out; const float* gain; bf16* xn; float* rs_out; float* ss; unsigned* cnt; float scale; const float* cgain;
    __device__ __forceinline__ void fused(f32x4 (&acc)[2][2][4][2], const Unit& u, int wr, int wc, int fr, int fq, LAS unsigned char* lds, int wid, int lane) const {
        LAS float* Pt = (LAS float*)lds;
        LAS float* Rt = (LAS float*)(lds + 4096);
        const int row0 = u.pm * BM + wr * 64 + fr, col0 = u.pn * BM + wc * 32 + 8 * fq;
        float inv8[8];
#pragma unroll
        for (int gi = 0; gi < 8; ++gi) inv8[gi] = BASE_BF16 ? brs[row0 + (gi >> 2) * HALF + (gi & 3) * 16] : 1.0f;
        f32x4 ci[4];
#pragma unroll
        for (int k = 0; k < 4; ++k) ci[k] = (f32x4){1.f, 1.f, 1.f, 1.f};
        if (BASE_BF16 && cgain) {
#pragma unroll
            for (int k = 0; k < 4; ++k) { const f32x4 gq = *(const f32x4*)(cgain + col0 + (k >> 1) * HALF + (k & 1) * 4); ci[k] = (f32x4){1.0f / gq[0], 1.0f / gq[1], 1.0f / gq[2], 1.0f / gq[3]}; } }
        f32x4 bq[3][4]; u32x4 bqb[3][2];
#define ERX_LOAD(slot, g_) do { const size_t off_ = (size_t)(row0 + ((g_) >> 2) * HALF + ((g_) & 3) * 16) * D + col0; \
            if constexpr (BASE_BF16) { bqb[slot][0] = *(const u32x4*)(bbn + off_); bqb[slot][1] = *(const u32x4*)(bbn + off_ + HALF); } \
            else { _Pragma("unroll") for (int bj_ = 0; bj_ < 2; ++bj_) { bq[slot][2 * bj_] = *(const f32x4*)(base + off_ + bj_ * HALF); bq[slot][2 * bj_ + 1] = *(const f32x4*)(base + off_ + bj_ * HALF + 4); } } } while (0)
        ERX_LOAD(0, 0); ERX_LOAD(1, 1);
#pragma unroll
        for (int gi = 0; gi < 8; ++gi) { const int ai = gi >> 2, m = gi & 3; float q = 0.f;
            if (gi < 6) ERX_LOAD((gi + 2) % 3, gi + 2);
            f32x4 bc[4];
            if constexpr (BASE_BF16) { const float iv = inv8[gi];
#pragma unroll
                for (int bj = 0; bj < 2; ++bj) { const u32x4 w = bqb[gi % 3][bj];
                    bc[2 * bj] = (f32x4){bflo(w.x), bfhi(w.x), bflo(w.y), bfhi(w.y)} * iv * ci[2 * bj]; bc[2 * bj + 1] = (f32x4){bflo(w.z), bfhi(w.z), bflo(w.w), bfhi(w.w)} * iv * ci[2 * bj + 1]; }
            } else {
#pragma unroll
                for (int k = 0; k < 4; ++k) bc[k] = bq[gi % 3][k]; }
#pragma unroll
            for (int bj = 0; bj < 2; ++bj) {
                const f32x4 v0 = bc[2 * bj] + acc[ai][bj][m][0] * scale, v1 = bc[2 * bj + 1] + acc[ai][bj][m][1] * scale;
                acc[ai][bj][m][0] = v0; acc[ai][bj][m][1] = v1;
                q += (v0[0] * v0[0] + v0[1] * v0[1]) + (v0[2] * v0[2] + v0[3] * v0[3]) + (v1[0] * v1[0] + v1[1] * v1[1]) + (v1[2] * v1[2] + v1[3] * v1[3]); }
            q += __shfl_xor(q, 16); q += __shfl_xor(q, 32);
            if (fq == 0) Pt[(ai * HALF + wr * 64 + m * 16 + fr) * 4 + wc] = q; }
#undef ERX_LOAD
        LDS_WAIT(); __builtin_amdgcn_s_barrier(); asm volatile("" ::: "memory");
        const int t = wid * 64 + lane;
        if (t < 256) { const float sp = (Pt[t * 4 + 0] + Pt[t * 4 + 1]) + (Pt[t * 4 + 2] + Pt[t * 4 + 3]);
            __hip_atomic_store(ss + (size_t)u.pn * M + u.pm * BM + t, sp, __ATOMIC_RELAXED, __HIP_MEMORY_SCOPE_AGENT); }
        asm volatile("s_waitcnt vmcnt(0)" ::: "memory");
        if (t < 256 && lane == 0) __hip_atomic_fetch_add(cnt + 16 * u.pm, 1u, __ATOMIC_RELAXED, __HIP_MEMORY_SCOPE_AGENT);
        if (wid == 0) {
            unsigned sp_ = 0;
            while ((unsigned)__builtin_amdgcn_readfirstlane(__hip_atomic_load(cnt + 16 * u.pm, __ATOMIC_RELAXED, __HIP_MEMORY_SCOPE_AGENT)) < 16u) { __builtin_amdgcn_s_sleep(1); if (++sp_ > (1u << 22)) break; }
            __builtin_amdgcn_fence(__ATOMIC_ACQUIRE, "agent");
        }
        asm volatile("s_waitcnt vmcnt(0) lgkmcnt(0)" ::: "memory"); __builtin_amdgcn_s_barrier(); asm volatile("" ::: "memory");
        if (t < 256) { float s4 = 0.f;
#pragma unroll
            for (int p = 0; p < 4; ++p) s4 += __hip_atomic_load(ss + (size_t)p * M + u.pm * BM + t, __ATOMIC_RELAXED, __HIP_MEMORY_SCOPE_AGENT);
            const float ms = s4 * (1.0f / D) + EPS, sq = sqrtf(ms);
            Rt[t] = 1.0f / sq;
            if (!FINAL && u.pn == 0) rs_out[u.pm * BM + t] = sq; }
        f32x4 gv[4];
#pragma unroll
        for (int k = 0; k < 4; ++k) gv[k] = (f32x4){1.f, 1.f, 1.f, 1.f};
        if constexpr (FINAL) {
#pragma unroll
            for (int bj = 0; bj < 2; ++bj) { gv[2 * bj] = *(const f32x4*)(gain + col0 + bj * HALF); gv[2 * bj + 1] = *(const f32x4*)(gain + col0 + bj * HALF + 4); } }
        LDS_WAIT(); __builtin_amdgcn_s_barrier(); asm volatile("" ::: "memory");
#pragma unroll
        for (int gi = 0; gi < 8; ++gi) { const int ai = gi >> 2, m = gi & 3; const int rl = ai * HALF + wr * 64 + m * 16 + fr; const float r = Rt[rl];
            const size_t off = (size_t)(u.pm * BM + rl) * D + col0;
#pragma unroll
            for (int bj = 0; bj < 2; ++bj) { const f32x4 o0 = acc[ai][bj][m][0] * r * gv[2 * bj], o1 = acc[ai][bj][m][1] * r * gv[2 * bj + 1];
                if constexpr (!FINAL) { u32x4 w; w.x = cvt_pk_bf16(o0[0], o0[1]); w.y = cvt_pk_bf16(o0[2], o0[3]); w.z = cvt_pk_bf16(o1[0], o1[1]); w.w = cvt_pk_bf16(o1[2], o1[3]); st16_wt(wt_rsrc(xn, (unsigned)((size_t)M * D * 2)), (off + bj * HALF) * 2, w); }
                else { *(f32x4*)(out + off + bj * HALF) = o0; *(f32x4*)(out + off + bj * HALF + 4) = o1; } } }
    }
};
}

#define XB_TMO      128
#define XB_XCNT(j)  (256  + 64 * (j))
#define XB_XSUB(j)  (1280 + 64 * (j))
#define XB_XGEN(j)  (2304 + 64 * (j))
#define XB_TOP      3328
#define XB_TOPGEN   3392
#define XCD_BAR_WORDS 3456
#define XB_SPIN_CAP (1u << 18)
__device__ __forceinline__ unsigned xb_ld(unsigned* p)              { return __hip_atomic_load(p, __ATOMIC_RELAXED, __HIP_MEMORY_SCOPE_AGENT); }
__device__ __forceinline__ unsigned xb_add(unsigned* p, unsigned v) { return __hip_atomic_fetch_add(p, v, __ATOMIC_RELAXED, __HIP_MEMORY_SCOPE_AGENT); }
__device__ __forceinline__ unsigned xb_xcc_id() { return (unsigned)__builtin_amdgcn_s_getreg((3 << 11) | 20) & 0xFu; }
#define XB_SPIN(cond, bar) do { unsigned _sp = 0; while (cond) { __builtin_amdgcn_s_sleep(1); \
    if ((++_sp & 255u) == 0u) { if (xb_ld(&(bar)[XB_TMO])) break; if (_sp > XB_SPIN_CAP) { atomicAdd(&(bar)[XB_TMO], 1u); break; } } } } while (0)
struct XcdBarrier { unsigned* bar; unsigned x; volatile LAS unsigned* st; };
__device__ __forceinline__ XcdBarrier xcd_barrier_post(unsigned* bar, volatile LAS unsigned* st) {
    XcdBarrier b; b.bar = bar; b.x = xb_xcc_id(); b.st = st;
    if (threadIdx.x == 0) (void)xb_add(&bar[XB_XCNT(b.x)], 1u);
    return b;
}
__device__ __forceinline__ void xcd_barrier_complete(unsigned* bar, unsigned x, unsigned& nloc, unsigned& nx) {
    const unsigned G = gridDim.x * gridDim.y * gridDim.z;
    unsigned sum, cnt, mine, sp = 0u;
    for (;;) {
        sum = 0u; cnt = 0u; mine = 0u;
#pragma unroll
        for (unsigned j = 0; j < 16; ++j) { const unsigned c = xb_ld(&bar[XB_XCNT(j)]); sum += c; cnt += (c > 0u) ? 1u : 0u; mine = (j == x) ? c : mine; }
        if (sum == G) break;
        __builtin_amdgcn_s_sleep(1);
        if ((++sp & 255u) == 0u) { if (xb_ld(&bar[XB_TMO])) break; if (sp > XB_SPIN_CAP) { atomicAdd(&bar[XB_TMO], 1u); break; } }
    }
    nloc = mine > 0u ? mine : 1u; nx = cnt > 0u ? cnt : 1u;
}
__device__ __forceinline__ void xcd_barrier(const XcdBarrier& b) {
    asm volatile("s_waitcnt vmcnt(0)" ::: "memory");
    __syncthreads();
    if (threadIdx.x == 0) {
        unsigned* bar = b.bar;
        __builtin_amdgcn_s_waitcnt(0);
        unsigned nloc = b.st[0], nx = b.st[1];
        if (nloc == 0u) { xcd_barrier_complete(bar, b.x, nloc, nx); b.st[0] = nloc; b.st[1] = nx; }
        const unsigned old = xb_add(&bar[XB_XSUB(b.x)], 1u);
        const unsigned gen = old / nloc;
        if (old + 1u == (gen + 1u) * nloc) {
            __builtin_amdgcn_fence(__ATOMIC_RELEASE, "agent");
            asm volatile("s_waitcnt vmcnt(0)" ::: "memory");
            const unsigned og = xb_add(&bar[XB_TOP], 1u);
            const unsigned tg = og / nx;
            if (og + 1u == (tg + 1u) * nx) xb_add(&bar[XB_TOPGEN], 1u);
            else XB_SPIN(xb_ld(&bar[XB_TOPGEN]) == tg, bar);
            __builtin_amdgcn_fence(__ATOMIC_ACQUIRE, "agent");
            xb_add(&bar[XB_XGEN(b.x)], 1u);
            asm volatile("s_waitcnt vmcnt(0)" ::: "memory");
        } else {
            XB_SPIN(xb_ld(&bar[XB_XGEN(b.x)]) == gen, bar);
            __builtin_amdgcn_fence(__ATOMIC_ACQUIRE, "agent");
            asm volatile("s_waitcnt vmcnt(0)" ::: "memory");
        }
    }
    __syncthreads();
}

__device__ __forceinline__ void p0_transpose_item(const float* W, int ldw, int k0, int nsrc0, int nvalid, const float* kscale, bf16* WT, int ldk, int ndst0, LAS float* scr, int lane) {
    const int n4 = (lane & 7) * 4;
    const int n4c = n4 < nvalid ? n4 : 0;
    f32x4 tv[8]; float ksv[8];
#pragma unroll
    for (int i = 0; i < 8; ++i) { const int kk = 8 * i + (lane >> 3); tv[i] = __builtin_nontemporal_load((const f32x4*)(W + (size_t)(k0 + kk) * ldw + nsrc0 + n4c)); }
    if (kscale) {
#pragma unroll
        for (int i = 0; i < 8; ++i) ksv[i] = kscale[k0 + 8 * i + (lane >> 3)];
#pragma unroll
        for (int i = 0; i < 8; ++i) tv[i] = tv[i] * ksv[i]; }
#pragma unroll
    for (int i = 0; i < 8; ++i) { const int kk = 8 * i + (lane >> 3);
        scr[kk * 33 + n4] = tv[i].x; scr[kk * 33 + n4 + 1] = tv[i].y; scr[kk * 33 + n4 + 2] = tv[i].z; scr[kk * 33 + n4 + 3] = tv[i].w; }
    LDS_WAIT(); asm volatile("" ::: "memory");
    const int c = lane & 7;
#pragma unroll
    for (int j = 0; j < 4; ++j) { const int n = (lane >> 3) + 8 * j; const LAS float* s = scr + (8 * c) * 33 + n;
        u32x4 o; o.x = pk2(s[0 * 33], s[1 * 33]); o.y = pk2(s[2 * 33], s[3 * 33]); o.z = pk2(s[4 * 33], s[5 * 33]); o.w = pk2(s[6 * 33], s[7 * 33]);
        if (n < nvalid) *(u32x4*)(WT + (size_t)(ndst0 + n) * ldk + k0 + 8 * c) = o; }
    LDS_WAIT(); asm volatile("" ::: "memory");
}

struct Args { const float* in[21]; float* out; unsigned char* ws; int ph_lo, ph_hi; };

template <int PART>
__device__ __forceinline__ void p0_prologue(const Args& a, LAS unsigned char* lds, int gw, int NGW, int wave, int lane) {
    LAS float* scr = (LAS float*)(lds + wave * 16384);
    unsigned char* ws = a.ws;
    bf16 *GU1 = (bf16*)(ws + WS_GU1), *D1 = (bf16*)(ws + WS_D1), *GU2 = (bf16*)(ws + WS_GU2), *D2 = (bf16*)(ws + WS_D2), *WIN = (bf16*)(ws + WS_WIN), *WOUT = (bf16*)(ws + WS_WOUT), *XN = (bf16*)(ws + WS_XN);
    if constexpr (PART == 0) {
        const float* gain = a.in[1];
        f32x4 gv[4];
#pragma unroll
        for (int j = 0; j < 4; ++j) gv[j] = *((const f32x4*)gain + lane + 64 * j);
        for (int m = gw; m < M; m += 4 * NGW) {
            f32x4 v[4][4];
#pragma unroll
            for (int q = 0; q < 4; ++q) { const int mm = m + q * NGW; const f32x4* xr = (const f32x4*)(a.in[0] + (size_t)(mm < M ? mm : m) * D) + lane;
#pragma unroll
                for (int j = 0; j < 4; ++j) v[q][j] = __builtin_nontemporal_load(xr + 64 * j); }
#pragma unroll
            for (int q = 0; q < 4; ++q) { const int mm = m + q * NGW; float s = 0.f;
#pragma unroll
                for (int j = 0; j < 4; ++j) s += (v[q][j].x * v[q][j].x + v[q][j].y * v[q][j].y) + (v[q][j].z * v[q][j].z + v[q][j].w * v[q][j].w);
                const float sq0 = sqrtf(wave_sum(s) * (1.0f / D) + EPS), r = 1.0f / sq0;
                if (mm < M && lane == 0) ((float*)(ws + WS_RS0))[mm] = sq0;
                if (mm < M) { u32x2* o8 = (u32x2*)(XN + (size_t)mm * D) + lane;
#pragma unroll
                    for (int j = 0; j < 4; ++j) { u32x2 w; w.x = pk2(v[q][j].x * r * gv[j].x, v[q][j].y * r * gv[j].y); w.y = pk2(v[q][j].z * r * gv[j].z, v[q][j].w * r * gv[j].w); o8[64 * j] = w; } } }
        }
    }
    constexpr int I_GU = 16 * 88, I_DN = 44 * 32, I_IN = 16 * 113, I_OUT = 16 * 32;
    if constexpr (PART == 0) {
    for (int it = gw; it < 4 * I_GU; it += NGW) {
        int r = it; const int which = r / I_GU; r -= which * I_GU; const int kb = r / 88, nb = r % 88, j0 = 32 * nb;
        const float* W = a.in[which == 0 ? 2 : which == 1 ? 3 : which == 2 ? 17 : 18];
        const float* ks = which >= 2 ? a.in[16] : nullptr;
        bf16* WT = which >= 2 ? GU2 : GU1;
        p0_transpose_item(W, FF, 64 * kb, j0, 32, ks, WT, D, 256 * (j0 >> 7) + (j0 & 127) + 128 * (which & 1), scr, lane); }
    }
    if constexpr (PART == 1 || PART == 2) {
    for (int it = gw; it < I_DN; it += NGW) { const int kb = it / 32, nb = it % 32;
        p0_transpose_item(a.in[PART == 2 ? 19 : 4], D, 64 * kb, 32 * nb, 32, nullptr, PART == 2 ? D2 : D1, FF, 32 * nb, scr, lane); }
    }
    if constexpr (PART == 1) {
    for (int it = gw; it < I_IN + I_OUT; it += NGW) {
        int r = it;
        if (r < I_IN) { const int kb = r / 113, db = r % 113;
            const int nd = 32 * db, nsrc = db < 80 ? nd : (db < 112 ? nd + 16 : 2560), nv = db < 112 ? 32 : 16;
            p0_transpose_item(a.in[6], 3600, 64 * kb, nsrc, nv, a.in[5], WIN, D, nd, scr, lane); continue; }
        r -= I_IN;
        { const int kb = r / 32, nb = r % 32;
            p0_transpose_item(a.in[15], D, 64 * kb, 32 * nb, 32, a.in[12], WOUT, MIXD, 32 * nb, scr, lane); }
    }
    for (int it = gw; it < 16 * 32; it += NGW) { const int kb = it / 32, nb = it % 32;
        p0_transpose_item(a.in[15] + (size_t)1024 * D, D, 64 * kb, 32 * nb, 32, nullptr, (bf16*)(ws + WS_FA) + (size_t)(kb >> 2) * 1024 * 256 - (size_t)(kb >> 2) * 256, 256, 32 * nb, scr, lane); }
    { bf16* FB = (bf16*)(ws + WS_FB);
      for (int i = gw * 64 + lane; i < 4 * 256 * 256 / 4; i += NGW * 64) { const int e0 = 4 * i, g = e0 >> 16, d = e0 & 255;
          const f32x4 w = *(const f32x4*)(a.in[13] + e0), sc = *(const f32x4*)(a.in[14] + 256 * g + d);
          *(u32x2*)(FB + e0) = (u32x2){pk2(w.x * sc.x, w.y * sc.y), pk2(w.z * sc.z, w.w * sc.w)}; } }
    }
}

constexpr int SB_CC = 0, SB_BC = 17408, SB_XT = 34816, SB_XD = 39424, SB_VEC = 44032, SB_STRIDE = 45056;
constexpr int SL_MM = 90112, SL_SL = 99328, SL_END = 108032;
constexpr int P272 = 272, P144 = 144;
typedef short v4i16_t __attribute__((ext_vector_type(4)));

__device__ __forceinline__ void unpack8(const u32x4 r, float (&f)[8]) { f[0] = bflo(r.x); f[1] = bfhi(r.x); f[2] = bflo(r.y); f[3] = bfhi(r.y); f[4] = bflo(r.z); f[5] = bfhi(r.z); f[6] = bflo(r.w); f[7] = bfhi(r.w); }

__device__ __forceinline__ void conv8x4(const bf16* PROJ, size_t tok0, int tseq, int col, const float* conv_w, const float* conv_b, bf16* dst, int pitch) {
    float wbc[4][8], bbc[8];
#pragma unroll
    for (int k = 0; k < 4; ++k) { const f32x4 w0 = *(const f32x4*)(conv_w + k * CONV_DIM + col - 1024), w1 = *(const f32x4*)(conv_w + k * CONV_DIM + col - 1024 + 4);
#pragma unroll
        for (int e = 0; e < 4; ++e) { wbc[k][e] = w0[e]; wbc[k][4 + e] = w1[e]; } }
    { const f32x4 w0 = *(const f32x4*)(conv_b + col - 1024), w1 = *(const f32x4*)(conv_b + col - 1024 + 4);
#pragma unroll
        for (int e = 0; e < 4; ++e) { bbc[e] = w0[e]; bbc[4 + e] = w1[e]; } }
    u32x4 rbc[7];
#pragma unroll
    for (int i = 0; i < 7; ++i) { rbc[i] = (u32x4){0u, 0u, 0u, 0u}; if (tseq - 3 + i >= 0) rbc[i] = *(const u32x4*)(PROJ + (tok0 + tseq - 3 + i) * PROJ_LD + col); }
    float ob[4][8];
#pragma unroll
    for (int j = 0; j < 4; ++j)
#pragma unroll
        for (int e = 0; e < 8; ++e) ob[j][e] = bbc[e];
#pragma unroll
    for (int i = 0; i < 7; ++i) { float f[8]; unpack8(rbc[i], f);
#pragma unroll
        for (int j = 0; j < 4; ++j) { const int k = i - j; if (k >= 0 && k < 4) {
#pragma unroll
            for (int e = 0; e < 8; ++e) ob[j][e] += wbc[k][e] * f[e]; } } }
#pragma unroll
    for (int j = 0; j < 4; ++j) {
#pragma unroll
        for (int e = 0; e < 8; ++e) ob[j][e] = silu_f(ob[j][e]);
        u32x4 w; w.x = cvt_pk_bf16(ob[j][0], ob[j][1]); w.y = cvt_pk_bf16(ob[j][2], ob[j][3]); w.z = cvt_pk_bf16(ob[j][4], ob[j][5]); w.w = cvt_pk_bf16(ob[j][6], ob[j][7]);
        *(u32x4*)(dst + (size_t)j * pitch) = w; }
}

__device__ __forceinline__ void conv_phase(const Args& a, int G, int vc) {
    const int tid = threadIdx.x, lane = tid & 63, wave = __builtin_amdgcn_readfirstlane(tid >> 6);
    const bf16* PROJ = (const bf16*)(a.ws + WS_PROJ);
    bf16* BCG = (bf16*)a.out;
    bf16* MIX = (bf16*)(a.ws + WS_MIX);
    const float* DT = (const float*)(a.ws + WS_DT);
    float* DTV = (float*)(a.ws + WS_DTV); float* CSV = (float*)(a.ws + WS_CSV);
    const float* conv_w = a.in[7]; const float* conv_b = a.in[8];
    for (int uu = 2 * vc; uu < 512; uu += 2 * G)
    for (int unit = uu; unit < uu + 2; ++unit) {
        const int b = unit >> 6, c = (unit >> 1) & 31, g = unit & 1;
        const size_t tok0 = (size_t)b * SEQ;
        { const int cg = tid & 31, tl = tid >> 5;
          conv8x4(PROJ, tok0, c * 64 + 4 * tl, B_OFF + (cg >> 4) * 256 + g * 128 + 8 * (cg & 15), conv_w, conv_b, BCG + (size_t)unit * 16384 + (4 * tl) * 256 + 8 * cg, 256); }
#pragma unroll 1
        for (int pass = 0; pass < 2; ++pass) { const int cgx = tid & 63, tlx = (tid >> 6) + 8 * pass; const int ch = g * 512 + 8 * cgx;
          conv8x4(PROJ, tok0, c * 64 + 4 * tlx, XS_OFF + ch, conv_w, conv_b, MIX + (tok0 + c * 64 + 4 * tlx) * MIXD + ch, MIXD); }
        { const int h = 8 * g + wave; const size_t tok = tok0 + c * 64 + lane;
          const float xdt = DT[tok * 16 + h] + a.in[9][h];
          const float dtv = xdt > 20.f ? xdt : log1pf(expf(xdt));
          float cs = dtv * (-expf(a.in[10][h]));
#pragma unroll
          for (int o = 1; o < 64; o <<= 1) { const float t = __shfl_up(cs, o); if (lane >= o) cs += t; }
          const size_t tix_ = ((size_t)(b * 32 + c) * 16 + h) * 64 + lane;
          DTV[tix_] = dtv; CSV[tix_] = cs; }
    }
}

__device__ __forceinline__ void ssd_phase(LAS unsigned char* lds, const Args& a, int G, int vc) {
    const int tid = threadIdx.x, lane = tid & 63, wave = __builtin_amdgcn_readfirstlane(tid >> 6);
    const int l16 = lane & 15, quad = lane >> 4;
    const bf16* PROJ = (const bf16*)(a.ws + WS_PROJ);
    const bf16* BCG = (const bf16*)a.out;
    const float* DTV = (const float*)(a.ws + WS_DTV); const float* CSV = (const float*)(a.ws + WS_CSV);
    bf16* MIX = (bf16*)(a.ws + WS_MIX);
    float* PSS = (float*)(a.ws + WS_PSS);
    for (int item = vc; item < 256; item += G) {
        const int b = item >> 5, h = (item >> 1) & 15, ph = item & 1, g = h >> 3;
        const float Dh = a.in[11][h];
        const int xtok = tid >> 3, xc4 = tid & 7;
        const int x_ch = h * 64 + ph * 32 + 4 * xc4;
        f32x4 accS[2]; accS[0] = (f32x4){0.f, 0.f, 0.f, 0.f}; accS[1] = accS[0];
        for (int i = tid; i < (SL_END - SL_SL) / 4; i += NTHR) ((LAS unsigned*)(lds + SL_SL))[i] = 0u;
        const size_t tok0 = (size_t)b * SEQ;
        const int ti = wave >> 1, q = wave & 1;
        const int pcol = h * 64 + ph * 32 + 16 * q + 4 * quad;
        u32x4 rbA[2][4]; u32x2 xrA[2]; float dtvA[2], csA[2]; u32x2 zrA[2];
#define SSD_LOAD_RAW(c, S) do { const bf16* ub = BCG + ((size_t)(b * 32 + (c)) * 2 + g) * 16384; \
            _Pragma("unroll") for (int k = 0; k < 4; ++k) rbA[S][k] = *(const u32x4*)(ub + (size_t)(tid + 512 * k) * 8); \
            xrA[S] = *(const u32x2*)(MIX + (tok0 + (size_t)(c) * 64 + xtok) * MIXD + x_ch); \
            dtvA[S] = DTV[((size_t)(b * 32 + (c)) * 16 + h) * 64 + lane]; csA[S] = CSV[((size_t)(b * 32 + (c)) * 16 + h) * 64 + lane]; \
            zrA[S] = *(const u32x2*)(PROJ + (tok0 + (size_t)(c) * 64 + 16 * ti + l16) * PROJ_LD + Z_OFF + pcol); } while (0)
        SSD_LOAD_RAW(0, 0); SSD_LOAD_RAW(1, 1);
#pragma unroll 2
        for (int c = 0; c < 32; ++c) {
            const int S = c & 1;
            const float dtv = dtvA[S], cs = csA[S]; const u32x2 xr = xrA[S];
            LAS unsigned char* sb = lds + (c & 1) * SB_STRIDE;
            const float cs63 = __shfl(cs, 63);
#pragma unroll
            for (int k = 0; k < 4; ++k) { const int pp = tid + 512 * k, row = pp >> 5, c16 = pp & 31;
                *(LAS u32x4*)(sb + (c16 < 16 ? SB_BC : SB_CC) + row * P272 + 16 * (c16 & 15)) = rbA[S][k]; }
            {
                const float sd = __shfl(dtv, xtok & 63) * __expf(cs63 - __shfl(cs, xtok & 63));
                const float f[4] = {bflo(xr.x), bfhi(xr.x), bflo(xr.y), bfhi(xr.y)};
                const unsigned xb[4] = {xr.x & 0xffffu, xr.x >> 16, xr.y & 0xffffu, xr.y >> 16};
#pragma unroll
                for (int e = 0; e < 4; ++e) {
                    *(LAS unsigned short*)(sb + SB_XT + (4 * xc4 + e) * P144 + 2 * xtok) = (unsigned short)xb[e];
                    *(LAS unsigned short*)(sb + SB_XD + (4 * xc4 + e) * P144 + 2 * xtok) = (unsigned short)f2bf(f[e] * sd); }
            }
            if (wave == 0) { ((LAS float*)(sb + SB_VEC))[lane] = cs; ((LAS float*)(sb + SB_VEC))[64 + lane] = dtv; }
            const float dec = __expf(cs63);
            LDS_WAIT(); __builtin_amdgcn_s_barrier(); asm volatile("" ::: "memory");
            const size_t otok = tok0 + (size_t)c * 64 + 16 * ti + l16;
            const float zv[4] = {bflo(zrA[S].x), bfhi(zrA[S].x), bflo(zrA[S].y), bfhi(zrA[S].y)};
            if (c + 2 < 32) SSD_LOAD_RAW(c + 2, S);
            const float cs_l = ((const LAS float*)(sb + SB_VEC))[16 * ti + l16];
            bf16x8 Cf[4];
#pragma unroll
            for (int k = 0; k < 4; ++k) Cf[k] = *(const LAS bf16x8*)(sb + SB_CC + (16 * ti + l16) * P272 + (32 * k + 8 * quad) * 2);
#pragma unroll
            for (int jj = 0; jj < 2; ++jj) {
                const int j = 2 * q + jj;
                if (j <= ti) {
                    f32x4 gacc = (f32x4){0.f, 0.f, 0.f, 0.f};
#pragma unroll
                    for (int k = 0; k < 4; ++k) {
                        const bf16x8 Aop = *(const LAS bf16x8*)(sb + SB_BC + (16 * j + l16) * P272 + (32 * k + 8 * quad) * 2);
                        gacc = __builtin_amdgcn_mfma_f32_16x16x32_bf16(Aop, Cf[k], gacc, 0, 0, 0); }
                    const f32x4 cs_s = *(const LAS f32x4*)(sb + SB_VEC + (16 * j + 4 * quad) * 4), dt_s = *(const LAS f32x4*)(sb + SB_VEC + 256 + (16 * j + 4 * quad) * 4);
                    float mv[4];
#pragma unroll
                    for (int r = 0; r < 4; ++r) { const int s_ = 16 * j + 4 * quad + r, l = 16 * ti + l16;
                        float v = gacc[r] * __expf(fminf(cs_l - cs_s[r], 0.f)) * dt_s[r];
                        v = (s_ <= l) ? v : 0.f; if (s_ == l) v += Dh; mv[r] = v; }
                    *(LAS u32x2*)(lds + SL_MM + (16 * ti + l16) * P144 + (16 * j + 4 * quad) * 2) = (u32x2){cvt_pk_bf16(mv[0], mv[1]), cvt_pk_bf16(mv[2], mv[3])};
                } else if ((j >> 1) <= (ti >> 1)) {
                    *(LAS u32x2*)(lds + SL_MM + (16 * ti + l16) * P144 + (16 * j + 4 * quad) * 2) = (u32x2){0u, 0u};
                }
            }
            f32x4 y = (f32x4){0.f, 0.f, 0.f, 0.f};
#pragma unroll
            for (int k = 0; k < 4; ++k) {
                const bf16x8 Aop = *(const LAS bf16x8*)(lds + SL_SL + (16 * q + l16) * P272 + (32 * k + 8 * quad) * 2);
                y = __builtin_amdgcn_mfma_f32_16x16x32_bf16(Aop, Cf[k], y, 0, 0, 0); }
            y = y * __expf(cs_l);
#pragma unroll
            for (int t = 0; t < 2; ++t) { const int jn = 2 * ti + t;
                accS[t] = accS[t] * dec;
#pragma unroll
                for (int kk = 0; kk < 2; ++kk) {
                    LAS unsigned char* tp = sb + SB_BC + (32 * kk + 8 * quad + (l16 >> 2)) * P272 + (16 * jn + 4 * (lane & 3)) * 2;
                    const v4i16_t lo = __builtin_amdgcn_ds_read_tr16_b64_v4i16((LAS v4i16_t*)tp), hi = __builtin_amdgcn_ds_read_tr16_b64_v4i16((LAS v4i16_t*)(tp + 4 * P272));
                    const bf16x8 Aop = __builtin_shufflevector(lo, hi, 0, 1, 2, 3, 4, 5, 6, 7);
                    const bf16x8 Bop = *(const LAS bf16x8*)(sb + SB_XD + (16 * q + l16) * P144 + (32 * kk + 8 * quad) * 2);
                    accS[t] = __builtin_amdgcn_mfma_f32_16x16x32_bf16(Aop, Bop, accS[t], 0, 0, 0); } }
            LDS_WAIT(); __builtin_amdgcn_s_barrier(); asm volatile("" ::: "memory");
            for (int kk = 0; kk <= (ti >> 1); ++kk) {
                const bf16x8 Aop = *(const LAS bf16x8*)(sb + SB_XT + (16 * q + l16) * P144 + (32 * kk + 8 * quad) * 2);
                const bf16x8 Bop = *(const LAS bf16x8*)(lds + SL_MM + (16 * ti + l16) * P144 + (32 * kk + 8 * quad) * 2);
                y = __builtin_amdgcn_mfma_f32_16x16x32_bf16(Aop, Bop, y, 0, 0, 0); }
#pragma unroll
            for (int t = 0; t < 2; ++t) { const int jn = 2 * ti + t;
                *(LAS u32x2*)(lds + SL_SL + (16 * q + l16) * P272 + (16 * jn + 4 * quad) * 2) = (u32x2){cvtpk_s(accS[t][0], accS[t][1]), cvtpk_s(accS[t][2], accS[t][3])}; }
            float v[4], ssq = 0.f;
#pragma unroll
            for (int r = 0; r < 4; ++r) { v[r] = y[r] * silu_f(zv[r]); ssq += v[r] * v[r]; }
            *(u32x2*)(MIX + otok * MIXD + pcol) = (u32x2){cvt_pk_bf16(v[0], v[1]), cvt_pk_bf16(v[2], v[3])};
            ssq += __shfl_xor(ssq, 16); ssq += __shfl_xor(ssq, 32);
            PSS[(size_t)(g * 32 + (h & 7) * 4 + ph * 2 + q) * M + otok] = ssq;
        }
        LDS_WAIT(); __builtin_amdgcn_s_barrier(); asm volatile("" ::: "memory");
#undef SSD_LOAD_RAW
    }
}

template <int WIN>
__device__ __forceinline__ void pool_quads(const bf16* PROJ, bf16* MIX, int blk, int cgp, int tr) {
    for (int i = 0; i < 4; ++i) {
        const int t0 = blk * 64 + tr * 16 + 4 * i, ts0 = t0 & (SEQ - 1);
        u32x4 r[WIN + 3];
#pragma unroll
        for (int k = 0; k < WIN + 3; ++k) { const int dt = k - (WIN - 1); r[k] = (u32x4){0u, 0u, 0u, 0u};
            if (ts0 + dt >= 0) r[k] = *(const u32x4*)(PROJ + (size_t)(t0 + dt) * PROJ_LD + U_OFF + 8 * cgp); }
        float s[8];
#pragma unroll
        for (int e = 0; e < 8; ++e) s[e] = 0.f;
#pragma unroll
        for (int k = 0; k < WIN; ++k) { float f[8]; unpack8(r[k], f);
#pragma unroll
            for (int e = 0; e < 8; ++e) s[e] += f[e]; }
#pragma unroll
        for (int j = 0; j < 4; ++j) {
            float u0[8]; unpack8(r[WIN - 1 + j], u0);
            if (j > 0) { float f[8]; unpack8(r[j - 1], f);
#pragma unroll
                for (int e = 0; e < 8; ++e) s[e] += u0[e] - f[e]; }
            const int cnt = (ts0 + j + 1) < WIN ? (ts0 + j + 1) : WIN; const float inv = 1.0f / (float)cnt;
            u32x4 o; o.x = cvt_pk_bf16(s[0] * inv - u0[0], s[1] * inv - u0[1]); o.y = cvt_pk_bf16(s[2] * inv - u0[2], s[3] * inv - u0[3]);
            o.z = cvt_pk_bf16(s[4] * inv - u0[4], s[5] * inv - u0[5]); o.w = cvt_pk_bf16(s[6] * inv - u0[6], s[7] * inv - u0[7]);
            *(u32x4*)(MIX + (size_t)(t0 + j) * MIXD + 1024 + 8 * cgp) = o; }
    }
}
__device__ __forceinline__ void pool_phase(const Args& a, int G, int vc) {
    const bf16* PROJ = (const bf16*)(a.ws + WS_PROJ);
    bf16* MIX = (bf16*)(a.ws + WS_MIX);
    const int tid = threadIdx.x, lane = tid & 63, wave = __builtin_amdgcn_readfirstlane(tid >> 6);
    const int grp = wave & 3, cgp = grp * 32 + (lane & 31), tr = (wave >> 2) * 2 + (lane >> 5);
    for (int blk = vc; blk < M / 64; blk += G) {
        if (grp == 0) pool_quads<2>(PROJ, MIX, blk, cgp, tr);
        else if (grp == 1) pool_quads<4>(PROJ, MIX, blk, cgp, tr);
        else if (grp == 2) pool_quads<8>(PROJ, MIX, blk, cgp, tr);
        else pool_quads<16>(PROJ, MIX, blk, cgp, tr);
    }
}

constexpr int N_PHASES = 9;
__global__ void __launch_bounds__(NTHR, 2) hybrid_fwd(Args args) {
    extern __shared__ __attribute__((aligned(16))) unsigned char lds_raw[];
    LAS unsigned char* lds = (LAS unsigned char*)lds_raw;
    const int tid = threadIdx.x, lane = tid & 63, wave = __builtin_amdgcn_readfirstlane(tid >> 6);
    const int G = gridDim.x; const int bx = blockIdx.x; const int vcu = (G % 8 == 0) ? (bx % 8) * (G / 8) + bx / 8 : bx;
    unsigned char* ws = args.ws;
    volatile LAS unsigned* MISC = (volatile LAS unsigned*)(lds + MISC_OFF);
    if (tid < 32) MISC[tid] = 0u;
    __syncthreads();
    const int lo = args.ph_lo, hi = args.ph_hi;
#if MK_CG_SYNC
    cg::grid_group grid = cg::this_grid();
#define GRID_BAR() do { __threadfence(); grid.sync(); } while (0)
#else
    cg::grid_group grid = cg::this_grid();
    XcdBarrier bar; bar.bar = (unsigned*)(ws + WS_CTL) + CW_BAR; bar.x = 0; bar.st = nullptr;
    if (hi - lo > 1) bar = xcd_barrier_post((unsigned*)(ws + WS_CTL) + CW_BAR, MISC + 8);
    if (lo > 1000) grid.sync();
#define GRID_BAR() xcd_barrier(bar)
#endif
#define IN(k) (lo <= (k) && (k) < hi)
#define BOTH(k) (IN(k) && IN((k) + 1))
    bf16 *GU1 = (bf16*)(ws + WS_GU1), *D1 = (bf16*)(ws + WS_D1), *GU2 = (bf16*)(ws + WS_GU2), *D2 = (bf16*)(ws + WS_D2), *WIN = (bf16*)(ws + WS_WIN), *WOUT = (bf16*)(ws + WS_WOUT);
    bf16 *XN = (bf16*)(ws + WS_XN), *HID = (bf16*)(ws + WS_HID), *PROJ = (bf16*)(ws + WS_PROJ), *MIX = (bf16*)(ws + WS_MIX);
    float *SS = (float*)(ws + WS_SS), *DTB = (float*)(ws + WS_DT), *PSS = (float*)(ws + WS_PSS);

    if (IN(0)) { p0_prologue<0>(args, lds, vcu * NWAVES + wave, G * NWAVES, wave, lane); if (BOTH(0)) GRID_BAR(); }
    if (IN(1)) {
        pg8::Gemm g{XN, GU1, M, NGU, D}; pg8::StaticOrder S; S.init(M, NGU, G, bx);
        pg8::EpiSwiglu E{HID, nullptr};
        pg8::gemm_phase<pg8::EpiSwiglu, pg8::StaticOrder, pg8::NoHook, true>(lds, g, S, E, pg8::NoHook{});
        { const int first = ((M / 256) * (NGU / 256)) % G;
          if (bx >= first) p0_prologue<1>(args, lds, (bx - first) * NWAVES + wave, (G - first) * NWAVES, wave, lane); }
        if (BOTH(1)) GRID_BAR();
    }
    if (IN(2)) {
        pg8::Gemm g{HID, D1, M, D, FF}; pg8::StaticOrder S; S.init(M, D, G, bx);
        pg8::EpiResX<true, false> E{nullptr, XN, (const float*)(ws + WS_RS0), nullptr, nullptr, XN, (float*)(ws + WS_RS1), SS, (unsigned*)(ws + WS_CTL) + CW_PANEL, 0.5f, args.in[1]};
        pg8::gemm_phase<pg8::EpiResX<true, false>, pg8::StaticOrder, pg8::NoHook, false>(lds, g, S, E, pg8::NoHook{});
        if (BOTH(2)) GRID_BAR();
    }
    if (IN(3)) {
        pg8::Gemm g{XN, WIN, M, NIN, D}; pg8::StaticOrder S; S.init(M, NIN, G, bx);
        pg8::EpiProj E{PROJ, DTB, nullptr};
        pg8::gemm_phase<pg8::EpiProj, pg8::StaticOrder, pg8::NoHook, true>(lds, g, S, E, pg8::NoHook{});
        {
            pg8::Gemm gf{(const bf16*)(ws + WS_FA), (const bf16*)(ws + WS_FB), 4096, 1024, 256}; pg8::FoldOrder SF{G == 256 ? bx - 192 : bx};
            pg8::EpiFold EF{WOUT};
            pg8::gemm_phase<pg8::EpiFold, pg8::FoldOrder, pg8::NoHook, true>(lds, gf, SF, EF, pg8::NoHook{});
        }
        if (BOTH(3)) GRID_BAR();
    }
    if (IN(4)) {
        pool_phase(args, G, vcu);
        conv_phase(args, G, vcu);
        if (BOTH(4)) GRID_BAR();
    }
    if (IN(5)) {
        ssd_phase(lds, args, G, vcu);
        if (BOTH(5)) GRID_BAR();
    }
    if (IN(6)) {
        pg8::StaticOrder S; S.init(M, D, G, bx); pg8::Unit u0;
        LAS float* TAB = (LAS float*)(lds + TAB_OFF);
        if (S.next(0, u0)) {
            const int row = tid & 255, gg = tid >> 8; float s = 0.f;
            for (int k = 0; k < 32; ++k) s += PSS[(size_t)(gg * 32 + k) * M + u0.pm * 256 + row];
            TAB[512 + gg * 256 + row] = 1.0f / sqrtf(s * (1.0f / 512.0f) + EPS);
        }
        __syncthreads();
        if (tid < 256) { const float r0 = TAB[512 + tid], r1 = TAB[768 + tid]; TAB[tid] = r0 / r1; TAB[256 + tid] = r1; }
        __syncthreads();
        pg8::Gemm g{MIX, WOUT, M, D, MIXD};
        pg8::EpiResX<true, false> E{nullptr, XN, (const float*)(ws + WS_RS1), nullptr, nullptr, XN, (float*)(ws + WS_RS2), SS, (unsigned*)(ws + WS_CTL) + CW_PANEL + 1024, 1.0f, nullptr};
        pg8::ScaleHook HK{TAB, 8, 16};
        pg8::gemm_phase<pg8::EpiResX<true, false>, pg8::StaticOrder, pg8::ScaleHook, false>(lds, g, S, E, HK);
        if (BOTH(6)) GRID_BAR();
    }
    if (IN(7)) {
        pg8::Gemm g{XN, GU2, M, NGU, D}; pg8::StaticOrder S; S.init(M, NGU, G, bx);
        pg8::EpiSwiglu E{HID, nullptr};
        pg8::gemm_phase<pg8::EpiSwiglu, pg8::StaticOrder, pg8::NoHook, true>(lds, g, S, E, pg8::NoHook{});
        { const int first = ((M / 256) * (NGU / 256)) % G;
          if (bx >= first) p0_prologue<2>(args, lds, (bx - first) * NWAVES + wave, (G - first) * NWAVES, wave, lane); }
        if (BOTH(7)) GRID_BAR();
    }
    if (IN(8)) {
        pg8::Gemm g{HID, D2, M, D, FF}; pg8::StaticOrder S; S.init(M, D, G, bx);
        pg8::EpiResX<true, true> E{nullptr, XN, (const float*)(ws + WS_RS2), args.out, args.in[20], nullptr, nullptr, SS, (unsigned*)(ws + WS_CTL) + CW_PANEL + 2048, 0.5f, nullptr};
        pg8::gemm_phase<pg8::EpiResX<true, true>, pg8::StaticOrder, pg8::NoHook, false>(lds, g, S, E, pg8::NoHook{});
    }
#undef IN
#undef BOTH
}

extern "C" void kernel_launch(void* const* d_in, const int* in_sizes, int n_in, void* d_out, int out_size, void* d_ws, size_t ws_size, hipStream_t stream) {
    static int grid = 0;
    if (grid == 0) {
        if (n_in != 21 || in_sizes[0] != M * D || out_size != M * D || ws_size < WS_END) { fprintf(stderr, "kernel_launch: unexpected shapes (n_in %d, in0 %d, out %d, ws %zu)\n", n_in, n_in > 0 ? in_sizes[0] : -1, out_size, ws_size); grid = -1; return; }
        int dev = 0, cus = 0, per_cu = 0;
        if (hipGetDevice(&dev) != hipSuccess || hipDeviceGetAttribute(&cus, hipDeviceAttributeMultiprocessorCount, dev) != hipSuccess) { grid = -1; return; }
        if (hipFuncSetAttribute((const void*)hybrid_fwd, hipFuncAttributeMaxDynamicSharedMemorySize, LDS_BYTES) != hipSuccess) { fprintf(stderr, "kernel_launch: hipFuncSetAttribute failed\n"); grid = -1; return; }
        if (hipOccupancyMaxActiveBlocksPerMultiprocessor(&per_cu, (const void*)hybrid_fwd, NTHR, LDS_BYTES) != hipSuccess || per_cu < 1) { fprintf(stderr, "kernel_launch: occupancy query says %d\n", per_cu); per_cu = 1; }
        (void)hipGetLastError();
        grid = cus;
        if (grid != 256) fprintf(stderr, "kernel_launch: %d CUs; the single-unit GEMM phases expect 256\n", grid);
    }
    if (grid < 0) return;
    (void)hipMemsetAsync((char*)d_ws + WS_CTL, 0, CTL_ZERO_BYTES, stream);
    Args a{};
    for (int i = 0; i < 21; ++i) a.in[i] = (const float*)d_in[i];
    a.out = (float*)d_out; a.ws = (unsigned char*)d_ws;
#if MK_N_LAUNCHES == 1
    a.ph_lo = 0; a.ph_hi = N_PHASES;
    void* kargs[] = {&a};
    hipError_t e = hipLaunchCooperativeKernel((const void*)hybrid_fwd, dim3(grid), dim3(NTHR), kargs, LDS_BYTES, stream);
    if (e != hipSuccess) fprintf(stderr, "kernel_launch: cooperative launch failed: %s (grid %d)\n", hipGetErrorString(e), grid);
#else
    for (int p = 0; p < N_PHASES; ++p) { a.ph_lo = p; a.ph_hi = p + 1; hipLaunchKernelGGL(hybrid_fwd, dim3(grid), dim3(NTHR), LDS_BYTES, stream, a); }
#endif
}
```
